# Optimizing an MI355X kernel written in HIP

```python
import jax, jax.numpy as jnp
from jax import lax
import numpy as np

D_MODEL = 1024
BATCH = 8
SEQ = 2048
DEPTH = 4
DEC_BATCH = 8
DEC_SEQ = 64
PAST_LEN = 2048

CHUNK = 64
Q_BLOCK = 128
N_EVEN = (DEPTH + 1) // 2
N_ODD = DEPTH // 2
WA = D_MODEL // 2
HA = 8
BWA = WA // HA
CONV_W = 4
LRU_C = 8.0
HB = 8
DHB = (D_MODEL // 2) // HB
WB = HB * DHB
AB_IN = 2 * WA + 3 * WB
AB_OUT = WA + WB
HC = D_MODEL // 256
DKC = D_MODEL // HC
DVC = 2 * DKC
WC_V = HC * DVC
C_IN = 2 * D_MODEL + 2 * WC_V
ROPE_BASE = 10000.0
D_FF = 2816
P_DIM = 256
N_NORMS = 8
EPS = 1e-6
F32 = jnp.float32

kernel_name = 'hybrid_lru_stickbreak_retention_stream_step'


def rms_norm(x, g):
    xf = x.astype(F32)
    y = xf * lax.rsqrt(jnp.mean(xf * xf, axis=-1, keepdims=True) + EPS)
    return (y * g.astype(F32)).astype(x.dtype)


def swiglu(x, w_gate, w_up, w_down):
    return (jax.nn.silu(x @ w_gate) * (x @ w_up)) @ w_down


def causal_conv(x, buf, w, b):
    L = x.shape[1]
    xp = jnp.concatenate([buf.astype(x.dtype), x], axis=1)
    y = b
    for tap in range(CONV_W):
        y = y + xp[:, tap:tap + L] * w[tap]
    return y, xp[:, -(CONV_W - 1):]


def rg_lru(xc, h0, lam, w_r, b_r, w_i, b_i):
    B, L, _ = xc.shape
    xf = xc.astype(F32)
    xh = xf.reshape(B, L, HA, BWA)
    rg = jax.nn.sigmoid(jnp.einsum('blhi,hij->blhj', xh, w_r.astype(F32)).reshape(B, L, WA) + b_r.astype(F32))
    ig = jax.nn.sigmoid(jnp.einsum('blhi,hij->blhj', xh, w_i.astype(F32)).reshape(B, L, WA) + b_i.astype(F32))
    log_a = -LRU_C * rg * jax.nn.softplus(-lam.astype(F32))
    a = jnp.exp(log_a)
    u = jnp.sqrt(-jnp.expm1(2.0 * log_a)) * ig * xf
    u = u.at[:, 0].add(a[:, 0] * h0.astype(F32))

    def combine(left, right):
        a1, b1 = left
        a2, b2 = right
        return a1 * a2, a2 * b1 + b2

    _, h = lax.associative_scan(combine, (a, u), axis=1)
    return h, h[:, -1]


def stick_breaking_block(q, k, v, q_pos0):
    z = jnp.einsum('bqhd,bkhd->bhqk', q.astype(F32), k.astype(F32)) * (DHB ** -0.5)
    t = q_pos0 + jnp.arange(q.shape[1])
    s = jnp.arange(k.shape[1])
    mask = (s[None, :] < t[:, None])[None, None]
    log_1mb = jnp.where(mask, jax.nn.log_sigmoid(-z), 0.0)
    tail = lax.cumsum(log_1mb, axis=3, reverse=True) - log_1mb
    att = jnp.where(mask, jnp.exp(jax.nn.log_sigmoid(z) + tail), 0.0)
    return jnp.einsum('bhqk,bkhd->bqhd', att, v.astype(F32)).astype(q.dtype)


def stick_breaking(q, k_all, v_all):
    L = q.shape[1]
    P = k_all.shape[1] - L
    outs = []
    for s0 in range(0, L, Q_BLOCK):
        e = min(s0 + Q_BLOCK, L)
        outs.append(stick_breaking_block(q[:, s0:e], k_all[:, :P + e], v_all[:, :P + e], P + s0))
    return jnp.concatenate(outs, axis=1)


def mixer_ab(h, conv_buf, lru_h0, past_k, past_v, w_in, w_out, conv_w, conv_b, w_r, b_r, w_i, b_i, lam):
    B, L, _ = h.shape
    xa, ga, q, k, v = jnp.split(h @ w_in, [WA, 2 * WA, 2 * WA + WB, 2 * WA + 2 * WB], axis=-1)
    xc, new_buf = causal_conv(xa, conv_buf, conv_w, conv_b)
    hs, h_last = rg_lru(xc, lru_h0, lam, w_r, b_r, w_i, b_i)
    out_a = jax.nn.gelu(ga) * hs.astype(h.dtype)
    q = q.reshape(B, L, HB, DHB)
    k = k.reshape(B, L, HB, DHB)
    v = v.reshape(B, L, HB, DHB)
    k_all = jnp.concatenate([past_k.astype(k.dtype), k], axis=1)
    v_all = jnp.concatenate([past_v.astype(v.dtype), v], axis=1)
    out_b = stick_breaking(q, k_all, v_all).reshape(B, L, WB)
    y = jnp.concatenate([out_a, out_b], axis=-1) @ w_out
    return y, h_last.astype(h.dtype), new_buf, k, v


def rotary(x, pos):
    half = x.shape[-1] // 2
    freq = ROPE_BASE ** (-jnp.arange(half, dtype=F32) / half)
    ang = pos.astype(F32)[:, None] * freq[None, :]
    cos = jnp.cos(ang)[None, :, None, :]
    sin = jnp.sin(ang)[None, :, None, :]
    x1, x2 = x[..., :half], x[..., half:]
    return jnp.concatenate([x1 * cos - x2 * sin, x2 * cos + x1 * sin], axis=-1)


def retention_chunk(q, k, v, R, log_g):
    L = q.shape[1]
    idx = jnp.arange(L, dtype=F32)
    dist = jnp.abs(idx[:, None] - idx[None, :])
    decay = jnp.exp(log_g[:, None, None] * dist)
    scores = jnp.einsum('blhd,bmhd->bhlm', q, k) * decay[None]
    o = jnp.einsum('bhlm,bmhe->blhe', scores, v)
    xi = jnp.exp(log_g[None, :] * (idx[:, None] + 1.0))
    o = o + jnp.einsum('blhd,bhde->blhe', q, R) * xi[None, :, :, None]
    zeta = jnp.exp(log_g[None, :] * (L - 1.0 - idx[:, None]))
    R = jnp.exp(log_g * L)[None, :, None, None] * R + jnp.einsum('blhd,blhe->bhde', k * zeta[None, :, :, None], v)
    return o, R


def mixer_c(h, R0, pos0, w_in, w_out):
    B, L, _ = h.shape
    q, k, v, g = jnp.split(h @ w_in, [D_MODEL, 2 * D_MODEL, 2 * D_MODEL + WC_V], axis=-1)
    pos = pos0 + jnp.arange(L)
    q = rotary(q.reshape(B, L, HC, DKC).astype(F32), pos)
    k = rotary(k.reshape(B, L, HC, DKC).astype(F32), pos) * (DKC ** -0.5)
    v = v.reshape(B, L, HC, DVC).astype(F32)
    log_g = jnp.log(1.0 - 2.0 ** (-5.0 - jnp.arange(HC, dtype=F32)))
    cl = min(L, CHUNK)
    n = L // cl

    def to_chunks(t):
        return t.reshape(B, n, cl, *t.shape[2:]).swapaxes(0, 1)

    def step(R, qkv):
        o, R = retention_chunk(qkv[0], qkv[1], qkv[2], R, log_g)
        return R, o

    R_last, o = lax.scan(step, R0.astype(F32), (to_chunks(q), to_chunks(k), to_chunks(v)))
    o = o.swapaxes(0, 1).reshape(B, L, HC, DVC)
    mu = jnp.mean(o, axis=-1, keepdims=True)
    var = jnp.mean(jnp.square(o - mu), axis=-1, keepdims=True)
    o = ((o - mu) * lax.rsqrt(var + EPS)).reshape(B, L, WC_V)
    y = (jax.nn.silu(g.astype(F32)) * o).astype(h.dtype) @ w_out
    return y, R_last.astype(h.dtype)


def run_group(x, p, conv_state, lru_state, past_k, past_v, ret_state,
              norm_g, ffn_w_gate, ffn_w_up, ffn_w_down, ple_w_in, ple_w_gate,
              ab_w_in, ab_w_out, lru_conv_w, lru_conv_b, lru_w_r, lru_b_r, lru_w_i, lru_b_i, lru_lambda,
              ret_w_in, ret_w_out):
    pos0 = past_k.shape[2]
    new_h, new_conv, new_k, new_v, new_ret = [], [], [], [], []
    for i in range(DEPTH):
        g = norm_g[i]
        j = i // 2
        x = x + 0.5 * rms_norm(swiglu(rms_norm(x, g[0]), ffn_w_gate[i, 0], ffn_w_up[i, 0], ffn_w_down[i, 0]), g[1])
        hn = rms_norm(x, g[2])
        if i % 2 == 0:
            mix, h_last, buf, k_rows, v_rows = mixer_ab(
                hn, conv_state[j], lru_state[j], past_k[j], past_v[j], ab_w_in[j], ab_w_out[j],
                lru_conv_w[j], lru_conv_b[j], lru_w_r[j], lru_b_r[j], lru_w_i[j], lru_b_i[j], lru_lambda[j])
            new_h.append(h_last)
            new_conv.append(buf)
            new_k.append(k_rows)
            new_v.append(v_rows)
        else:
            mix, R = mixer_c(hn, ret_state[j], pos0, ret_w_in[j], ret_w_out[j])
            new_ret.append(R)
        x = x + rms_norm(mix, g[3])
        x = x + 0.5 * rms_norm(swiglu(rms_norm(x, g[4]), ffn_w_gate[i, 1], ffn_w_up[i, 1], ffn_w_down[i, 1]), g[5])
        gate = jax.nn.sigmoid(rms_norm(x, g[6]) @ ple_w_gate[i])
        x = x + rms_norm(gate * (p[i] @ ple_w_in[i]), g[7])
    return x, jnp.stack(new_h), jnp.stack(new_conv), jnp.stack(new_k), jnp.stack(new_v), jnp.stack(new_ret)


def setup_inputs(seed: int = 0) -> dict:
    key = jax.random.key(seed)
    ks = jax.random.split(key, 32)
    nrm = jax.random.normal
    u = jax.random.uniform(ks[25], (N_EVEN, WA), F32, 0.9, 0.999)
    a = u ** (1.0 / LRU_C)
    lam = jnp.log(a) - jnp.log1p(-a)
    return {
        'x_prompt': nrm(ks[0], (BATCH, SEQ, D_MODEL), F32),
        'x_sample': nrm(ks[1], (DEC_BATCH, DEC_SEQ, D_MODEL), F32),
        'p_prompt': nrm(ks[2], (DEPTH, BATCH, SEQ, P_DIM), F32),
        'p_sample': nrm(ks[3], (DEPTH, DEC_BATCH, DEC_SEQ, P_DIM), F32),
        'state_lru_h': 0.5 * nrm(ks[4], (N_EVEN, DEC_BATCH, WA), F32),
        'state_conv': nrm(ks[5], (N_EVEN, DEC_BATCH, CONV_W - 1, WA), F32),
        'cache_sb_k': nrm(ks[6], (N_EVEN, DEC_BATCH, PAST_LEN, HB, DHB), F32),
        'cache_sb_v': nrm(ks[7], (N_EVEN, DEC_BATCH, PAST_LEN, HB, DHB), F32),
        'state_ret': 0.1 * nrm(ks[8], (N_ODD, DEC_BATCH, HC, DKC, DVC), F32),
        'norm_g': 1.0 + 0.05 * nrm(ks[9], (DEPTH, N_NORMS, D_MODEL), F32),
        'ffn_w_gate': nrm(ks[10], (DEPTH, 2, D_MODEL, D_FF), F32) * D_MODEL ** -0.5,
        'ffn_w_up': nrm(ks[11], (DEPTH, 2, D_MODEL, D_FF), F32) * D_MODEL ** -0.5,
        'ffn_w_down': nrm(ks[12], (DEPTH, 2, D_FF, D_MODEL), F32) * D_FF ** -0.5,
        'ple_w_in': nrm(ks[13], (DEPTH, P_DIM, D_MODEL), F32) * P_DIM ** -0.5,
        'ple_w_gate': nrm(ks[14], (DEPTH, D_MODEL, D_MODEL), F32) * D_MODEL ** -0.5,
        'ab_w_in': nrm(ks[15], (N_EVEN, D_MODEL, AB_IN), F32) * D_MODEL ** -0.5,
        'ab_w_out': nrm(ks[16], (N_EVEN, AB_OUT, D_MODEL), F32) * AB_OUT ** -0.5,
        'lru_conv_w': nrm(ks[17], (N_EVEN, CONV_W, WA), F32) * CONV_W ** -0.5,
        'lru_conv_b': 0.01 * nrm(ks[18], (N_EVEN, WA), F32),
        'lru_w_r': nrm(ks[19], (N_EVEN, HA, BWA, BWA), F32) * BWA ** -0.5,
        'lru_b_r': 0.01 * nrm(ks[20], (N_EVEN, WA), F32),
        'lru_w_i': nrm(ks[21], (N_EVEN, HA, BWA, BWA), F32) * BWA ** -0.5,
        'lru_b_i': 0.01 * nrm(ks[22], (N_EVEN, WA), F32),
        'lru_lambda': lam,
        'ret_w_in': nrm(ks[23], (N_ODD, D_MODEL, C_IN), F32) * D_MODEL ** -0.5,
        'ret_w_out': nrm(ks[24], (N_ODD, WC_V, D_MODEL), F32) * WC_V ** -0.5,
    }


def reference(x_prompt, x_sample, p_prompt, p_sample, state_lru_h, state_conv, cache_sb_k, cache_sb_v, state_ret,
              norm_g, ffn_w_gate, ffn_w_up, ffn_w_down, ple_w_in, ple_w_gate,
              ab_w_in, ab_w_out, lru_conv_w, lru_conv_b, lru_w_r, lru_b_r, lru_w_i, lru_b_i, lru_lambda,
              ret_w_in, ret_w_out):
    B = x_prompt.shape[0]
    dt = x_prompt.dtype
    conv0 = jnp.zeros((N_EVEN, B, CONV_W - 1, WA), dt)
    h0 = jnp.zeros((N_EVEN, B, WA), dt)
    kv0 = jnp.zeros((N_EVEN, B, 0, HB, DHB), dt)
    r0 = jnp.zeros((N_ODD, B, HC, DKC, DVC), dt)
    y_p, h_p, c_p, k_p, v_p, r_p = run_group(
        x_prompt, p_prompt, conv0, h0, kv0, kv0, r0,
        norm_g, ffn_w_gate, ffn_w_up, ffn_w_down, ple_w_in, ple_w_gate,
        ab_w_in, ab_w_out, lru_conv_w, lru_conv_b, lru_w_r, lru_b_r, lru_w_i, lru_b_i, lru_lambda,
        ret_w_in, ret_w_out)
    y_s, h_s, c_s, k_s, v_s, r_s = run_group(
        x_sample, p_sample, state_conv, state_lru_h, cache_sb_k, cache_sb_v, state_ret,
        norm_g, ffn_w_gate, ffn_w_up, ffn_w_down, ple_w_in, ple_w_gate,
        ab_w_in, ab_w_out, lru_conv_w, lru_conv_b, lru_w_r, lru_b_r, lru_w_i, lru_b_i, lru_lambda,
        ret_w_in, ret_w_out)
    return (y_p, y_s, h_p, c_p, k_p, v_p, r_p, h_s, c_s, k_s, v_s, r_s)
```

```cpp
#include <hip/hip_runtime.h>
#include <hip/hip_cooperative_groups.h>
#include <cstdio>
#include <cstdint>
namespace cg = cooperative_groups;
namespace pg8 {
#define PG8_LAS __attribute__((address_space(3)))
typedef unsigned short bf16_t;
typedef short bf16x8 __attribute__((ext_vector_type(8)));
typedef float f32x4 __attribute__((ext_vector_type(4)));
typedef unsigned u32x4 __attribute__((ext_vector_type(4)));
constexpr int BM = 256, BK = 64, HALF = 128, HTB = HALF * BK * 2  , STAGE_BYTES = 8 * HTB, NXCD = 8, WGM = 8;

__host__ __device__ __forceinline__ int lds_byte(int r, int c) { const int st = (r >> 4) * 2 + (c >> 5), rr = r & 15, cc = c & 31, ob = rr * 64 + cc * 2; return st * 1024 + (ob ^ (((ob >> 9) & 1) << 5)); }
__host__ __device__ __forceinline__ void stage_rc(int b, int& R, int& C) { const int st = b / 1024, sb = b % 1024, swz = sb ^ (((sb >> 9) & 1) << 5); R = (st >> 1) * 16 + swz / 64; C = (st & 1) * 32 + (swz % 64) / 2; }
__host__ __device__ __forceinline__ int perm32(int rho) { const int n = rho >> 4, i = rho & 15; return 8 * (i >> 2) + 4 * n + (i & 3); }

struct Unit { int pm, pn; };
struct Gemm { const bf16_t* A; const bf16_t* Bt; int M, N, K; };

struct StaticOrder {
    int nM, nN, nwg, G, c;
    __host__ __device__ void init(int M, int N, int G_, int c_) { nM = M / BM; nN = N / BM; nwg = nM * nN; G = G_; c = c_; }
    __host__ __device__ bool next(int i, Unit& u) const {
        const long L = (long)i * G + c; if (L >= nwg) return false;
        int wgid = (int)L; { const int q = nwg / NXCD, r = nwg % NXCD, xcd = wgid % NXCD, off = wgid / NXCD; wgid = (xcd < r ? xcd * (q + 1) : r * (q + 1) + (xcd - r) * q) + off; }
        const int nig = WGM * nN, gid = wgid / nig, fm = gid * WGM, gsz = (nM - fm) < WGM ? (nM - fm) : WGM;
        u.pm = fm + ((wgid % nig) % gsz); u.pn = (wgid % nig) / gsz; return true;
    }
    __device__ __forceinline__ void a_ready(const Unit&) const {}
    __device__ __forceinline__ void done(const Unit&) const {}
};

__device__ __forceinline__ unsigned cvt_pk_bf16(float lo, float hi) { unsigned r; asm volatile("v_cvt_pk_bf16_f32 %0, %1, %2" : "=v"(r) : "v"(lo), "v"(hi)); return r; }
template <class Epi, class Sched, bool ALIGN_EPI = false, bool SP2 = false>
__device__ __forceinline__ void gemm_phase(PG8_LAS unsigned char* lds, const Gemm g, const Sched& S, const Epi& E) {
    int tid_l = threadIdx.x; asm volatile("" : "+v"(tid_l));
    const int tid = tid_l, wid = __builtin_amdgcn_readfirstlane(tid >> 6), lane = tid & 63, wr = wid >> 2, wc = wid & 3, fr = lane & 15, fq = lane >> 4;
    const int K = g.K, nt = K / BK;
    unsigned voffA[2], voffB[2];
#pragma unroll
    for (int i = 0; i < 2; ++i) { int R, C; stage_rc(tid * 16 + i * 8192, R, C); const int Rb = Epi::PERM ? ((R & ~31) + perm32(R & 31)) : R;
        voffA[i] = (unsigned)(R * K + C) * 2u; voffB[i] = (unsigned)(Rb * K + C) * 2u; }
    const size_t kstep = (size_t)(BK * 2);
    const size_t hstep = (size_t)HALF * K * 2;
    const size_t tstep = 2 * hstep;
    const unsigned ldsw = (unsigned)wid * 1024u;
    const int aoff = lds_byte(wr * 64 + fr, fq * 8), boff = lds_byte(wc * 32 + fr, fq * 8);
#define PG8_SA(b, h) (((b) * 2 + (h)) * HTB)
#define PG8_SB(b, h) ((4 + (b) * 2 + (h)) * HTB)
#define PG8_STAGE(bufoff, gbase, voff) do { _Pragma("unroll") for (int _i = 0; _i < 2; ++_i) \
        __builtin_amdgcn_global_load_lds((const unsigned*)((const char*)(gbase) + (voff)[_i]), (PG8_LAS unsigned*)(lds + (bufoff) + ldsw + _i * 8192), 16, 0, 0); } while (0)
#define PG8_LDA(dst, b, h) do { _Pragma("unroll") for (int m = 0; m < 4; ++m) _Pragma("unroll") for (int k = 0; k < 2; ++k) dst[m][k] = *(const PG8_LAS bf16x8*)(lds + PG8_SA(b, h) + aoff + m * 2048 + k * 1024); } while (0)
#define PG8_LDB(dst, b, h) do { _Pragma("unroll") for (int n = 0; n < 2; ++n) _Pragma("unroll") for (int k = 0; k < 2; ++k) dst[n][k] = *(const PG8_LAS bf16x8*)(lds + PG8_SB(b, h) + boff + n * 2048 + k * 1024); } while (0)
#define PG8_MMA(ai, bj, At, Bt) do { __builtin_amdgcn_s_setprio(1); _Pragma("unroll") for (int m = 0; m < 4; ++m) _Pragma("unroll") for (int n = 0; n < 2; ++n) _Pragma("unroll") for (int k = 0; k < 2; ++k) \
        acc[ai][bj][m][n] = __builtin_amdgcn_mfma_f32_16x16x32_bf16(Bt[n][k], At[m][k], acc[ai][bj][m][n], 0, 0, 0); __builtin_amdgcn_s_setprio(0); } while (0)
#define PG8_WAIT_V(n) asm volatile("s_waitcnt vmcnt(" #n ")" ::: "memory")
#define PG8_WAIT_L(n) asm volatile("s_waitcnt lgkmcnt(" #n ")" ::: "memory")
#define PG8_BAR __builtin_amdgcn_s_barrier()
#define PG8_SCHED __builtin_amdgcn_sched_barrier(0)
    Unit cur, nxt; int ui = 0;
    if (!S.next(0, cur)) return;
    f32x4 acc[2][2][4][2];
#pragma unroll
    for (int a = 0; a < 2; ++a)
#pragma unroll
        for (int b = 0; b < 2; ++b)
#pragma unroll
            for (int m = 0; m < 4; ++m)
#pragma unroll
                for (int n = 0; n < 2; ++n) acc[a][b][m][n] = (f32x4){0.f, 0.f, 0.f, 0.f};
    bf16x8 At[4][2], B0[2][2], B1[2][2];
    const char* cA = (const char*)g.A + (size_t)cur.pm * tstep; const char* cB = (const char*)g.Bt + (size_t)cur.pn * tstep;
    S.a_ready(cur);
    if constexpr (SP2) {
        PG8_STAGE(PG8_SB(0, 0), cB, voffB); PG8_STAGE(PG8_SB(0, 1), cB + hstep, voffB); PG8_STAGE(PG8_SA(0, 0), cA, voffA); PG8_STAGE(PG8_SA(0, 1), cA + hstep, voffA);
        if (wr == 1) PG8_BAR;
        PG8_WAIT_V(2); PG8_BAR;
        PG8_STAGE(PG8_SB(1, 0), cB + kstep, voffB); PG8_STAGE(PG8_SA(1, 0), cA + kstep, voffA); PG8_STAGE(PG8_SB(1, 1), cB + hstep + kstep, voffB);
        PG8_WAIT_V(6); PG8_BAR;
    } else {
        PG8_STAGE(PG8_SB(0, 0), cB, voffB); PG8_STAGE(PG8_SA(0, 0), cA, voffA); PG8_STAGE(PG8_SB(0, 1), cB + hstep, voffB); PG8_STAGE(PG8_SA(0, 1), cA + hstep, voffA);
        if (wr == 1) PG8_BAR;
        PG8_WAIT_V(4); PG8_BAR;
        PG8_STAGE(PG8_SB(1, 0), cB + kstep, voffB); PG8_STAGE(PG8_SA(1, 0), cA + kstep, voffA); PG8_STAGE(PG8_SB(1, 1), cB + hstep + kstep, voffB);
        PG8_WAIT_V(6); PG8_BAR;
    }
    for (;;) {
        const bool has_next = S.next(ui + 1, nxt);
        const char* nA = has_next ? (const char*)g.A + (size_t)nxt.pm * tstep : cA; const char* nB = has_next ? (const char*)g.Bt + (size_t)nxt.pn * tstep : cB;
        for (int t = 0; t < nt; t += 2) {
            const bool last = (t == nt - 2);
            const char* a1 = cA + (size_t)(t + 1) * kstep;
            const char* a2 = last ? nA : cA + (size_t)(t + 2) * kstep; const char* b2 = last ? nB : cB + (size_t)(t + 2) * kstep;
            const char* a3 = a2 + kstep; const char* b3 = b2 + kstep;
            if (last && has_next) S.a_ready(nxt);
            if constexpr (SP2) {
            PG8_LDB(B0, 0, 0); PG8_LDB(B1, 0, 1); PG8_SCHED; PG8_LDA(At, 0, 0); PG8_STAGE(PG8_SA(1, 1), a1 + hstep, voffA);
            PG8_WAIT_V(8); PG8_WAIT_L(0); PG8_BAR; PG8_MMA(0, 0, At, B0); PG8_MMA(0, 1, At, B1); PG8_BAR; PG8_SCHED;
            PG8_LDA(At, 0, 1); PG8_STAGE(PG8_SB(0, 0), b2, voffB); PG8_STAGE(PG8_SB(0, 1), b2 + hstep, voffB); PG8_STAGE(PG8_SA(0, 0), a2, voffA);
            PG8_WAIT_V(8); PG8_WAIT_L(0); PG8_BAR; PG8_MMA(1, 0, At, B0); PG8_MMA(1, 1, At, B1); PG8_BAR; PG8_SCHED;
            PG8_LDB(B0, 1, 0); PG8_LDB(B1, 1, 1); PG8_SCHED; PG8_LDA(At, 1, 0); PG8_STAGE(PG8_SA(0, 1), a2 + hstep, voffA);
            PG8_WAIT_V(8); PG8_WAIT_L(0); PG8_BAR; PG8_MMA(0, 0, At, B0); PG8_MMA(0, 1, At, B1); PG8_BAR; PG8_SCHED;
            PG8_LDA(At, 1, 1); PG8_STAGE(PG8_SB(1, 0), b3, voffB); PG8_STAGE(PG8_SB(1, 1), b3 + hstep, voffB); PG8_STAGE(PG8_SA(1, 0), a3, voffA);
            PG8_WAIT_V(8); PG8_WAIT_L(0); PG8_BAR; PG8_MMA(1, 0, At, B0); PG8_MMA(1, 1, At, B1); PG8_BAR; PG8_SCHED;
            } else {
            PG8_LDB(B0, 0, 0); PG8_SCHED; PG8_LDA(At, 0, 0); PG8_STAGE(PG8_SA(1, 1), a1 + hstep, voffA);
            PG8_WAIT_L(8); PG8_BAR; PG8_WAIT_L(0); PG8_MMA(0, 0, At, B0); PG8_BAR; PG8_SCHED;
            PG8_LDB(B1, 0, 1); PG8_STAGE(PG8_SB(0, 0), b2, voffB);
            PG8_BAR; PG8_WAIT_L(0); PG8_MMA(0, 1, At, B1); PG8_BAR;
            PG8_LDA(At, 0, 1); PG8_STAGE(PG8_SA(0, 0), a2, voffA);
            PG8_BAR; PG8_WAIT_L(0); PG8_MMA(1, 0, At, B0); PG8_BAR; PG8_SCHED;
            PG8_STAGE(PG8_SB(0, 1), b2 + hstep, voffB);
            PG8_WAIT_V(6); PG8_BAR; PG8_MMA(1, 1, At, B1); PG8_BAR;
            PG8_LDB(B0, 1, 0); PG8_SCHED; PG8_LDA(At, 1, 0); PG8_STAGE(PG8_SA(0, 1), a2 + hstep, voffA);
            PG8_WAIT_L(8); PG8_BAR; PG8_WAIT_L(0); PG8_MMA(0, 0, At, B0); PG8_BAR; PG8_SCHED;
            PG8_LDB(B1, 1, 1); PG8_STAGE(PG8_SB(1, 0), b3, voffB);
            PG8_BAR; PG8_WAIT_L(0); PG8_MMA(0, 1, At, B1); PG8_BAR;
            PG8_LDA(At, 1, 1); PG8_STAGE(PG8_SA(1, 0), a3, voffA);
            PG8_BAR; PG8_WAIT_L(0); PG8_MMA(1, 0, At, B0); PG8_BAR; PG8_SCHED;
            PG8_STAGE(PG8_SB(1, 1), b3 + hstep, voffB);
            PG8_WAIT_V(6); PG8_BAR; PG8_MMA(1, 1, At, B1); PG8_BAR;
            }
        }
        if constexpr (ALIGN_EPI) { if (wr == 0) PG8_BAR; }
        if constexpr (!Epi::AFTER_DRAIN) { Unit cu = cur; int fr_l = fr, fq_l = fq; asm volatile("" : "+s"(cu.pm), "+s"(cu.pn), "+v"(fr_l), "+v"(fq_l)); E(acc, cu, wr, wc, fr_l, fq_l); S.done(cur); }
        if (!has_next) break;
#pragma unroll
        for (int a = 0; a < 2; ++a)
#pragma unroll
            for (int b = 0; b < 2; ++b)
#pragma unroll
                for (int m = 0; m < 4; ++m)
#pragma unroll
                    for (int n = 0; n < 2; ++n) acc[a][b][m][n] = (f32x4){0.f, 0.f, 0.f, 0.f};
        cur = nxt; cA = nA; cB = nB; ++ui;
        if constexpr (ALIGN_EPI) { if (wr == 1) PG8_BAR; }
    }
    PG8_WAIT_V(0);
    if constexpr (!ALIGN_EPI) { if (wr == 0) PG8_BAR; }
    PG8_BAR;
    if constexpr (Epi::AFTER_DRAIN) { E.fused(acc, cur, wr, wc, fr, fq, lds, wid, lane); S.done(cur); }
#undef PG8_SA
#undef PG8_SB
#undef PG8_STAGE
#undef PG8_LDA
#undef PG8_LDB
#undef PG8_MMA
#undef PG8_WAIT_V
#undef PG8_WAIT_L
#undef PG8_BAR
#undef PG8_SCHED
}
}

#define LAS __attribute__((address_space(3)))
typedef unsigned short bf16_t;
typedef short bf16x8 __attribute__((ext_vector_type(8)));
typedef float f32x4 __attribute__((ext_vector_type(4)));
typedef float f32x2 __attribute__((ext_vector_type(2)));
typedef float f32x16 __attribute__((ext_vector_type(16)));
typedef unsigned u32x4 __attribute__((ext_vector_type(4)));
typedef unsigned u32x2 __attribute__((ext_vector_type(2)));
#define DI __device__ __forceinline__
#define MFMA32(a, b, c) __builtin_amdgcn_mfma_f32_32x32x16_bf16((a), (b), (c), 0, 0, 0)

constexpr int M = 16896, MP = 16384, D = 1024, FF = 2816;
constexpr float EPS = 1e-6f;
constexpr int NTHR = 512;
constexpr int LDS_BYTES = 136 * 1024;

constexpr size_t O_Y = 0;
constexpr size_t O_LRUH_P = (size_t)M * 1024;
constexpr size_t O_CONV_P = O_LRUH_P + 8192;
constexpr size_t O_SBK_P = O_CONV_P + 24576;
constexpr size_t O_SBV_P = O_SBK_P + 16777216;
constexpr size_t O_RET_P = O_SBV_P + 16777216;
constexpr size_t O_LRUH_S = O_RET_P + 8388608;
constexpr size_t O_CONV_S = O_LRUH_S + 8192;
constexpr size_t O_SBK_S = O_CONV_S + 24576;
constexpr size_t O_SBV_S = O_SBK_S + 524288;
constexpr size_t O_RET_S = O_SBV_S + 524288;
constexpr size_t O_END = O_RET_S + 8388608;

constexpr size_t SZ_M1K = (size_t)M * 1024 * 2;
constexpr size_t WS_CTL = 0;
constexpr size_t WS_WGU = 65536;
constexpr size_t SZ_WGU1 = (size_t)5632 * 1024 * 2;
constexpr size_t WS_WDN = WS_WGU + 8 * SZ_WGU1;
constexpr size_t SZ_WDN1 = (size_t)1024 * 2816 * 2;
constexpr size_t WS_WPG = WS_WDN + 8 * SZ_WDN1;
constexpr size_t SZ_W1K = (size_t)1024 * 1024 * 2;
constexpr size_t WS_WPI = WS_WPG + 4 * SZ_W1K;
constexpr size_t SZ_WPI1 = (size_t)1024 * 256 * 2;
constexpr size_t WS_WABI = WS_WPI + 4 * SZ_WPI1;
constexpr size_t SZ_WABI1 = (size_t)2560 * 1024 * 2;
constexpr size_t WS_WABO = WS_WABI + 2 * SZ_WABI1;
constexpr size_t WS_WCI = WS_WABO + 2 * SZ_W1K;
constexpr size_t SZ_WCI1 = (size_t)6144 * 1024 * 2;
constexpr size_t WS_WCO = WS_WCI + 2 * SZ_WCI1;
constexpr size_t SZ_WCO1 = (size_t)1024 * 2048 * 2;
constexpr size_t WS_H = WS_WCO + 2 * SZ_WCO1;
constexpr size_t WS_ACT = WS_H + SZ_M1K;
constexpr size_t WS_Y = WS_ACT + (size_t)M * 2816 * 2;
constexpr size_t WS_PE = WS_Y + SZ_M1K;
constexpr size_t WS_KBS = WS_PE + SZ_M1K;
constexpr size_t SZ_KBS1 = (size_t)64 * 2112 * 64 * 2;
constexpr size_t WS_VTS = WS_KBS + 2 * SZ_KBS1;
constexpr size_t WS_TAB = WS_VTS + 2 * SZ_KBS1;
constexpr size_t SZ_TAB1 = (size_t)2112 * 128 * 4;
constexpr size_t WS_MIX = WS_TAB + 2 * SZ_TAB1;
constexpr size_t WS_XAQ = WS_MIX;
constexpr size_t WS_KBP = WS_XAQ + (size_t)M * 1536 * 2;
constexpr size_t WS_VTP = WS_KBP + (size_t)64 * 2048 * 64 * 2;
constexpr size_t WS_MIXE = WS_VTP + (size_t)64 * 2048 * 64 * 2;
constexpr size_t WS_KR = WS_MIX;
constexpr size_t WS_GG = WS_KR + SZ_M1K;
constexpr size_t WS_KT = WS_GG + 2 * SZ_M1K;
constexpr size_t WS_VT = WS_KT + SZ_M1K;
constexpr size_t WS_END = WS_VT + 2 * SZ_M1K;
constexpr size_t WS_PB = WS_MIX;
constexpr size_t WS_QR = WS_Y;
constexpr size_t WS_OB = WS_ACT;

struct KArgs { const float* in[26]; float* out; unsigned char* ws; };

DI float lane_xor(float v, int lane, int o) { return __builtin_bit_cast(float, __builtin_amdgcn_ds_bpermute((lane ^ o) << 2, __builtin_bit_cast(int, v))); }
DI float wave_sum(float v, int lane) {
#pragma unroll
    for (int o = 1; o < 64; o <<= 1) v += lane_xor(v, lane, o);
    return v;
}
DI unsigned f2bf(float f) { unsigned u = __float_as_uint(f); return (u + 0x7fffu + ((u >> 16) & 1u)) >> 16; }
DI unsigned pk2(float lo, float hi) { return f2bf(lo) | (f2bf(hi) << 16); }
DI float bflo(unsigned w) { return __uint_as_float(w << 16); }
DI float bfhi(unsigned w) { return __uint_as_float(w & 0xffff0000u); }
DI float bf1(bf16_t h) { return __uint_as_float((unsigned)h << 16); }
DI float sigmoidf_(float x) { return __builtin_amdgcn_rcpf(1.f + __expf(-x)); }
DI void row_dec(int r, int& g, int& b, int& t) { if (r < MP) { g = 0; b = r >> 11; t = r & 2047; } else { g = 1; const int q = r - MP; b = q >> 6; t = q & 63; } }
DI int crow(int reg, int h) { return (reg & 3) + 8 * (reg >> 2) + 4 * h; }
#define WAVE_LDS_SYNC() do { asm volatile("s_waitcnt lgkmcnt(0)" ::: "memory"); __builtin_amdgcn_wave_barrier(); asm volatile("" ::: "memory"); } while (0)

using pg8::Unit;
typedef const f32x4 (&AccRef)[2][2][4][2];

struct EpiSwiGLU {
    static constexpr bool PERM = true, AFTER_DRAIN = false;
    bf16_t* O;
    DI void operator()(AccRef acc, const Unit& u, int wr, int wc, int fr, int fq) const {
        const int row0 = u.pm * 256 + wr * 64 + fr, col0 = u.pn * 128 + wc * 32 + 8 * fq;
#pragma unroll
        for (int ai = 0; ai < 2; ++ai)
#pragma unroll
            for (int m = 0; m < 4; ++m) {
                float v[8];
#pragma unroll
                for (int n = 0; n < 2; ++n)
#pragma unroll
                    for (int i = 0; i < 4; ++i) { const float g = acc[ai][0][m][n][i], up = acc[ai][1][m][n][i]; v[n * 4 + i] = g * up * sigmoidf_(g); }
                u32x4 w; w.x = pk2(v[0], v[1]); w.y = pk2(v[2], v[3]); w.z = pk2(v[4], v[5]); w.w = pk2(v[6], v[7]);
                *(u32x4*)(O + (size_t)(row0 + ai * 128 + m * 16) * FF + col0) = w;
            }
    }
};
struct EpiY {
    static constexpr bool PERM = true, AFTER_DRAIN = false;
    bf16_t* O; const bf16_t* PE;
    DI void operator()(AccRef acc, const Unit& u, int wr, int wc, int fr, int fq) const {
        const int row0 = u.pm * 256 + wr * 64 + fr, col0 = u.pn * 256 + wc * 32 + 8 * fq;
#pragma unroll
        for (int ai = 0; ai < 2; ++ai)
#pragma unroll
            for (int m = 0; m < 4; ++m)
#pragma unroll
                for (int bj = 0; bj < 2; ++bj) {
                    const size_t off = (size_t)(row0 + ai * 128 + m * 16) * 1024 + col0 + bj * 128;
                    f32x4 v0 = acc[ai][bj][m][0], v1 = acc[ai][bj][m][1];
                    if (PE) {
                        const u32x4 p = *(const u32x4*)(PE + off);
                        v0[0] = sigmoidf_(v0[0]) * bflo(p.x); v0[1] = sigmoidf_(v0[1]) * bfhi(p.x); v0[2] = sigmoidf_(v0[2]) * bflo(p.y); v0[3] = sigmoidf_(v0[3]) * bfhi(p.y);
                        v1[0] = sigmoidf_(v1[0]) * bflo(p.z); v1[1] = sigmoidf_(v1[1]) * bfhi(p.z); v1[2] = sigmoidf_(v1[2]) * bflo(p.w); v1[3] = sigmoidf_(v1[3]) * bfhi(p.w);
                    }
                    u32x4 w; w.x = pk2(v0[0], v0[1]); w.y = pk2(v0[2], v0[3]); w.z = pk2(v1[0], v1[1]); w.w = pk2(v1[2], v1[3]);
                    *(u32x4*)(O + off) = w;
                }
    }
};
struct EpiAB {
    static constexpr bool PERM = true, AFTER_DRAIN = false;
    bf16_t* XAQ; bf16_t* KBP; bf16_t* VTP; bf16_t* KBS; bf16_t* VTS; float* out; int j;
    DI void operator()(AccRef acc, const Unit& u, int wr, int wc, int fr, int fq) const {
        const int row0 = u.pm * 256 + wr * 64 + fr, offc = wc * 32 + 8 * fq;
        if (u.pn < 6) {
#pragma unroll
            for (int ai = 0; ai < 2; ++ai)
#pragma unroll
                for (int m = 0; m < 4; ++m)
#pragma unroll
                    for (int bj = 0; bj < 2; ++bj) {
                        const f32x4 v0 = acc[ai][bj][m][0], v1 = acc[ai][bj][m][1];
                        u32x4 w; w.x = pk2(v0[0], v0[1]); w.y = pk2(v0[2], v0[3]); w.z = pk2(v1[0], v1[1]); w.w = pk2(v1[2], v1[3]);
                        *(u32x4*)(XAQ + (size_t)(row0 + ai * 128 + m * 16) * 1536 + u.pn * 256 + bj * 128 + offc) = w;
                    }
        } else {
            const bool isv = u.pn >= 8;
#pragma unroll
            for (int ai = 0; ai < 2; ++ai)
#pragma unroll
                for (int m = 0; m < 4; ++m) {
                    const int r = row0 + ai * 128 + m * 16; int g, b, t; row_dec(r, g, b, t);
                    float* of = out + (g ? (isv ? O_SBV_S : O_SBK_S) + (size_t)j * (512 * 512) + (size_t)(r - MP) * 512
                                         : (isv ? O_SBV_P : O_SBK_P) + (size_t)j * ((size_t)MP * 512) + (size_t)r * 512);
#pragma unroll
                    for (int bj = 0; bj < 2; ++bj) {
                        const int c = ((u.pn & 1) * 256) + bj * 128 + offc, head = c >> 6, d = c & 63;
                        const f32x4 v0 = acc[ai][bj][m][0], v1 = acc[ai][bj][m][1];
                        *(f32x4*)(of + c) = v0; *(f32x4*)(of + c + 4) = v1;
                        if (!isv) {
                            u32x4 w; w.x = pk2(v0[0], v0[1]); w.y = pk2(v0[2], v0[3]); w.z = pk2(v1[0], v1[1]); w.w = pk2(v1[2], v1[3]);
                            bf16_t* kb = g ? KBS + ((size_t)(b * 8 + head) * 2112 + 2048 + t) * 64 + d : KBP + ((size_t)(b * 8 + head) * 2048 + t) * 64 + d;
                            *(u32x4*)kb = w;
                        } else {
                            const size_t T = g ? 2112 : 2048;
                            bf16_t* vt = g ? VTS + ((size_t)(b * 8 + head) * 64 + d) * 2112 + 2048 + t : VTP + ((size_t)(b * 8 + head) * 64 + d) * 2048 + t;
#pragma unroll
                            for (int i = 0; i < 4; ++i) { vt[(size_t)i * T] = (bf16_t)f2bf(v0[i]); vt[(size_t)(4 + i) * T] = (bf16_t)f2bf(v1[i]); }
                        }
                    }
                }
        }
    }
};
struct EpiC {
    static constexpr bool PERM = true, AFTER_DRAIN = false;
    bf16_t* QR; bf16_t* KR; bf16_t* KT; bf16_t* VT; bf16_t* GG; const float* ctab; const float* stab;
    DI void operator()(AccRef acc, const Unit& u, int wr, int wc, int fr, int fq) const {
        const int row0 = u.pm * 256 + wr * 64 + fr, offc = wc * 32 + 8 * fq;
        if (u.pn < 8) {
            const bool isk = u.pn >= 4; const int head = u.pn & 3; const float sc = isk ? 0.0625f : 1.f;
            bf16_t* dst = isk ? KR : QR;
#pragma unroll
            for (int ai = 0; ai < 2; ++ai)
#pragma unroll
                for (int m = 0; m < 4; ++m) {
                    const int r = row0 + ai * 128 + m * 16; int g, b, t; row_dec(r, g, b, t);
                    const int pos = g ? 2048 + t : t;
                    const size_t T = g ? 64 : 2048;
                    bf16_t* kt = g ? KT + (size_t)MP * 1024 + ((size_t)(b * 4 + head) * 256 + offc) * 64 + t : KT + ((size_t)(b * 4 + head) * 256 + offc) * 2048 + t;
#pragma unroll
                    for (int n = 0; n < 2; ++n) {
                        const f32x4 cc = *(const f32x4*)(ctab + pos * 128 + offc + 4 * n), ss = *(const f32x4*)(stab + pos * 128 + offc + 4 * n);
                        const f32x4 x1 = acc[ai][0][m][n] * sc, x2 = acc[ai][1][m][n] * sc;
                        const f32x4 ra = x1 * cc - x2 * ss, rb = x2 * cc + x1 * ss;
                        u32x2 w1, w2; w1.x = pk2(ra[0], ra[1]); w1.y = pk2(ra[2], ra[3]); w2.x = pk2(rb[0], rb[1]); w2.y = pk2(rb[2], rb[3]);
                        *(u32x2*)(dst + (size_t)r * 1024 + head * 256 + offc + 4 * n) = w1;
                        *(u32x2*)(dst + (size_t)r * 1024 + head * 256 + 128 + offc + 4 * n) = w2;
                        if (isk) {
#pragma unroll
                            for (int i = 0; i < 4; ++i) { kt[(size_t)(4 * n + i) * T] = (bf16_t)(w1[i >> 1] >> (16 * (i & 1))); kt[(size_t)(128 + 4 * n + i) * T] = (bf16_t)(w2[i >> 1] >> (16 * (i & 1))); }
                        }
                        asm volatile("" ::: "memory");
                    }
                }
        } else if (u.pn < 16) {
#pragma unroll
            for (int ai = 0; ai < 2; ++ai)
#pragma unroll
                for (int m = 0; m < 4; ++m) {
                    const int r = row0 + ai * 128 + m * 16; int g, b, t; row_dec(r, g, b, t);
                    const size_t T = g ? 64 : 2048;
#pragma unroll
                    for (int bj = 0; bj < 2; ++bj) {
                        const int eg = (u.pn - 8) * 256 + bj * 128 + offc, head = eg >> 9, e = eg & 511;
                        bf16_t* vt = g ? VT + (size_t)MP * 2048 + ((size_t)(b * 4 + head) * 512 + e) * 64 + t : VT + ((size_t)(b * 4 + head) * 512 + e) * 2048 + t;
                        const f32x4 v0 = acc[ai][bj][m][0], v1 = acc[ai][bj][m][1];
#pragma unroll
                        for (int i = 0; i < 4; ++i) { vt[(size_t)i * T] = (bf16_t)f2bf(v0[i]); vt[(size_t)(4 + i) * T] = (bf16_t)f2bf(v1[i]); }
                    }
                }
        } else {
#pragma unroll
            for (int ai = 0; ai < 2; ++ai)
#pragma unroll
                for (int m = 0; m < 4; ++m)
#pragma unroll
                    for (int bj = 0; bj < 2; ++bj) {
                        const f32x4 v0 = acc[ai][bj][m][0], v1 = acc[ai][bj][m][1];
                        u32x4 w; w.x = pk2(v0[0], v0[1]); w.y = pk2(v0[2], v0[3]); w.z = pk2(v1[0], v1[1]); w.w = pk2(v1[2], v1[3]);
                        *(u32x4*)(GG + (size_t)(row0 + ai * 128 + m * 16) * 2048 + (u.pn - 16) * 256 + bj * 128 + offc) = w;
                    }
        }
    }
};

DI void tr_item(const float* in, size_t ldi, bf16_t* out, size_t ldo, int k0, int n0, int drow0, LAS float* scr, int lane) {
#pragma unroll 8
    for (int i = 0; i < 32; ++i) { const int kk = 2 * i + (lane >> 5); scr[kk * 33 + (lane & 31)] = in[(size_t)(k0 + kk) * ldi + n0 + (lane & 31)]; }
    WAVE_LDS_SYNC();
    const int c = lane & 7;
#pragma unroll
    for (int jj = 0; jj < 4; ++jj) { const int n = (lane >> 3) + 8 * jj; const LAS float* s = scr + (8 * c) * 33 + n;
        u32x4 o; o.x = pk2(s[0 * 33], s[1 * 33]); o.y = pk2(s[2 * 33], s[3 * 33]); o.z = pk2(s[4 * 33], s[5 * 33]); o.w = pk2(s[6 * 33], s[7 * 33]);
        *(u32x4*)(out + (size_t)(drow0 + n) * ldo + k0 + 8 * c) = o; }
    WAVE_LDS_SYNC();
}
DI void tr_plain(const float* W, int K, int N, bf16_t* WT, int it, LAS float* scr, int lane) {
    const int nblk = N / 32, kb = it / nblk, nb = it % nblk;
    tr_item(W, (size_t)N, WT, (size_t)K, kb * 64, nb * 32, nb * 32, scr, lane);
}

DI void prologue_phase(const KArgs& a, LAS unsigned char* lds, int vcu, int G, int tid, int wave, int lane) {
    unsigned char* ws = a.ws;
    LAS float* scr = (LAS float*)(lds + wave * 8704);
    const int gw = vcu * 8 + wave, NGW = G * 8;
    if (blockIdx.x == 0 && tid < 64) ((unsigned*)(ws + WS_CTL))[tid * 64] = 0u;
    constexpr int I_FFN = 1408, N_FFN = 8 * 3 * I_FFN;
    constexpr int I_PG = 512, I_PI = 128, I_ABI = 1280, I_ABO = 512, I_CI = 3072, I_CO = 1024, I_CV = 64;
    constexpr int E0 = N_FFN, E1 = E0 + 4 * I_PG, E2 = E1 + 4 * I_PI, E3 = E2 + 2 * I_ABI, E4 = E3 + 2 * I_ABO, E5 = E4 + 2 * I_CI, E6 = E5 + 2 * I_CO, E7 = E6 + 128 * I_CV;
    for (int it = gw; it < E7; it += NGW) {
        if (it < E0) {
            const int mf = it / (3 * I_FFN), r = it % (3 * I_FFN), kind = r / I_FFN, q = r % I_FFN;
            if (kind < 2) {
                const float* W = a.in[10 + kind] + (size_t)mf * 1024 * FF;
                const int kb = q / 88, nb = q % 88, n0 = nb * 32;
                tr_item(W, FF, (bf16_t*)(ws + WS_WGU + (size_t)mf * SZ_WGU1), 1024, kb * 64, n0, (n0 >> 7) * 256 + kind * 128 + (n0 & 127), scr, lane);
            } else {
                tr_plain(a.in[12] + (size_t)mf * FF * 1024, FF, 1024, (bf16_t*)(ws + WS_WDN + (size_t)mf * SZ_WDN1), q, scr, lane);
            }
        } else if (it < E1) { const int q = it - E0, l = q / I_PG; tr_plain(a.in[14] + (size_t)l * 1024 * 1024, 1024, 1024, (bf16_t*)(ws + WS_WPG + (size_t)l * SZ_W1K), q % I_PG, scr, lane); }
        else if (it < E2) { const int q = it - E1, l = q / I_PI; tr_plain(a.in[13] + (size_t)l * 256 * 1024, 256, 1024, (bf16_t*)(ws + WS_WPI + (size_t)l * SZ_WPI1), q % I_PI, scr, lane); }
        else if (it < E3) { const int q = it - E2, l = q / I_ABI; tr_plain(a.in[15] + (size_t)l * 1024 * 2560, 1024, 2560, (bf16_t*)(ws + WS_WABI + (size_t)l * SZ_WABI1), q % I_ABI, scr, lane); }
        else if (it < E4) { const int q = it - E3, l = q / I_ABO; tr_plain(a.in[16] + (size_t)l * 1024 * 1024, 1024, 1024, (bf16_t*)(ws + WS_WABO + (size_t)l * SZ_W1K), q % I_ABO, scr, lane); }
        else if (it < E5) { const int q = it - E4, l = q / I_CI; tr_plain(a.in[24] + (size_t)l * 1024 * 6144, 1024, 6144, (bf16_t*)(ws + WS_WCI + (size_t)l * SZ_WCI1), q % I_CI, scr, lane); }
        else if (it < E6) { const int q = it - E5, l = q / I_CO; tr_plain(a.in[25] + (size_t)l * 2048 * 1024, 2048, 1024, (bf16_t*)(ws + WS_WCO + (size_t)l * SZ_WCO1), q % I_CO, scr, lane); }
        else {
            const int q = it - E6, jbh = q / I_CV, r = q % I_CV, jb = jbh >> 3, h = jbh & 7, kb = r >> 1, nb = r & 1;
            tr_item(a.in[7] + (size_t)jb * 2048 * 512 + h * 64, 512, (bf16_t*)(ws + WS_VTS) + (size_t)jbh * 64 * 2112, 2112, kb * 64, nb * 32, nb * 32, scr, lane);
        }
    }
    const int gt = vcu * NTHR + tid, NGT = G * NTHR;
    for (int it = gt; it < 2 * 8 * 2048 * 64; it += NGT) {
        const int d8 = it & 7, h = (it >> 3) & 7, t = (it >> 6) & 2047, jb = it >> 17;
        const float* s = a.in[6] + ((size_t)(jb * 2048 + t) * 512 + h * 64 + d8 * 8);
        const f32x4 v0 = *(const f32x4*)s, v1 = *(const f32x4*)(s + 4);
        u32x4 w; w.x = pk2(v0[0], v0[1]); w.y = pk2(v0[2], v0[3]); w.z = pk2(v1[0], v1[1]); w.w = pk2(v1[2], v1[3]);
        *(u32x4*)((bf16_t*)(ws + WS_KBS) + ((size_t)(jb * 8 + h) * 2112 + t) * 64 + d8 * 8) = w;
    }
    for (int it = gt; it < 2112 * 128; it += NGT) {
        const int pos = it >> 7, jf = it & 127;
        const float freq = exp2f(-(float)jf * (13.287712379549449f / 128.f));
        const float ang = (float)pos * freq;
        const double rev = (double)ang * 0.15915494309189535; const float fr = (float)(rev - floor(rev));
        ((float*)(ws + WS_TAB))[it] = __builtin_amdgcn_cosf(fr); ((float*)(ws + WS_TAB + SZ_TAB1))[it] = __builtin_amdgcn_sinf(fr);
    }
}
DI void pconv_phase(const KArgs& a, int l, int gt, int NGT) {
    bf16_t* PB = (bf16_t*)(a.ws + WS_PB);
    for (int it = gt; it < M * 32; it += NGT) {
        const int r = it >> 5, c8 = (it & 31) * 8;
        const float* s = (r < MP) ? a.in[2] + ((size_t)l * MP + r) * 256 + c8 : a.in[3] + ((size_t)l * 512 + (r - MP)) * 256 + c8;
        const f32x4 v0 = *(const f32x4*)s, v1 = *(const f32x4*)(s + 4);
        u32x4 w; w.x = pk2(v0[0], v0[1]); w.y = pk2(v0[2], v0[3]); w.z = pk2(v1[0], v1[1]); w.w = pk2(v1[2], v1[3]);
        *(u32x4*)(PB + (size_t)r * 256 + c8) = w;
    }
}
DI void rowwise_phase(const KArgs& a, const bf16_t* Y, const float* ga, float c, const float* gb, int gw, int NGW, int lane) {
    float* X = a.out; bf16_t* H = (bf16_t*)(a.ws + WS_H);
    for (int r = gw; r < M; r += NGW) {
        f32x4 x[4]; float ss = 0.f;
        if (Y) {
            f32x4 y[4];
#pragma unroll
            for (int q = 0; q < 4; ++q) { const int col = 4 * lane + 256 * q; const u32x2 w = *(const u32x2*)(Y + (size_t)r * 1024 + col);
                y[q] = (f32x4){bflo(w.x), bfhi(w.x), bflo(w.y), bfhi(w.y)}; x[q] = *(const f32x4*)(X + (size_t)r * 1024 + col);
                ss += (y[q][0] * y[q][0] + y[q][1] * y[q][1]) + (y[q][2] * y[q][2] + y[q][3] * y[q][3]); }
            const float rs = c * rsqrtf(wave_sum(ss, lane) * (1.f / 1024.f) + EPS);
#pragma unroll
            for (int q = 0; q < 4; ++q) { const int col = 4 * lane + 256 * q; const f32x4 g = *(const f32x4*)(ga + col); x[q] = x[q] + y[q] * g * rs; *(f32x4*)(X + (size_t)r * 1024 + col) = x[q]; }
        } else {
            const float* src = (r < MP) ? a.in[0] + (size_t)r * 1024 : a.in[1] + (size_t)(r - MP) * 1024;
#pragma unroll
            for (int q = 0; q < 4; ++q) { const int col = 4 * lane + 256 * q; x[q] = *(const f32x4*)(src + col); *(f32x4*)(X + (size_t)r * 1024 + col) = x[q]; }
        }
        if (gb) {
            float s2 = 0.f;
#pragma unroll
            for (int q = 0; q < 4; ++q) s2 += (x[q][0] * x[q][0] + x[q][1] * x[q][1]) + (x[q][2] * x[q][2] + x[q][3] * x[q][3]);
            const float rs2 = rsqrtf(wave_sum(s2, lane) * (1.f / 1024.f) + EPS);
#pragma unroll
            for (int q = 0; q < 4; ++q) { const int col = 4 * lane + 256 * q; const f32x4 g = *(const f32x4*)(gb + col); const f32x4 h = x[q] * g * rs2;
                u32x2 w; w.x = pk2(h[0], h[1]); w.y = pk2(h[2], h[3]); *(u32x2*)(H + (size_t)r * 1024 + col) = w; }
        }
    }
}
DI float lru_ldx(const bf16_t* XAQ, const float* cst, int g, int L, int rowbase, int ch, int t) {
    if (t >= 0) return (t < L) ? bf1(XAQ[(size_t)(rowbase + t) * 1536 + ch]) : 0.f;
    return g ? cst[(size_t)(3 + t) * 512] : 0.f;
}
DI void lru_unit(const KArgs& a, int j, int g, int b, int hb, LAS unsigned char* lds, int tid, int wave, int lane) {
    const bf16_t* XAQ = (const bf16_t*)(a.ws + WS_XAQ); bf16_t* MIX = (bf16_t*)(a.ws + WS_MIXE);
    const int L = g ? 64 : 2048, rowbase = g ? MP + b * 64 : b * 2048;
    LAS float* XC = (LAS float*)lds;
    LAS float* AA = XC + 128 * 65;
    LAS float* UU = AA + 128 * 64;
    LAS float* SEG = UU + 128 * 64;
    const int c = tid & 63, seg = tid >> 6, ch = hb * 64 + c;
    const float* cw = a.in[17] + (size_t)j * 4 * 512 + ch;
    const float w0 = cw[0], w1 = cw[512], w2 = cw[1024], w3 = cw[1536], cb = a.in[18][j * 512 + ch];
    const int tb = wave >> 1, chh = wave & 1, hh = lane >> 5, oc = chh * 32 + (lane & 31);
    bf16x8 Wr[4], Wi[4];
    {
        const float* wr_ = a.in[19] + ((size_t)(j * 8 + hb) * 64) * 64 + oc; const float* wi_ = a.in[21] + ((size_t)(j * 8 + hb) * 64) * 64 + oc;
#pragma unroll
        for (int ks = 0; ks < 4; ++ks)
#pragma unroll
            for (int e = 0; e < 8; ++e) { const int i = 16 * ks + 8 * hh + e; Wr[ks][e] = (short)f2bf(wr_[(size_t)i * 64]); Wi[ks][e] = (short)f2bf(wi_[(size_t)i * 64]); }
    }
    const float br = a.in[20][j * 512 + hb * 64 + oc], bi = a.in[22][j * 512 + hb * 64 + oc];
    const float lam = a.in[23][j * 512 + hb * 64 + oc];
    const float spl = (lam > 0.f ? 0.f : -lam) + log1pf(__expf(-fabsf(lam)));
    float carry = g ? a.in[4][(size_t)(j * 8 + b) * 512 + ch] : 0.f;
    const float* cst = a.in[5] + (size_t)(j * 8 + b) * 3 * 512 + ch;
    const int nchunk = (L + 127) / 128;
    for (int ck = 0; ck < nchunk; ++ck) {
        const int t0 = ck * 128;
        {
            float xm3, xm2, xm1;
            const int ts = t0 + 16 * seg;
#define ldx(t_) lru_ldx(XAQ, cst, g, L, rowbase, ch, (t_))
            xm3 = ldx(ts - 3); xm2 = ldx(ts - 2); xm1 = ldx(ts - 1);
#pragma unroll 4
            for (int q = 0; q < 16; ++q) { const float x0 = ldx(ts + q); XC[(16 * seg + q) * 65 + c] = cb + w0 * xm3 + w1 * xm2 + w2 * xm1 + w3 * x0; xm3 = xm2; xm2 = xm1; xm1 = x0; }
#undef ldx
        }
        __syncthreads();
        {
            f32x16 ar, ai;
#pragma unroll
            for (int i = 0; i < 16; ++i) { ar[i] = 0.f; ai[i] = 0.f; }
            const int tokA = 32 * tb + (lane & 31);
#pragma unroll
            for (int ks = 0; ks < 4; ++ks) {
                bf16x8 A; const LAS float* s = XC + tokA * 65 + 16 * ks + 8 * hh;
#pragma unroll
                for (int e = 0; e < 8; ++e) A[e] = (short)f2bf(s[e]);
                ar = MFMA32(A, Wr[ks], ar); ai = MFMA32(A, Wi[ks], ai);
            }
#pragma unroll
            for (int i = 0; i < 16; ++i) {
                const int tl = 32 * tb + crow(i, hh);
                const float rg = sigmoidf_(ar[i] + br), ig = sigmoidf_(ai[i] + bi);
                const float la = -8.f * rg * spl;
                float av = __expf(la), uv = sqrtf(-expm1f(2.f * la)) * ig * XC[tl * 65 + oc];
                if (t0 + tl >= L) { av = 1.f; uv = 0.f; }
                AA[tl * 64 + oc] = av; UU[tl * 64 + oc] = uv;
            }
        }
        __syncthreads();
        {
            float A = 1.f, Hh = 0.f;
#pragma unroll 4
            for (int q = 0; q < 16; ++q) { const float av = AA[(16 * seg + q) * 64 + c], uv = UU[(16 * seg + q) * 64 + c]; Hh = av * Hh + uv; A *= av; }
            SEG[(seg * 64 + c) * 2] = A; SEG[(seg * 64 + c) * 2 + 1] = Hh;
        }
        __syncthreads();
        {
            float hin = carry;
            for (int s = 0; s < seg; ++s) hin = SEG[(s * 64 + c) * 2] * hin + SEG[(s * 64 + c) * 2 + 1];
            float hend = hin;
            for (int s = seg; s < 8; ++s) hend = SEG[(s * 64 + c) * 2] * hend + SEG[(s * 64 + c) * 2 + 1];
            carry = hend;
            float h = hin;
#pragma unroll 4
            for (int q = 0; q < 16; ++q) {
                const int tl = 16 * seg + q, t = t0 + tl;
                h = AA[tl * 64 + c] * h + UU[tl * 64 + c];
                if (t < L) {
                    const float gv = bf1(XAQ[(size_t)(rowbase + t) * 1536 + 512 + ch]);
                    const float gl = gv * sigmoidf_(1.5957691216057308f * (gv + 0.044715f * gv * gv * gv));
                    MIX[(size_t)(rowbase + t) * 1024 + ch] = (bf16_t)f2bf(gl * h);
                }
            }
        }
        __syncthreads();
    }
    if (seg == 0) {
        a.out[(g ? O_LRUH_S : O_LRUH_P) + (size_t)(j * 8 + b) * 512 + ch] = carry;
#pragma unroll
        for (int k = 0; k < 3; ++k) a.out[(g ? O_CONV_S : O_CONV_P) + ((size_t)(j * 8 + b) * 3 + k) * 512 + ch] = bf1(XAQ[(size_t)(rowbase + L - 3 + k) * 1536 + ch]);
    }
}
DI void sb_task(const KArgs& a, int j, int task, int lane) {
    int g, b, h, qb;
    if (task < 128) { g = 1; b = task >> 4; h = (task >> 1) & 7; qb = task & 1; }
    else { const int q = task - 128; g = 0; b = q >> 9; h = (q >> 6) & 7; qb = 63 - (q & 63); }
    const int P = g ? 2048 : 0, T = g ? 2112 : 2048, rowbase = g ? MP + b * 64 : b * 2048;
    const bf16_t* XAQ = (const bf16_t*)(a.ws + WS_XAQ); bf16_t* MIX = (bf16_t*)(a.ws + WS_MIXE);
    const bf16_t* Kb = g ? (const bf16_t*)(a.ws + WS_KBS) + (size_t)j * (SZ_KBS1 / 2) + (size_t)(b * 8 + h) * 2112 * 64 : (const bf16_t*)(a.ws + WS_KBP) + (size_t)(b * 8 + h) * 2048 * 64;
    const bf16_t* Vt = g ? (const bf16_t*)(a.ws + WS_VTS) + (size_t)j * (SZ_KBS1 / 2) + (size_t)(b * 8 + h) * 64 * 2112 : (const bf16_t*)(a.ws + WS_VTP) + (size_t)(b * 8 + h) * 64 * 2048;
    const int ql = lane & 31, hh = lane >> 5;
    const int rq = rowbase + 32 * qb + ql, tabs = P + 32 * qb + ql;
    bf16x8 qf[4];
#pragma unroll
    for (int ks = 0; ks < 4; ++ks) qf[ks] = *(const bf16x8*)(XAQ + (size_t)rq * 1536 + 1024 + h * 64 + 16 * ks + 8 * hh);
    f32x16 o0, o1;
#pragma unroll
    for (int i = 0; i < 16; ++i) { o0[i] = 0.f; o1[i] = 0.f; }
    float carry = 0.f;
    int kb = (P >> 5) + qb;
    bf16x8 kf[4];
#pragma unroll
    for (int ks = 0; ks < 4; ++ks) kf[ks] = *(const bf16x8*)(Kb + (size_t)(32 * kb + ql) * 64 + 16 * ks + 8 * hh);
    for (; kb >= 0; --kb) {
        u32x2 va[2][2][2];
#pragma unroll
        for (int dh = 0; dh < 2; ++dh)
#pragma unroll
            for (int s = 0; s < 2; ++s) { const bf16_t* p = Vt + (size_t)(32 * dh + ql) * T + 32 * kb + 16 * s + 4 * hh; va[dh][s][0] = *(const u32x2*)p; va[dh][s][1] = *(const u32x2*)(p + 8); }
        bf16x8 kn[4];
        if (kb > 0) {
#pragma unroll
            for (int ks = 0; ks < 4; ++ks) kn[ks] = *(const bf16x8*)(Kb + (size_t)(32 * (kb - 1) + ql) * 64 + 16 * ks + 8 * hh);
        } else {
#pragma unroll
            for (int ks = 0; ks < 4; ++ks) kn[ks] = kf[ks];
        }
        f32x16 st;
#pragma unroll
        for (int i = 0; i < 16; ++i) st[i] = 0.f;
#pragma unroll
        for (int ks = 0; ks < 4; ++ks) st = MFMA32(kf[ks], qf[ks], st);
        float z[16], lb[16];
#pragma unroll
        for (int i = 0; i < 16; ++i) {
            z[i] = st[i] * 0.125f;
            const float sp = fmaxf(z[i], 0.f) + __logf(1.f + __expf(-fabsf(z[i])));
            const bool ok = (32 * kb + crow(i, hh)) < tabs;
            lb[i] = ok ? -sp : 0.f;
        }
        float G[4], Gx[4];
#pragma unroll
        for (int q = 0; q < 4; ++q) { G[q] = (lb[4 * q] + lb[4 * q + 1]) + (lb[4 * q + 2] + lb[4 * q + 3]); Gx[q] = lane_xor(G[q], lane, 32); }
        float pv[16];
        float suf = carry;
#pragma unroll
        for (int q = 3; q >= 0; --q) {
            float tl = suf + (hh == 0 ? Gx[q] : 0.f);
#pragma unroll
            for (int ii = 3; ii >= 0; --ii) {
                const int i = 4 * q + ii;
                const bool ok = (32 * kb + crow(i, hh)) < tabs;
                pv[i] = ok ? __expf(z[i] + lb[i] + tl) : 0.f;
                tl += lb[i];
            }
            suf += G[q] + Gx[q];
        }
        carry = suf;
        bf16x8 pb[2];
#pragma unroll
        for (int s = 0; s < 2; ++s) {
            u32x4 w; w.x = pk2(pv[8 * s], pv[8 * s + 1]); w.y = pk2(pv[8 * s + 2], pv[8 * s + 3]); w.z = pk2(pv[8 * s + 4], pv[8 * s + 5]); w.w = pk2(pv[8 * s + 6], pv[8 * s + 7]);
            pb[s] = __builtin_bit_cast(bf16x8, w);
        }
#pragma unroll
        for (int s = 0; s < 2; ++s) {
            u32x4 w0; w0.x = va[0][s][0].x; w0.y = va[0][s][0].y; w0.z = va[0][s][1].x; w0.w = va[0][s][1].y;
            u32x4 w1; w1.x = va[1][s][0].x; w1.y = va[1][s][0].y; w1.z = va[1][s][1].x; w1.w = va[1][s][1].y;
            o0 = MFMA32(__builtin_bit_cast(bf16x8, w0), pb[s], o0);
            o1 = MFMA32(__builtin_bit_cast(bf16x8, w1), pb[s], o1);
        }
#pragma unroll
        for (int ks = 0; ks < 4; ++ks) kf[ks] = kn[ks];
        if (__all(carry < -104.f)) break;
    }
#pragma unroll
    for (int q = 0; q < 4; ++q) {
        u32x2 w; w.x = pk2(o0[4 * q], o0[4 * q + 1]); w.y = pk2(o0[4 * q + 2], o0[4 * q + 3]);
        *(u32x2*)(MIX + (size_t)rq * 1024 + 512 + h * 64 + 8 * q + 4 * hh) = w;
        w.x = pk2(o1[4 * q], o1[4 * q + 1]); w.y = pk2(o1[4 * q + 2], o1[4 * q + 3]);
        *(u32x2*)(MIX + (size_t)rq * 1024 + 512 + h * 64 + 32 + 8 * q + 4 * hh) = w;
    }
}

DI void ret_unit(const KArgs& a, int j, int g, int b, int h, int es, LAS unsigned char* lds, int wave, int lane) {
    const int L = g ? 64 : 2048, rowbase = g ? MP + b * 64 : b * 2048, nch = L >> 6;
    const bf16_t* VT = (const bf16_t*)(a.ws + WS_VT) + (g ? (size_t)MP * 2048 + ((size_t)(b * 4 + h) * 512 + es * 64) * 64 : ((size_t)(b * 4 + h) * 512 + es * 64) * 2048);
    const float lg2 = log2f(1.f - exp2f(-5.f - (float)h));
    const int l31 = lane & 31, hh = lane >> 5, w4 = wave & 3;
    constexpr int RTS = 264;
    LAS bf16_t* RT = (LAS bf16_t*)lds;
    if (wave < 4) {
        const bf16_t* QR = (const bf16_t*)(a.ws + WS_QR); const bf16_t* KR = (const bf16_t*)(a.ws + WS_KR); bf16_t* OB = (bf16_t*)(a.ws + WS_OB);
        const int et = w4 & 1, lt = w4 >> 1;
        const float xi = exp2f(lg2 * (float)(32 * lt + l31 + 1));
        __syncthreads();
        int buf = 0;
        for (int c = 0; c < nch; ++c) {
            const int t0 = c * 64;
            const int rl = rowbase + t0 + 32 * lt + l31;
            f32x16 st0, st1, oc, oi;
#pragma unroll
            for (int i = 0; i < 16; ++i) { st0[i] = 0.f; st1[i] = 0.f; oc[i] = 0.f; oi[i] = 0.f; }
            const bf16_t* qp = QR + (size_t)rl * 1024 + h * 256 + 8 * hh;
            const bf16_t* kp = KR + (size_t)(rowbase + t0 + l31) * 1024 + h * 256 + 8 * hh;
            const LAS bf16_t* rp = RT + buf * (64 * RTS) + (32 * et + l31) * RTS + 8 * hh;
#pragma unroll 2
            for (int ks = 0; ks < 16; ++ks) {
                const bf16x8 qf = *(const bf16x8*)(qp + 16 * ks);
                const bf16x8 k0 = *(const bf16x8*)(kp + 16 * ks), k1 = *(const bf16x8*)(kp + 32 * 1024 + 16 * ks);
                const bf16x8 rf = *(const LAS bf16x8*)(rp + 16 * ks);
                st0 = MFMA32(k0, qf, st0); st1 = MFMA32(k1, qf, st1);
                oc = MFMA32(rf, qf, oc);
            }
#pragma unroll
            for (int mt = 0; mt < 2; ++mt) {
                float p[16];
#pragma unroll
                for (int i = 0; i < 16; ++i) { const int mm = 32 * mt + crow(i, hh), ll = 32 * lt + l31; const float dd = (float)(mm > ll ? mm - ll : ll - mm); p[i] = (mt ? st1[i] : st0[i]) * exp2f(lg2 * dd); }
#pragma unroll
                for (int s = 0; s < 2; ++s) {
                    u32x4 w; w.x = pk2(p[8 * s], p[8 * s + 1]); w.y = pk2(p[8 * s + 2], p[8 * s + 3]); w.z = pk2(p[8 * s + 4], p[8 * s + 5]); w.w = pk2(p[8 * s + 6], p[8 * s + 7]);
                    const bf16_t* vp = VT + (size_t)(32 * et + l31) * L + t0 + 32 * mt + 16 * s + 4 * hh;
                    const u32x2 v0 = *(const u32x2*)vp, v1 = *(const u32x2*)(vp + 8);
                    u32x4 va; va.x = v0.x; va.y = v0.y; va.z = v1.x; va.w = v1.y;
                    oi = MFMA32(__builtin_bit_cast(bf16x8, va), __builtin_bit_cast(bf16x8, w), oi);
                }
            }
#pragma unroll
            for (int q = 0; q < 4; ++q) {
                u32x2 w; w.x = pk2(oi[4 * q] + xi * oc[4 * q], oi[4 * q + 1] + xi * oc[4 * q + 1]); w.y = pk2(oi[4 * q + 2] + xi * oc[4 * q + 2], oi[4 * q + 3] + xi * oc[4 * q + 3]);
                *(u32x2*)(OB + (size_t)rl * 2048 + h * 512 + es * 64 + 32 * et + 8 * q + 4 * hh) = w;
            }
            __syncthreads();
            buf ^= 1;
        }
        __syncthreads();
    } else {
        const bf16_t* KT = (const bf16_t*)(a.ws + WS_KT) + (g ? (size_t)MP * 1024 + (size_t)(b * 4 + h) * 256 * 64 : (size_t)(b * 4 + h) * 256 * 2048);
        f32x16 R[2][2];
#pragma unroll
        for (int x = 0; x < 2; ++x)
#pragma unroll
            for (int y = 0; y < 2; ++y)
#pragma unroll
                for (int i = 0; i < 16; ++i) R[x][y][i] = 0.f;
        if (g) {
            const float* R0 = a.in[8] + ((size_t)((j * 8 + b) * 4 + h) * 256) * 512 + es * 64;
#pragma unroll
            for (int dti = 0; dti < 2; ++dti)
#pragma unroll
                for (int et = 0; et < 2; ++et)
#pragma unroll
                    for (int i = 0; i < 16; ++i) { R[dti][et][i] = R0[(size_t)(32 * (2 * w4 + dti) + crow(i, hh)) * 512 + 32 * et + l31]; if ((i & 3) == 3) asm volatile("" ::: "memory"); }
        }
#pragma unroll
        for (int dti = 0; dti < 2; ++dti)
#pragma unroll
            for (int et = 0; et < 2; ++et)
#pragma unroll
                for (int q = 0; q < 4; ++q) { u32x2 w; w.x = pk2(R[dti][et][4 * q], R[dti][et][4 * q + 1]); w.y = pk2(R[dti][et][4 * q + 2], R[dti][et][4 * q + 3]);
                    *(LAS u32x2*)(RT + (32 * et + l31) * RTS + 32 * (2 * w4 + dti) + 8 * q + 4 * hh) = w; }
        __syncthreads();
        const float g64 = exp2f(lg2 * 64.f);
        float z[8];
#pragma unroll
        for (int e = 0; e < 8; ++e) z[e] = exp2f(lg2 * (float)(63 - 8 * hh - e));
        const float ginv16 = exp2f(-16.f * lg2);
        int buf = 0;
        for (int c = 0; c < nch; ++c) {
            const int t0 = c * 64;
#pragma unroll
            for (int dti = 0; dti < 2; ++dti)
#pragma unroll
                for (int et = 0; et < 2; ++et)
#pragma unroll
                    for (int i = 0; i < 16; ++i) R[dti][et][i] *= g64;
            float zs = 1.f;
#pragma unroll
            for (int s = 0; s < 4; ++s) {
                const bf16x8 vb0 = *(const bf16x8*)(VT + (size_t)l31 * L + t0 + 16 * s + 8 * hh), vb1 = *(const bf16x8*)(VT + (size_t)(32 + l31) * L + t0 + 16 * s + 8 * hh);
#pragma unroll
                for (int dti = 0; dti < 2; ++dti) {
                    const u32x4 kw = *(const u32x4*)(KT + (size_t)(32 * (2 * w4 + dti) + l31) * L + t0 + 16 * s + 8 * hh);
                    u32x4 ks_; ks_.x = pk2(bflo(kw.x) * (z[0] * zs), bfhi(kw.x) * (z[1] * zs)); ks_.y = pk2(bflo(kw.y) * (z[2] * zs), bfhi(kw.y) * (z[3] * zs));
                    ks_.z = pk2(bflo(kw.z) * (z[4] * zs), bfhi(kw.z) * (z[5] * zs)); ks_.w = pk2(bflo(kw.w) * (z[6] * zs), bfhi(kw.w) * (z[7] * zs));
                    const bf16x8 ka = __builtin_bit_cast(bf16x8, ks_);
                    R[dti][0] = MFMA32(ka, vb0, R[dti][0]); R[dti][1] = MFMA32(ka, vb1, R[dti][1]);
                }
                zs *= ginv16;
            }
#pragma unroll
            for (int dti = 0; dti < 2; ++dti)
#pragma unroll
                for (int et = 0; et < 2; ++et)
#pragma unroll
                    for (int q = 0; q < 4; ++q) { u32x2 w; w.x = pk2(R[dti][et][4 * q], R[dti][et][4 * q + 1]); w.y = pk2(R[dti][et][4 * q + 2], R[dti][et][4 * q + 3]);
                        *(LAS u32x2*)(RT + (buf ^ 1) * (64 * RTS) + (32 * et + l31) * RTS + 32 * (2 * w4 + dti) + 8 * q + 4 * hh) = w; }
            __syncthreads();
            buf ^= 1;
        }
        float* Rout = a.out + (g ? O_RET_S : O_RET_P) + ((size_t)((j * 8 + b) * 4 + h) * 256) * 512 + es * 64;
#pragma unroll
        for (int dti = 0; dti < 2; ++dti)
#pragma unroll
            for (int et = 0; et < 2; ++et)
#pragma unroll
                for (int i = 0; i < 16; ++i) { Rout[(size_t)(32 * (2 * w4 + dti) + crow(i, hh)) * 512 + 32 * et + l31] = R[dti][et][i]; if ((i & 3) == 3) asm volatile("" ::: "memory"); }
        __syncthreads();
    }
}
DI void gn_phase(const KArgs& a, int gw, int NGW, int lane) {
    bf16_t* OB = (bf16_t*)(a.ws + WS_OB); const bf16_t* GG = (const bf16_t*)(a.ws + WS_GG);
    for (int it = gw; it < M * 4; it += NGW) {
        const size_t off = (size_t)(it >> 2) * 2048 + (it & 3) * 512 + lane * 8;
        const u32x4 ow = *(const u32x4*)(OB + off), gwv = *(const u32x4*)(GG + off);
        float o[8] = {bflo(ow.x), bfhi(ow.x), bflo(ow.y), bfhi(ow.y), bflo(ow.z), bfhi(ow.z), bflo(ow.w), bfhi(ow.w)};
        const float gg[8] = {bflo(gwv.x), bfhi(gwv.x), bflo(gwv.y), bfhi(gwv.y), bflo(gwv.z), bfhi(gwv.z), bflo(gwv.w), bfhi(gwv.w)};
        float s = 0.f;
#pragma unroll
        for (int e = 0; e < 8; ++e) s += o[e];
        const float mu = wave_sum(s, lane) * (1.f / 512.f);
        float v = 0.f;
#pragma unroll
        for (int e = 0; e < 8; ++e) { o[e] -= mu; v += o[e] * o[e]; }
        const float rstd = rsqrtf(wave_sum(v, lane) * (1.f / 512.f) + EPS);
        float y[8];
#pragma unroll
        for (int e = 0; e < 8; ++e) y[e] = gg[e] * sigmoidf_(gg[e]) * o[e] * rstd;
        u32x4 w; w.x = pk2(y[0], y[1]); w.y = pk2(y[2], y[3]); w.z = pk2(y[4], y[5]); w.w = pk2(y[6], y[7]);
        *(u32x4*)(OB + off) = w;
    }
}

__global__ void __launch_bounds__(NTHR, 2) hybrid_fwd(const KArgs a) {
    extern __shared__ __attribute__((aligned(16))) unsigned char lds_raw[];
    cg::grid_group grid = cg::this_grid();
    LAS unsigned char* lds = (LAS unsigned char*)lds_raw;
    const int G = gridDim.x, bx = blockIdx.x;
    const int vcu = (G % 8 == 0) ? (bx % 8) * (G / 8) + bx / 8 : bx;
    const int NGW = G * 8, NGT = G * NTHR;

    {
        const int tid = threadIdx.x, lane = tid & 63, wave = __builtin_amdgcn_readfirstlane(tid >> 6);
        prologue_phase(a, lds, vcu, G, tid, wave, lane);
        rowwise_phase(a, nullptr, nullptr, 0.f, a.in[9], vcu * 8 + wave, NGW, lane);
    }
    grid.sync();

    const KArgs a0 = a;
    for (int step = 0; step < 20; ++step) {
        KArgs a = a0;
        asm volatile("" : "+s"(a.ws), "+s"(a.out));
        unsigned char* ws = a.ws; const float* normg = a.in[9];
        int tid, lane, wave, gw, gt, bxs;
#define LAUNDER() do { tid = threadIdx.x; bxs = bx; asm volatile("" : "+v"(tid), "+s"(bxs)); lane = tid & 63; wave = __builtin_amdgcn_readfirstlane(tid >> 6); gw = vcu * 8 + wave; gt = vcu * NTHR + tid; } while (0)
        LAUNDER();
        const int i = step / 5, sb = step % 5, j = i >> 1;
        const bool odd = (i & 1) != 0;
        const bf16_t* yA = nullptr; const bf16_t* yB = nullptr; int yK = 0; const bf16_t* yPE = nullptr; bf16_t* yO = (bf16_t*)(ws + WS_Y);
        if (sb == 0 || sb == 2) {
            const int mf = i * 2 + (sb >> 1);
            {
                pg8::Gemm gm{(const bf16_t*)(ws + WS_H), (const bf16_t*)(ws + WS_WGU + (size_t)mf * SZ_WGU1), M, 5632, 1024};
                pg8::StaticOrder S; S.init(M, 5632, G, bxs);
                EpiSwiGLU E{(bf16_t*)(ws + WS_ACT)};
                pg8::gemm_phase<EpiSwiGLU, pg8::StaticOrder, true, true>(lds, gm, S, E);
            }
            grid.sync(); LAUNDER();
            yA = (const bf16_t*)(ws + WS_ACT); yB = (const bf16_t*)(ws + WS_WDN + (size_t)mf * SZ_WDN1); yK = FF;
        } else if (sb == 1) {
            if (!odd) {
                {
                    pg8::Gemm gm{(const bf16_t*)(ws + WS_H), (const bf16_t*)(ws + WS_WABI + (size_t)j * SZ_WABI1), M, 2560, 1024};
                    pg8::StaticOrder S; S.init(M, 2560, G, bxs);
                    EpiAB E{(bf16_t*)(ws + WS_XAQ), (bf16_t*)(ws + WS_KBP), (bf16_t*)(ws + WS_VTP), (bf16_t*)(ws + WS_KBS + (size_t)j * SZ_KBS1), (bf16_t*)(ws + WS_VTS + (size_t)j * SZ_KBS1), a.out, j};
                    pg8::gemm_phase<EpiAB, pg8::StaticOrder, true, true>(lds, gm, S, E);
                }
                grid.sync(); LAUNDER();
                for (int u = vcu; u < 128; u += G) { const int g = u >> 6, q = u & 63; lru_unit(a, j, g, q >> 3, q & 7, lds, tid, wave, lane); }
                {
                    unsigned* ctr = (unsigned*)(ws + WS_CTL) + 64 * j;
                    for (;;) {
                        unsigned t = 0; if (lane == 0) t = atomicAdd(ctr, 1u);
                        t = __builtin_amdgcn_readfirstlane(t);
                        if (t >= 128u + 4096u) break;
                        sb_task(a, j, (int)t, lane);
                    }
                }
                grid.sync(); LAUNDER();
                yA = (const bf16_t*)(ws + WS_MIXE); yB = (const bf16_t*)(ws + WS_WABO + (size_t)j * SZ_W1K); yK = 1024;
            } else {
                {
                    pg8::Gemm gm{(const bf16_t*)(ws + WS_H), (const bf16_t*)(ws + WS_WCI + (size_t)j * SZ_WCI1), M, 6144, 1024};
                    pg8::StaticOrder S; S.init(M, 6144, G, bxs);
                    EpiC E{(bf16_t*)(ws + WS_QR), (bf16_t*)(ws + WS_KR), (bf16_t*)(ws + WS_KT), (bf16_t*)(ws + WS_VT), (bf16_t*)(ws + WS_GG), (const float*)(ws + WS_TAB), (const float*)(ws + WS_TAB + SZ_TAB1)};
                    pg8::gemm_phase<EpiC, pg8::StaticOrder, true, true>(lds, gm, S, E);
                }
                grid.sync(); LAUNDER();
                for (int u = vcu; u < 512; u += G) { const int g = u >> 8, q = u & 255; ret_unit(a, j, g, q >> 5, (q >> 3) & 3, q & 7, lds, wave, lane); }
                grid.sync(); LAUNDER();
                gn_phase(a, gw, NGW, lane);
                grid.sync(); LAUNDER();
                yA = (const bf16_t*)(ws + WS_OB); yB = (const bf16_t*)(ws + WS_WCO + (size_t)j * SZ_WCO1); yK = 2048;
            }
        } else if (sb == 3) {
            yA = (const bf16_t*)(ws + WS_PB); yB = (const bf16_t*)(ws + WS_WPI + (size_t)i * SZ_WPI1); yK = 256; yO = (bf16_t*)(ws + WS_PE);
        } else {
            yA = (const bf16_t*)(ws + WS_H); yB = (const bf16_t*)(ws + WS_WPG + (size_t)i * SZ_W1K); yK = 1024; yPE = (const bf16_t*)(ws + WS_PE);
        }
        {
            pg8::Gemm gm{yA, yB, M, 1024, yK};
            pg8::StaticOrder S; S.init(M, 1024, G, bxs);
            EpiY E{yO, yPE};
            pg8::gemm_phase<EpiY, pg8::StaticOrder, true, true>(lds, gm, S, E);
        }
        grid.sync(); LAUNDER();
        if (sb != 3) {
            const int nidx = (sb == 4) ? 3 : sb;
            const float* ga = normg + (size_t)(i * 8 + 2 * nidx + 1) * 1024;
            const float* gb = (step == 19) ? nullptr : normg + (size_t)(i * 8 + 2 * nidx + 2) * 1024;
            rowwise_phase(a, (const bf16_t*)(ws + WS_Y), ga, (nidx & 1) ? 1.f : 0.5f, gb, gw, NGW, lane);
            if (sb == 2) pconv_phase(a, i, gt, NGT);
            if (step != 19) grid.sync(); LAUNDER();
        }
    }
}

extern "C" void kernel_launch(void* const* d_in, const int* in_sizes, int n_in, void* d_out, int out_size, void* d_ws, size_t ws_size, hipStream_t stream) {
    static int grid = 0;
    if (grid == 0) {
        int dev = 0, cus = 0, per_cu = 0;
        if (hipGetDevice(&dev) != hipSuccess || hipDeviceGetAttribute(&cus, hipDeviceAttributeMultiprocessorCount, dev) != hipSuccess) { grid = -1; return; }
        if (hipFuncSetAttribute((const void*)hybrid_fwd, hipFuncAttributeMaxDynamicSharedMemorySize, LDS_BYTES) != hipSuccess) { fprintf(stderr, "hipFuncSetAttribute failed\n"); grid = -1; return; }
        if (hipOccupancyMaxActiveBlocksPerMultiprocessor(&per_cu, (const void*)hybrid_fwd, NTHR, LDS_BYTES) != hipSuccess || per_cu < 1) fprintf(stderr, "occupancy query: %d\n", per_cu);
        (void)hipGetLastError();
        grid = cus;
        if (n_in != 26 || (size_t)out_size != O_END || ws_size < WS_END) { fprintf(stderr, "kernel_launch: unexpected sizes n_in %d out %d ws %zu (need %zu)\n", n_in, out_size, ws_size, (size_t)WS_END); grid = -1; return; }
    }
    if (grid < 0) return;
    KArgs a{};
    for (int i = 0; i < 26; ++i) a.in[i] = (const float*)d_in[i];
    a.out = (float*)d_out; a.ws = (unsigned char*)d_ws;
    void* args[] = {&a};
    hipError_t e = hipLaunchCooperativeKernel((void*)hybrid_fwd, dim3(grid), dim3(NTHR), args, LDS_BYTES, stream);
    if (e != hipSuccess) fprintf(stderr, "cooperative launch failed: %s (grid %d)\n", hipGetErrorString(e), grid);
}
```

```cpp
#include <hip/hip_runtime.h>
#include <hip/hip_cooperative_groups.h>
#include <cstdio>
#include <cstdint>
namespace cg = cooperative_groups;
namespace pg8 {
#define PG8_LAS __attribute__((address_space(3)))
typedef unsigned short bf16_t;
typedef short bf16x8 __attribute__((ext_vector_type(8)));
typedef float f32x4 __attribute__((ext_vector_type(4)));
typedef unsigned u32x4 __attribute__((ext_vector_type(4)));
constexpr int BM = 256, BK = 64, HALF = 128, HTB = HALF * BK * 2  , STAGE_BYTES = 8 * HTB, NXCD = 8, WGM = 8;

__host__ __device__ __forceinline__ int lds_byte(int r, int c) { const int st = (r >> 4) * 2 + (c >> 5), rr = r & 15, cc = c & 31, ob = rr * 64 + cc * 2; return st * 1024 + (ob ^ (((ob >> 9) & 1) << 5)); }
__host__ __device__ __forceinline__ void stage_rc(int b, int& R, int& C) { const int st = b / 1024, sb = b % 1024, swz = sb ^ (((sb >> 9) & 1) << 5); R = (st >> 1) * 16 + swz / 64; C = (st & 1) * 32 + (swz % 64) / 2; }
__host__ __device__ __forceinline__ int perm32(int rho) { const int n = rho >> 4, i = rho & 15; return 8 * (i >> 2) + 4 * n + (i & 3); }

struct Unit { int pm, pn; };
struct Gemm { const bf16_t* A; const bf16_t* Bt; int M, N, K; };

struct StaticOrder {
    int nM, nN, nwg, G, c;
    __host__ __device__ void init(int M, int N, int G_, int c_) { nM = M / BM; nN = N / BM; nwg = nM * nN; G = G_; c = c_; }
    __host__ __device__ bool next(int i, Unit& u) const {
        const long L = (long)i * G + c; if (L >= nwg) return false;
        int wgid = (int)L; { const int q = nwg / NXCD, r = nwg % NXCD, xcd = wgid % NXCD, off = wgid / NXCD; wgid = (xcd < r ? xcd * (q + 1) : r * (q + 1) + (xcd - r) * q) + off; }
        const int nig = WGM * nN, gid = wgid / nig, fm = gid * WGM, gsz = (nM - fm) < WGM ? (nM - fm) : WGM;
        u.pm = fm + ((wgid % nig) % gsz); u.pn = (wgid % nig) / gsz; return true;
    }
    __device__ __forceinline__ void a_ready(const Unit&) const {}
    __device__ __forceinline__ void done(const Unit&) const {}
};

__device__ __forceinline__ unsigned cvt_pk_bf16(float lo, float hi) { unsigned r; asm volatile("v_cvt_pk_bf16_f32 %0, %1, %2" : "=v"(r) : "v"(lo), "v"(hi)); return r; }
template <class Epi, class Sched, bool ALIGN_EPI = false, bool SP2 = false>
__device__ __forceinline__ void gemm_phase(PG8_LAS unsigned char* lds, const Gemm g, const Sched& S, const Epi& E) {
    int tid_l = threadIdx.x; asm volatile("" : "+v"(tid_l));
    const int tid = tid_l, wid = __builtin_amdgcn_readfirstlane(tid >> 6), lane = tid & 63, wr = wid >> 2, wc = wid & 3, fr = lane & 15, fq = lane >> 4;
    const int K = g.K, nt = K / BK;
    unsigned voffA[2], voffB[2];
#pragma unroll
    for (int i = 0; i < 2; ++i) { int R, C; stage_rc(tid * 16 + i * 8192, R, C); const int Rb = Epi::PERM ? ((R & ~31) + perm32(R & 31)) : R;
        voffA[i] = (unsigned)(R * K + C) * 2u; voffB[i] = (unsigned)(Rb * K + C) * 2u; }
    const size_t kstep = (size_t)(BK * 2);
    const size_t hstep = (size_t)HALF * K * 2;
    const size_t tstep = 2 * hstep;
    const unsigned ldsw = (unsigned)wid * 1024u;
    const int aoff = lds_byte(wr * 64 + fr, fq * 8), boff = lds_byte(wc * 32 + fr, fq * 8);
#define PG8_SA(b, h) (((b) * 2 + (h)) * HTB)
#define PG8_SB(b, h) ((4 + (b) * 2 + (h)) * HTB)
#define PG8_STAGE(bufoff, gbase, voff) do { _Pragma("unroll") for (int _i = 0; _i < 2; ++_i) \
        __builtin_amdgcn_global_load_lds((const unsigned*)((const char*)(gbase) + (voff)[_i]), (PG8_LAS unsigned*)(lds + (bufoff) + ldsw + _i * 8192), 16, 0, 0); } while (0)
#define PG8_LDA(dst, b, h) do { _Pragma("unroll") for (int m = 0; m < 4; ++m) _Pragma("unroll") for (int k = 0; k < 2; ++k) dst[m][k] = *(const PG8_LAS bf16x8*)(lds + PG8_SA(b, h) + aoff + m * 2048 + k * 1024); } while (0)
#define PG8_LDB(dst, b, h) do { _Pragma("unroll") for (int n = 0; n < 2; ++n) _Pragma("unroll") for (int k = 0; k < 2; ++k) dst[n][k] = *(const PG8_LAS bf16x8*)(lds + PG8_SB(b, h) + boff + n * 2048 + k * 1024); } while (0)
#define PG8_MMA(ai, bj, At, Bt) do { __builtin_amdgcn_s_setprio(1); _Pragma("unroll") for (int m = 0; m < 4; ++m) _Pragma("unroll") for (int n = 0; n < 2; ++n) _Pragma("unroll") for (int k = 0; k < 2; ++k) \
        acc[ai][bj][m][n] = __builtin_amdgcn_mfma_f32_16x16x32_bf16(Bt[n][k], At[m][k], acc[ai][bj][m][n], 0, 0, 0); __builtin_amdgcn_s_setprio(0); } while (0)
#define PG8_WAIT_V(n) asm volatile("s_waitcnt vmcnt(" #n ")" ::: "memory")
#define PG8_WAIT_L(n) asm volatile("s_waitcnt lgkmcnt(" #n ")" ::: "memory")
#define PG8_BAR __builtin_amdgcn_s_barrier()
#define PG8_SCHED __builtin_amdgcn_sched_barrier(0)
    Unit cur, nxt; int ui = 0;
    if (!S.next(0, cur)) return;
    f32x4 acc[2][2][4][2];
#pragma unroll
    for (int a = 0; a < 2; ++a)
#pragma unroll
        for (int b = 0; b < 2; ++b)
#pragma unroll
            for (int m = 0; m < 4; ++m)
#pragma unroll
                for (int n = 0; n < 2; ++n) acc[a][b][m][n] = (f32x4){0.f, 0.f, 0.f, 0.f};
    bf16x8 At[4][2], B0[2][2], B1[2][2];
    const char* cA = (const char*)g.A + (size_t)cur.pm * tstep; const char* cB = (const char*)g.Bt + (size_t)cur.pn * tstep;
    S.a_ready(cur);
    if constexpr (SP2) {
        PG8_STAGE(PG8_SB(0, 0), cB, voffB); PG8_STAGE(PG8_SB(0, 1), cB + hstep, voffB); PG8_STAGE(PG8_SA(0, 0), cA, voffA); PG8_STAGE(PG8_SA(0, 1), cA + hstep, voffA);
        if (wr == 1) PG8_BAR;
        PG8_WAIT_V(2); PG8_BAR;
        PG8_STAGE(PG8_SB(1, 0), cB + kstep, voffB); PG8_STAGE(PG8_SA(1, 0), cA + kstep, voffA); PG8_STAGE(PG8_SB(1, 1), cB + hstep + kstep, voffB);
        PG8_WAIT_V(6); PG8_BAR;
    } else {
        PG8_STAGE(PG8_SB(0, 0), cB, voffB); PG8_STAGE(PG8_SA(0, 0), cA, voffA); PG8_STAGE(PG8_SB(0, 1), cB + hstep, voffB); PG8_STAGE(PG8_SA(0, 1), cA + hstep, voffA);
        if (wr == 1) PG8_BAR;
        PG8_WAIT_V(4); PG8_BAR;
        PG8_STAGE(PG8_SB(1, 0), cB + kstep, voffB); PG8_STAGE(PG8_SA(1, 0), cA + kstep, voffA); PG8_STAGE(PG8_SB(1, 1), cB + hstep + kstep, voffB);
        PG8_WAIT_V(6); PG8_BAR;
    }
    for (;;) {
        const bool has_next = S.next(ui + 1, nxt);
        const char* nA = has_next ? (const char*)g.A + (size_t)nxt.pm * tstep : cA; const char* nB = has_next ? (const char*)g.Bt + (size_t)nxt.pn * tstep : cB;
        for (int t = 0; t < nt; t += 2) {
            const bool last = (t == nt - 2);
            const char* a1 = cA + (size_t)(t + 1) * kstep;
            const char* a2 = last ? nA : cA + (size_t)(t + 2) * kstep; const char* b2 = last ? nB : cB + (size_t)(t + 2) * kstep;
            const char* a3 = a2 + kstep; const char* b3 = b2 + kstep;
            if (last && has_next) S.a_ready(nxt);
            if constexpr (SP2) {
            PG8_LDB(B0, 0, 0); PG8_LDB(B1, 0, 1); PG8_SCHED; PG8_LDA(At, 0, 0); PG8_STAGE(PG8_SA(1, 1), a1 + hstep, voffA);
            PG8_WAIT_V(8); PG8_WAIT_L(0); PG8_BAR; PG8_MMA(0, 0, At, B0); PG8_MMA(0, 1, At, B1); PG8_BAR; PG8_SCHED;
            PG8_LDA(At, 0, 1); PG8_STAGE(PG8_SB(0, 0), b2, voffB); PG8_STAGE(PG8_SB(0, 1), b2 + hstep, voffB); PG8_STAGE(PG8_SA(0, 0), a2, voffA);
            PG8_WAIT_V(8); PG8_WAIT_L(0); PG8_BAR; PG8_MMA(1, 0, At, B0); PG8_MMA(1, 1, At, B1); PG8_BAR; PG8_SCHED;
            PG8_LDB(B0, 1, 0); PG8_LDB(B1, 1, 1); PG8_SCHED; PG8_LDA(At, 1, 0); PG8_STAGE(PG8_SA(0, 1), a2 + hstep, voffA);
            PG8_WAIT_V(8); PG8_WAIT_L(0); PG8_BAR; PG8_MMA(0, 0, At, B0); PG8_MMA(0, 1, At, B1); PG8_BAR; PG8_SCHED;
            PG8_LDA(At, 1, 1); PG8_STAGE(PG8_SB(1, 0), b3, voffB); PG8_STAGE(PG8_SB(1, 1), b3 + hstep, voffB); PG8_STAGE(PG8_SA(1, 0), a3, voffA);
            PG8_WAIT_V(8); PG8_WAIT_L(0); PG8_BAR; PG8_MMA(1, 0, At, B0); PG8_MMA(1, 1, At, B1); PG8_BAR; PG8_SCHED;
            } else {
            PG8_LDB(B0, 0, 0); PG8_SCHED; PG8_LDA(At, 0, 0); PG8_STAGE(PG8_SA(1, 1), a1 + hstep, voffA);
            PG8_WAIT_L(8); PG8_BAR; PG8_WAIT_L(0); PG8_MMA(0, 0, At, B0); PG8_BAR; PG8_SCHED;
            PG8_LDB(B1, 0, 1); PG8_STAGE(PG8_SB(0, 0), b2, voffB);
            PG8_BAR; PG8_WAIT_L(0); PG8_MMA(0, 1, At, B1); PG8_BAR;
            PG8_LDA(At, 0, 1); PG8_STAGE(PG8_SA(0, 0), a2, voffA);
            PG8_BAR; PG8_WAIT_L(0); PG8_MMA(1, 0, At, B0); PG8_BAR; PG8_SCHED;
            PG8_STAGE(PG8_SB(0, 1), b2 + hstep, voffB);
            PG8_WAIT_V(6); PG8_BAR; PG8_MMA(1, 1, At, B1); PG8_BAR;
            PG8_LDB(B0, 1, 0); PG8_SCHED; PG8_LDA(At, 1, 0); PG8_STAGE(PG8_SA(0, 1), a2 + hstep, voffA);
            PG8_WAIT_L(8); PG8_BAR; PG8_WAIT_L(0); PG8_MMA(0, 0, At, B0); PG8_BAR; PG8_SCHED;
            PG8_LDB(B1, 1, 1); PG8_STAGE(PG8_SB(1, 0), b3, voffB);
            PG8_BAR; PG8_WAIT_L(0); PG8_MMA(0, 1, At, B1); PG8_BAR;
            PG8_LDA(At, 1, 1); PG8_STAGE(PG8_SA(1, 0), a3, voffA);
            PG8_BAR; PG8_WAIT_L(0); PG8_MMA(1, 0, At, B0); PG8_BAR; PG8_SCHED;
            PG8_STAGE(PG8_SB(1, 1), b3 + hstep, voffB);
            PG8_WAIT_V(6); PG8_BAR; PG8_MMA(1, 1, At, B1); PG8_BAR;
            }
        }
        if constexpr (ALIGN_EPI) { if (wr == 0) PG8_BAR; }
        if constexpr (!Epi::AFTER_DRAIN) { Unit cu = cur; int fr_l = fr, fq_l = fq; asm volatile("" : "+s"(cu.pm), "+s"(cu.pn), "+v"(fr_l), "+v"(fq_l)); E(acc, cu, wr, wc, fr_l, fq_l); S.done(cur); }
        if (!has_next) break;
#pragma unroll
        for (int a = 0; a < 2; ++a)
#pragma unroll
            for (int b = 0; b < 2; ++b)
#pragma unroll
                for (int m = 0; m < 4; ++m)
#pragma unroll
                    for (int n = 0; n < 2; ++n) acc[a][b][m][n] = (f32x4){0.f, 0.f, 0.f, 0.f};
        cur = nxt; cA = nA; cB = nB; ++ui;
        if constexpr (ALIGN_EPI) { if (wr == 1) PG8_BAR; }
    }
    PG8_WAIT_V(0);
    if constexpr (!ALIGN_EPI) { if (wr == 0) PG8_BAR; }
    PG8_BAR;
    if constexpr (Epi::AFTER_DRAIN) { E.fused(acc, cur, wr, wc, fr, fq, lds, wid, lane); S.done(cur); }
#undef PG8_SA
#undef PG8_SB
#undef PG8_STAGE
#undef PG8_LDA
#undef PG8_LDB
#undef PG8_MMA
#undef PG8_WAIT_V
#undef PG8_WAIT_L
#undef PG8_BAR
#undef PG8_SCHED
}
}

#define LAS __attribute__((address_space(3)))
typedef unsigned short bf16_t;
typedef short bf16x8 __attribute__((ext_vector_type(8)));
typedef float f32x4 __attribute__((ext_vector_type(4)));
typedef float f32x2 __attribute__((ext_vector_type(2)));
typedef float f32x16 __attribute__((ext_vector_type(16)));
typedef unsigned u32x4 __attribute__((ext_vector_type(4)));
typedef unsigned u32x2 __attribute__((ext_vector_type(2)));
#define DI __device__ __forceinline__
#define MFMA32(a, b, c) __builtin_amdgcn_mfma_f32_32x32x16_bf16((a), (b), (c), 0, 0, 0)

constexpr int M = 16896, MP = 16384, D = 1024, FF = 2816;
constexpr float EPS = 1e-6f;
constexpr int NTHR = 512;
constexpr int LDS_BYTES = 136 * 1024;

constexpr size_t O_Y = 0;
constexpr size_t O_LRUH_P = (size_t)M * 1024;
constexpr size_t O_CONV_P = O_LRUH_P + 8192;
constexpr size_t O_SBK_P = O_CONV_P + 24576;
constexpr size_t O_SBV_P = O_SBK_P + 16777216;
constexpr size_t O_RET_P = O_SBV_P + 16777216;
constexpr size_t O_LRUH_S = O_RET_P + 8388608;
constexpr size_t O_CONV_S = O_LRUH_S + 8192;
constexpr size_t O_SBK_S = O_CONV_S + 24576;
constexpr size_t O_SBV_S = O_SBK_S + 524288;
constexpr size_t O_RET_S = O_SBV_S + 524288;
constexpr size_t O_END = O_RET_S + 8388608;

constexpr size_t SZ_M1K = (size_t)M * 1024 * 2;
constexpr size_t WS_CTL = 0;
constexpr size_t WS_WGU = 65536;
constexpr size_t SZ_WGU1 = (size_t)5632 * 1024 * 2;
constexpr size_t WS_WDN = WS_WGU + 8 * SZ_WGU1;
constexpr size_t SZ_WDN1 = (size_t)1024 * 2816 * 2;
constexpr size_t WS_WPG = WS_WDN + 8 * SZ_WDN1;
constexpr size_t SZ_W1K = (size_t)1024 * 1024 * 2;
constexpr size_t WS_WPI = WS_WPG + 4 * SZ_W1K;
constexpr size_t SZ_WPI1 = (size_t)1024 * 256 * 2;
constexpr size_t WS_WABI = WS_WPI + 4 * SZ_WPI1;
constexpr size_t SZ_WABI1 = (size_t)2560 * 1024 * 2;
constexpr size_t WS_WABO = WS_WABI + 2 * SZ_WABI1;
constexpr size_t WS_WCI = WS_WABO + 2 * SZ_W1K;
constexpr size_t SZ_WCI1 = (size_t)6144 * 1024 * 2;
constexpr size_t WS_WCO = WS_WCI + 2 * SZ_WCI1;
constexpr size_t SZ_WCO1 = (size_t)1024 * 2048 * 2;
constexpr size_t WS_H = WS_WCO + 2 * SZ_WCO1;
constexpr size_t WS_ACT = WS_H + SZ_M1K;
constexpr size_t WS_Y = WS_ACT + (size_t)M * 2816 * 2;
constexpr size_t WS_PE = WS_Y + SZ_M1K;
constexpr size_t WS_KBS = WS_PE + SZ_M1K;
constexpr size_t SZ_KBS1 = (size_t)64 * 2112 * 64 * 2;
constexpr size_t WS_VTS = WS_KBS + 2 * SZ_KBS1;
constexpr size_t WS_TAB = WS_VTS + 2 * SZ_KBS1;
constexpr size_t SZ_TAB1 = (size_t)2112 * 128 * 4;
constexpr size_t WS_MIX = WS_TAB + 2 * SZ_TAB1;
constexpr size_t WS_XAQ = WS_MIX;
constexpr size_t WS_KBP = WS_XAQ + (size_t)M * 1536 * 2;
constexpr size_t WS_VTP = WS_KBP + (size_t)64 * 2048 * 64 * 2;
constexpr size_t WS_MIXE = WS_VTP + (size_t)64 * 2048 * 64 * 2;
constexpr size_t WS_KR = WS_MIX;
constexpr size_t WS_GG = WS_KR + SZ_M1K;
constexpr size_t WS_KT = WS_GG + 2 * SZ_M1K;
constexpr size_t WS_VT = WS_KT + SZ_M1K;
constexpr size_t WS_END = WS_VT + 2 * SZ_M1K;
constexpr size_t WS_PB = WS_MIX;
constexpr size_t WS_QR = WS_Y;
constexpr size_t WS_OB = WS_ACT;

struct KArgs { const float* in[26]; float* out; unsigned char* ws; };

DI float lane_xor(float v, int lane, int o) { return __builtin_bit_cast(float, __builtin_amdgcn_ds_bpermute((lane ^ o) << 2, __builtin_bit_cast(int, v))); }
DI float wave_sum(float v, int lane) {
#pragma unroll
    for (int o = 1; o < 64; o <<= 1) v += lane_xor(v, lane, o);
    return v;
}
DI unsigned f2bf(float f) { unsigned u = __float_as_uint(f); return (u + 0x7fffu + ((u >> 16) & 1u)) >> 16; }
DI unsigned pk2(float lo, float hi) { return f2bf(lo) | (f2bf(hi) << 16); }
DI float bflo(unsigned w) { return __uint_as_float(w << 16); }
DI float bfhi(unsigned w) { return __uint_as_float(w & 0xffff0000u); }
DI float bf1(bf16_t h) { return __uint_as_float((unsigned)h << 16); }
DI float sigmoidf_(float x) { return __builtin_amdgcn_rcpf(1.f + __expf(-x)); }
DI void row_dec(int r, int& g, int& b, int& t) { if (r < MP) { g = 0; b = r >> 11; t = r & 2047; } else { g = 1; const int q = r - MP; b = q >> 6; t = q & 63; } }
DI int crow(int reg, int h) { return (reg & 3) + 8 * (reg >> 2) + 4 * h; }
#define WAVE_LDS_SYNC() do { asm volatile("s_waitcnt lgkmcnt(0)" ::: "memory"); __builtin_amdgcn_wave_barrier(); asm volatile("" ::: "memory"); } while (0)

using pg8::Unit;
typedef const f32x4 (&AccRef)[2][2][4][2];

struct EpiSwiGLU {
    static constexpr bool PERM = true, AFTER_DRAIN = false;
    bf16_t* O;
    DI void operator()(AccRef acc, const Unit& u, int wr, int wc, int fr, int fq) const {
        const int row0 = u.pm * 256 + wr * 64 + fr, col0 = u.pn * 128 + wc * 32 + 8 * fq;
#pragma unroll
        for (int ai = 0; ai < 2; ++ai)
#pragma unroll
            for (int m = 0; m < 4; ++m) {
                float v[8];
#pragma unroll
                for (int n = 0; n < 2; ++n)
#pragma unroll
                    for (int i = 0; i < 4; ++i) { const float g = acc[ai][0][m][n][i], up = acc[ai][1][m][n][i]; v[n * 4 + i] = g * up * sigmoidf_(g); }
                u32x4 w; w.x = pk2(v[0], v[1]); w.y = pk2(v[2], v[3]); w.z = pk2(v[4], v[5]); w.w = pk2(v[6], v[7]);
                *(u32x4*)(O + (size_t)(row0 + ai * 128 + m * 16) * FF + col0) = w;
            }
    }
};
struct EpiY {
    static constexpr bool PERM = true, AFTER_DRAIN = false;
    bf16_t* O; const bf16_t* PE;
    DI void operator()(AccRef acc, const Unit& u, int wr, int wc, int fr, int fq) const {
        const int row0 = u.pm * 256 + wr * 64 + fr, col0 = u.pn * 256 + wc * 32 + 8 * fq;
#pragma unroll
        for (int ai = 0; ai < 2; ++ai)
#pragma unroll
            for (int m = 0; m < 4; ++m)
#pragma unroll
                for (int bj = 0; bj < 2; ++bj) {
                    const size_t off = (size_t)(row0 + ai * 128 + m * 16) * 1024 + col0 + bj * 128;
                    f32x4 v0 = acc[ai][bj][m][0], v1 = acc[ai][bj][m][1];
                    if (PE) {
                        const u32x4 p = *(const u32x4*)(PE + off);
                        v0[0] = sigmoidf_(v0[0]) * bflo(p.x); v0[1] = sigmoidf_(v0[1]) * bfhi(p.x); v0[2] = sigmoidf_(v0[2]) * bflo(p.y); v0[3] = sigmoidf_(v0[3]) * bfhi(p.y);
                        v1[0] = sigmoidf_(v1[0]) * bflo(p.z); v1[1] = sigmoidf_(v1[1]) * bfhi(p.z); v1[2] = sigmoidf_(v1[2]) * bflo(p.w); v1[3] = sigmoidf_(v1[3]) * bfhi(p.w);
                    }
                    u32x4 w; w.x = pk2(v0[0], v0[1]); w.y = pk2(v0[2], v0[3]); w.z = pk2(v1[0], v1[1]); w.w = pk2(v1[2], v1[3]);
                    *(u32x4*)(O + off) = w;
                }
    }
};
struct EpiAB {
    static constexpr bool PERM = true, AFTER_DRAIN = false;
    bf16_t* XAQ; bf16_t* KBP; bf16_t* VTP; bf16_t* KBS; bf16_t* VTS; float* out; int j;
    DI void operator()(AccRef acc, const Unit& u, int wr, int wc, int fr, int fq) const {
        const int row0 = u.pm * 256 + wr * 64 + fr, offc = wc * 32 + 8 * fq;
        if (u.pn < 6) {
#pragma unroll
            for (int ai = 0; ai < 2; ++ai)
#pragma unroll
                for (int m = 0; m < 4; ++m)
#pragma unroll
                    for (int bj = 0; bj < 2; ++bj) {
                        const f32x4 v0 = acc[ai][bj][m][0], v1 = acc[ai][bj][m][1];
                        u32x4 w; w.x = pk2(v0[0], v0[1]); w.y = pk2(v0[2], v0[3]); w.z = pk2(v1[0], v1[1]); w.w = pk2(v1[2], v1[3]);
                        *(u32x4*)(XAQ + (size_t)(row0 + ai * 128 + m * 16) * 1536 + u.pn * 256 + bj * 128 + offc) = w;
                    }
        } else {
            const bool isv = u.pn >= 8;
#pragma unroll
            for (int ai = 0; ai < 2; ++ai)
#pragma unroll
                for (int m = 0; m < 4; ++m) {
                    const int r = row0 + ai * 128 + m * 16; int g, b, t; row_dec(r, g, b, t);
                    float* of = out + (g ? (isv ? O_SBV_S : O_SBK_S) + (size_t)j * (512 * 512) + (size_t)(r - MP) * 512
                                         : (isv ? O_SBV_P : O_SBK_P) + (size_t)j * ((size_t)MP * 512) + (size_t)r * 512);
#pragma unroll
                    for (int bj = 0; bj < 2; ++bj) {
                        const int c = ((u.pn & 1) * 256) + bj * 128 + offc, head = c >> 6, d = c & 63;
                        const f32x4 v0 = acc[ai][bj][m][0], v1 = acc[ai][bj][m][1];
                        *(f32x4*)(of + c) = v0; *(f32x4*)(of + c + 4) = v1;
                        if (!isv) {
                            u32x4 w; w.x = pk2(v0[0], v0[1]); w.y = pk2(v0[2], v0[3]); w.z = pk2(v1[0], v1[1]); w.w = pk2(v1[2], v1[3]);
                            bf16_t* kb = g ? KBS + ((size_t)(b * 8 + head) * 2112 + 2048 + t) * 64 + d : KBP + ((size_t)(b * 8 + head) * 2048 + t) * 64 + d;
                            *(u32x4*)kb = w;
                        } else {
                            const size_t T = g ? 2112 : 2048;
                            bf16_t* vt = g ? VTS + ((size_t)(b * 8 + head) * 64 + d) * 2112 + 2048 + t : VTP + ((size_t)(b * 8 + head) * 64 + d) * 2048 + t;
#pragma unroll
                            for (int i = 0; i < 4; ++i) { vt[(size_t)i * T] = (bf16_t)f2bf(v0[i]); vt[(size_t)(4 + i) * T] = (bf16_t)f2bf(v1[i]); }
                        }
                    }
                }
        }
    }
};
struct EpiC {
    static constexpr bool PERM = true, AFTER_DRAIN = false;
    bf16_t* QR; bf16_t* KR; bf16_t* KT; bf16_t* VT; bf16_t* GG; const float* ctab; const float* stab;
    DI void operator()(AccRef acc, const Unit& u, int wr, int wc, int fr, int fq) const {
        const int row0 = u.pm * 256 + wr * 64 + fr, offc = wc * 32 + 8 * fq;
        if (u.pn < 8) {
            const bool isk = u.pn >= 4; const int head = u.pn & 3; const float sc = isk ? 0.0625f : 1.f;
            bf16_t* dst = isk ? KR : QR;
#pragma unroll
            for (int ai = 0; ai < 2; ++ai)
#pragma unroll
                for (int m = 0; m < 4; ++m) {
                    const int r = row0 + ai * 128 + m * 16; int g, b, t; row_dec(r, g, b, t);
                    const int pos = g ? 2048 + t : t;
                    const size_t T = g ? 64 : 2048;
                    bf16_t* kt = g ? KT + (size_t)MP * 1024 + ((size_t)(b * 4 + head) * 256 + offc) * 64 + t : KT + ((size_t)(b * 4 + head) * 256 + offc) * 2048 + t;
#pragma unroll
                    for (int n = 0; n < 2; ++n) {
                        const f32x4 cc = *(const f32x4*)(ctab + pos * 128 + offc + 4 * n), ss = *(const f32x4*)(stab + pos * 128 + offc + 4 * n);
                        const f32x4 x1 = acc[ai][0][m][n] * sc, x2 = acc[ai][1][m][n] * sc;
                        const f32x4 ra = x1 * cc - x2 * ss, rb = x2 * cc + x1 * ss;
                        u32x2 w1, w2; w1.x = pk2(ra[0], ra[1]); w1.y = pk2(ra[2], ra[3]); w2.x = pk2(rb[0], rb[1]); w2.y = pk2(rb[2], rb[3]);
                        *(u32x2*)(dst + (size_t)r * 1024 + head * 256 + offc + 4 * n) = w1;
                        *(u32x2*)(dst + (size_t)r * 1024 + head * 256 + 128 + offc + 4 * n) = w2;
                        if (isk) {
#pragma unroll
                            for (int i = 0; i < 4; ++i) { kt[(size_t)(4 * n + i) * T] = (bf16_t)(w1[i >> 1] >> (16 * (i & 1))); kt[(size_t)(128 + 4 * n + i) * T] = (bf16_t)(w2[i >> 1] >> (16 * (i & 1))); }
                        }
                        asm volatile("" ::: "memory");
                    }
                }
        } else if (u.pn < 16) {
#pragma unroll
            for (int ai = 0; ai < 2; ++ai)
#pragma unroll
                for (int m = 0; m < 4; ++m) {
                    const int r = row0 + ai * 128 + m * 16; int g, b, t; row_dec(r, g, b, t);
                    const size_t T = g ? 64 : 2048;
#pragma unroll
                    for (int bj = 0; bj < 2; ++bj) {
                        const int eg = (u.pn - 8) * 256 + bj * 128 + offc, head = eg >> 9, e = eg & 511;
                        bf16_t* vt = g ? VT + (size_t)MP * 2048 + ((size_t)(b * 4 + head) * 512 + e) * 64 + t : VT + ((size_t)(b * 4 + head) * 512 + e) * 2048 + t;
                        const f32x4 v0 = acc[ai][bj][m][0], v1 = acc[ai][bj][m][1];
#pragma unroll
                        for (int i = 0; i < 4; ++i) { vt[(size_t)i * T] = (bf16_t)f2bf(v0[i]); vt[(size_t)(4 + i) * T] = (bf16_t)f2bf(v1[i]); }
                    }
                }
        } else {
#pragma unroll
            for (int ai = 0; ai < 2; ++ai)
#pragma unroll
                for (int m = 0; m < 4; ++m)
#pragma unroll
                    for (int bj = 0; bj < 2; ++bj) {
                        const f32x4 v0 = acc[ai][bj][m][0], v1 = acc[ai][bj][m][1];
                        u32x4 w; w.x = pk2(v0[0], v0[1]); w.y = pk2(v0[2], v0[3]); w.z = pk2(v1[0], v1[1]); w.w = pk2(v1[2], v1[3]);
                        *(u32x4*)(GG + (size_t)(row0 + ai * 128 + m * 16) * 2048 + (u.pn - 16) * 256 + bj * 128 + offc) = w;
                    }
        }
    }
};

DI void tr_item(const float* in, size_t ldi, bf16_t* out, size_t ldo, int k0, int n0, int drow0, LAS float* scr, int lane) {
#pragma unroll 8
    for (int i = 0; i < 32; ++i) { const int kk = 2 * i + (lane >> 5); scr[kk * 33 + (lane & 31)] = in[(size_t)(k0 + kk) * ldi + n0 + (lane & 31)]; }
    WAVE_LDS_SYNC();
    const int c = lane & 7;
#pragma unroll
    for (int jj = 0; jj < 4; ++jj) { const int n = (lane >> 3) + 8 * jj; const LAS float* s = scr + (8 * c) * 33 + n;
        u32x4 o; o.x = pk2(s[0 * 33], s[1 * 33]); o.y = pk2(s[2 * 33], s[3 * 33]); o.z = pk2(s[4 * 33], s[5 * 33]); o.w = pk2(s[6 * 33], s[7 * 33]);
        *(u32x4*)(out + (size_t)(drow0 + n) * ldo + k0 + 8 * c) = o; }
    WAVE_LDS_SYNC();
}
DI void tr_plain(const float* W, int K, int N, bf16_t* WT, int it, LAS float* scr, int lane) {
    const int nblk = N / 32, kb = it / nblk, nb = it % nblk;
    tr_item(W, (size_t)N, WT, (size_t)K, kb * 64, nb * 32, nb * 32, scr, lane);
}

DI void prologue_phase(const KArgs& a, LAS unsigned char* lds, int vcu, int G, int tid, int wave, int lane) {
    unsigned char* ws = a.ws;
    LAS float* scr = (LAS float*)(lds + wave * 8704);
    const int gw = vcu * 8 + wave, NGW = G * 8;
    if (blockIdx.x == 0 && tid < 64) ((unsigned*)(ws + WS_CTL))[tid * 64] = 0u;
    constexpr int I_FFN = 1408, N_FFN = 8 * 3 * I_FFN;
    constexpr int I_PG = 512, I_PI = 128, I_ABI = 1280, I_ABO = 512, I_CI = 3072, I_CO = 1024, I_CV = 64;
    constexpr int E0 = N_FFN, E1 = E0 + 4 * I_PG, E2 = E1 + 4 * I_PI, E3 = E2 + 2 * I_ABI, E4 = E3 + 2 * I_ABO, E5 = E4 + 2 * I_CI, E6 = E5 + 2 * I_CO, E7 = E6 + 128 * I_CV;
    for (int it = gw; it < E7; it += NGW) {
        if (it < E0) {
            const int mf = it / (3 * I_FFN), r = it % (3 * I_FFN), kind = r / I_FFN, q = r % I_FFN;
            if (kind < 2) {
                const float* W = a.in[10 + kind] + (size_t)mf * 1024 * FF;
                const int kb = q / 88, nb = q % 88, n0 = nb * 32;
                tr_item(W, FF, (bf16_t*)(ws + WS_WGU + (size_t)mf * SZ_WGU1), 1024, kb * 64, n0, (n0 >> 7) * 256 + kind * 128 + (n0 & 127), scr, lane);
            } else {
                tr_plain(a.in[12] + (size_t)mf * FF * 1024, FF, 1024, (bf16_t*)(ws + WS_WDN + (size_t)mf * SZ_WDN1), q, scr, lane);
            }
        } else if (it < E1) { const int q = it - E0, l = q / I_PG; tr_plain(a.in[14] + (size_t)l * 1024 * 1024, 1024, 1024, (bf16_t*)(ws + WS_WPG + (size_t)l * SZ_W1K), q % I_PG, scr, lane); }
        else if (it < E2) { const int q = it - E1, l = q / I_PI; tr_plain(a.in[13] + (size_t)l * 256 * 1024, 256, 1024, (bf16_t*)(ws + WS_WPI + (size_t)l * SZ_WPI1), q % I_PI, scr, lane); }
        else if (it < E3) { const int q = it - E2, l = q / I_ABI; tr_plain(a.in[15] + (size_t)l * 1024 * 2560, 1024, 2560, (bf16_t*)(ws + WS_WABI + (size_t)l * SZ_WABI1), q % I_ABI, scr, lane); }
        else if (it < E4) { const int q = it - E3, l = q / I_ABO; tr_plain(a.in[16] + (size_t)l * 1024 * 1024, 1024, 1024, (bf16_t*)(ws + WS_WABO + (size_t)l * SZ_W1K), q % I_ABO, scr, lane); }
        else if (it < E5) { const int q = it - E4, l = q / I_CI; tr_plain(a.in[24] + (size_t)l * 1024 * 6144, 1024, 6144, (bf16_t*)(ws + WS_WCI + (size_t)l * SZ_WCI1), q % I_CI, scr, lane); }
        else if (it < E6) { const int q = it - E5, l = q / I_CO; tr_plain(a.in[25] + (size_t)l * 2048 * 1024, 2048, 1024, (bf16_t*)(ws + WS_WCO + (size_t)l * SZ_WCO1), q % I_CO, scr, lane); }
        else {
            const int q = it - E6, jbh = q / I_CV, r = q % I_CV, jb = jbh >> 3, h = jbh & 7, kb = r >> 1, nb = r & 1;
            tr_item(a.in[7] + (size_t)jb * 2048 * 512 + h * 64, 512, (bf16_t*)(ws + WS_VTS) + (size_t)jbh * 64 * 2112, 2112, kb * 64, nb * 32, nb * 32, scr, lane);
        }
    }
    const int gt = vcu * NTHR + tid, NGT = G * NTHR;
    for (int it = gt; it < 2 * 8 * 2048 * 64; it += NGT) {
        const int d8 = it & 7, h = (it >> 3) & 7, t = (it >> 6) & 2047, jb = it >> 17;
        const float* s = a.in[6] + ((size_t)(jb * 2048 + t) * 512 + h * 64 + d8 * 8);
        const f32x4 v0 = *(const f32x4*)s, v1 = *(const f32x4*)(s + 4);
        u32x4 w; w.x = pk2(v0[0], v0[1]); w.y = pk2(v0[2], v0[3]); w.z = pk2(v1[0], v1[1]); w.w = pk2(v1[2], v1[3]);
        *(u32x4*)((bf16_t*)(ws + WS_KBS) + ((size_t)(jb * 8 + h) * 2112 + t) * 64 + d8 * 8) = w;
    }
    for (int it = gt; it < 2112 * 128; it += NGT) {
        const int pos = it >> 7, jf = it & 127;
        const float freq = exp2f(-(float)jf * (13.287712379549449f / 128.f));
        const float ang = (float)pos * freq;
        const double rev = (double)ang * 0.15915494309189535; const float fr = (float)(rev - floor(rev));
        ((float*)(ws + WS_TAB))[it] = __builtin_amdgcn_cosf(fr); ((float*)(ws + WS_TAB + SZ_TAB1))[it] = __builtin_amdgcn_sinf(fr);
    }
}
DI void pconv_phase(const KArgs& a, int l, int gt, int NGT) {
    bf16_t* PB = (bf16_t*)(a.ws + WS_PB);
    for (int it = gt; it < M * 32; it += NGT) {
        const int r = it >> 5, c8 = (it & 31) * 8;
        const float* s = (r < MP) ? a.in[2] + ((size_t)l * MP + r) * 256 + c8 : a.in[3] + ((size_t)l * 512 + (r - MP)) * 256 + c8;
        const f32x4 v0 = *(const f32x4*)s, v1 = *(const f32x4*)(s + 4);
        u32x4 w; w.x = pk2(v0[0], v0[1]); w.y = pk2(v0[2], v0[3]); w.z = pk2(v1[0], v1[1]); w.w = pk2(v1[2], v1[3]);
        *(u32x4*)(PB + (size_t)r * 256 + c8) = w;
    }
}
DI void rowwise_phase(const KArgs& a, const bf16_t* Y, const float* ga, float c, const float* gb, int gw, int NGW, int lane) {
    float* X = a.out; bf16_t* H = (bf16_t*)(a.ws + WS_H);
    for (int r = gw; r < M; r += NGW) {
        f32x4 x[4]; float ss = 0.f;
        if (Y) {
            f32x4 y[4];
#pragma unroll
            for (int q = 0; q < 4; ++q) { const int col = 4 * lane + 256 * q; const u32x2 w = *(const u32x2*)(Y + (size_t)r * 1024 + col);
                y[q] = (f32x4){bflo(w.x), bfhi(w.x), bflo(w.y), bfhi(w.y)}; x[q] = *(const f32x4*)(X + (size_t)r * 1024 + col);
                ss += (y[q][0] * y[q][0] + y[q][1] * y[q][1]) + (y[q][2] * y[q][2] + y[q][3] * y[q][3]); }
            const float rs = c * rsqrtf(wave_sum(ss, lane) * (1.f / 1024.f) + EPS);
#pragma unroll
            for (int q = 0; q < 4; ++q) { const int col = 4 * lane + 256 * q; const f32x4 g = *(const f32x4*)(ga + col); x[q] = x[q] + y[q] * g * rs; *(f32x4*)(X + (size_t)r * 1024 + col) = x[q]; }
        } else {
            const float* src = (r < MP) ? a.in[0] + (size_t)r * 1024 : a.in[1] + (size_t)(r - MP) * 1024;
#pragma unroll
            for (int q = 0; q < 4; ++q) { const int col = 4 * lane + 256 * q; x[q] = *(const f32x4*)(src + col); *(f32x4*)(X + (size_t)r * 1024 + col) = x[q]; }
        }
        if (gb) {
            float s2 = 0.f;
#pragma unroll
            for (int q = 0; q < 4; ++q) s2 += (x[q][0] * x[q][0] + x[q][1] * x[q][1]) + (x[q][2] * x[q][2] + x[q][3] * x[q][3]);
            const float rs2 = rsqrtf(wave_sum(s2, lane) * (1.f / 1024.f) + EPS);
#pragma unroll
            for (int q = 0; q < 4; ++q) { const int col = 4 * lane + 256 * q; const f32x4 g = *(const f32x4*)(gb + col); const f32x4 h = x[q] * g * rs2;
                u32x2 w; w.x = pk2(h[0], h[1]); w.y = pk2(h[2], h[3]); *(u32x2*)(H + (size_t)r * 1024 + col) = w; }
        }
    }
}
DI float lru_ldx(const bf16_t* XAQ, const float* cst, int g, int L, int rowbase, int ch, int t) {
    if (t >= 0) return (t < L) ? bf1(XAQ[(size_t)(rowbase + t) * 1536 + ch]) : 0.f;
    return g ? cst[(size_t)(3 + t) * 512] : 0.f;
}
DI void lru_unit(const KArgs& a, int j, int g, int b, int hb, LAS unsigned char* lds, int tid, int wave, int lane) {
    const bf16_t* XAQ = (const bf16_t*)(a.ws + WS_XAQ); bf16_t* MIX = (bf16_t*)(a.ws + WS_MIXE);
    const int L = g ? 64 : 2048, rowbase = g ? MP + b * 64 : b * 2048;
    LAS float* XC = (LAS float*)lds;
    LAS float* AA = XC + 128 * 65;
    LAS float* UU = AA + 128 * 64;
    LAS float* SEG = UU + 128 * 64;
    const int c = tid & 63, seg = tid >> 6, ch = hb * 64 + c;
    const float* cw = a.in[17] + (size_t)j * 4 * 512 + ch;
    const float w0 = cw[0], w1 = cw[512], w2 = cw[1024], w3 = cw[1536], cb = a.in[18][j * 512 + ch];
    const int tb = wave >> 1, chh = wave & 1, hh = lane >> 5, oc = chh * 32 + (lane & 31);
    bf16x8 Wr[4], Wi[4];
    {
        const float* wr_ = a.in[19] + ((size_t)(j * 8 + hb) * 64) * 64 + oc; const float* wi_ = a.in[21] + ((size_t)(j * 8 + hb) * 64) * 64 + oc;
#pragma unroll
        for (int ks = 0; ks < 4; ++ks)
#pragma unroll
            for (int e = 0; e < 8; ++e) { const int i = 16 * ks + 8 * hh + e; Wr[ks][e] = (short)f2bf(wr_[(size_t)i * 64]); Wi[ks][e] = (short)f2bf(wi_[(size_t)i * 64]); }
    }
    const float br = a.in[20][j * 512 + hb * 64 + oc], bi = a.in[22][j * 512 + hb * 64 + oc];
    const float lam = a.in[23][j * 512 + hb * 64 + oc];
    const float spl = (lam > 0.f ? 0.f : -lam) + log1pf(__expf(-fabsf(lam)));
    float carry = g ? a.in[4][(size_t)(j * 8 + b) * 512 + ch] : 0.f;
    const float* cst = a.in[5] + (size_t)(j * 8 + b) * 3 * 512 + ch;
    const int nchunk = (L + 127) / 128;
    for (int ck = 0; ck < nchunk; ++ck) {
        const int t0 = ck * 128;
        {
            float xm3, xm2, xm1;
            const int ts = t0 + 16 * seg;
#define ldx(t_) lru_ldx(XAQ, cst, g, L, rowbase, ch, (t_))
            xm3 = ldx(ts - 3); xm2 = ldx(ts - 2); xm1 = ldx(ts - 1);
#pragma unroll 4
            for (int q = 0; q < 16; ++q) { const float x0 = ldx(ts + q); XC[(16 * seg + q) * 65 + c] = cb + w0 * xm3 + w1 * xm2 + w2 * xm1 + w3 * x0; xm3 = xm2; xm2 = xm1; xm1 = x0; }
#undef ldx
        }
        __syncthreads();
        {
            f32x16 ar, ai;
#pragma unroll
            for (int i = 0; i < 16; ++i) { ar[i] = 0.f; ai[i] = 0.f; }
            const int tokA = 32 * tb + (lane & 31);
#pragma unroll
            for (int ks = 0; ks < 4; ++ks) {
                bf16x8 A; const LAS float* s = XC + tokA * 65 + 16 * ks + 8 * hh;
#pragma unroll
                for (int e = 0; e < 8; ++e) A[e] = (short)f2bf(s[e]);
                ar = MFMA32(A, Wr[ks], ar); ai = MFMA32(A, Wi[ks], ai);
            }
#pragma unroll
            for (int i = 0; i < 16; ++i) {
                const int tl = 32 * tb + crow(i, hh);
                const float rg = sigmoidf_(ar[i] + br), ig = sigmoidf_(ai[i] + bi);
                const float la = -8.f * rg * spl;
                float av = __expf(la), uv = sqrtf(-expm1f(2.f * la)) * ig * XC[tl * 65 + oc];
                if (t0 + tl >= L) { av = 1.f; uv = 0.f; }
                AA[tl * 64 + oc] = av; UU[tl * 64 + oc] = uv;
            }
        }
        __syncthreads();
        {
            float A = 1.f, Hh = 0.f;
#pragma unroll 4
            for (int q = 0; q < 16; ++q) { const float av = AA[(16 * seg + q) * 64 + c], uv = UU[(16 * seg + q) * 64 + c]; Hh = av * Hh + uv; A *= av; }
            SEG[(seg * 64 + c) * 2] = A; SEG[(seg * 64 + c) * 2 + 1] = Hh;
        }
        __syncthreads();
        {
            float hin = carry;
            for (int s = 0; s < seg; ++s) hin = SEG[(s * 64 + c) * 2] * hin + SEG[(s * 64 + c) * 2 + 1];
            float hend = hin;
            for (int s = seg; s < 8; ++s) hend = SEG[(s * 64 + c) * 2] * hend + SEG[(s * 64 + c) * 2 + 1];
            carry = hend;
            float h = hin;
#pragma unroll 4
            for (int q = 0; q < 16; ++q) {
                const int tl = 16 * seg + q, t = t0 + tl;
                h = AA[tl * 64 + c] * h + UU[tl * 64 + c];
                if (t < L) {
                    const float gv = bf1(XAQ[(size_t)(rowbase + t) * 1536 + 512 + ch]);
                    const float gl = gv * sigmoidf_(1.5957691216057308f * (gv + 0.044715f * gv * gv * gv));
                    MIX[(size_t)(rowbase + t) * 1024 + ch] = (bf16_t)f2bf(gl * h);
                }
            }
        }
        __syncthreads();
    }
    if (seg == 0) {
        a.out[(g ? O_LRUH_S : O_LRUH_P) + (size_t)(j * 8 + b) * 512 + ch] = carry;
#pragma unroll
        for (int k = 0; k < 3; ++k) a.out[(g ? O_CONV_S : O_CONV_P) + ((size_t)(j * 8 + b) * 3 + k) * 512 + ch] = bf1(XAQ[(size_t)(rowbase + L - 3 + k) * 1536 + ch]);
    }
}
DI void sb_task(const KArgs& a, int j, int task, int lane) {
    int g, b, h, qb;
    if (task < 128) { g = 1; b = task >> 4; h = (task >> 1) & 7; qb = task & 1; }
    else { const int q = task - 128; g = 0; b = q >> 9; h = (q >> 6) & 7; qb = 63 - (q & 63); }
    const int P = g ? 2048 : 0, T = g ? 2112 : 2048, rowbase = g ? MP + b * 64 : b * 2048;
    const bf16_t* XAQ = (const bf16_t*)(a.ws + WS_XAQ); bf16_t* MIX = (bf16_t*)(a.ws + WS_MIXE);
    const bf16_t* Kb = g ? (const bf16_t*)(a.ws + WS_KBS) + (size_t)j * (SZ_KBS1 / 2) + (size_t)(b * 8 + h) * 2112 * 64 : (const bf16_t*)(a.ws + WS_KBP) + (size_t)(b * 8 + h) * 2048 * 64;
    const bf16_t* Vt = g ? (const bf16_t*)(a.ws + WS_VTS) + (size_t)j * (SZ_KBS1 / 2) + (size_t)(b * 8 + h) * 64 * 2112 : (const bf16_t*)(a.ws + WS_VTP) + (size_t)(b * 8 + h) * 64 * 2048;
    const int ql = lane & 31, hh = lane >> 5;
    const int rq = rowbase + 32 * qb + ql, tabs = P + 32 * qb + ql;
    bf16x8 qf[4];
#pragma unroll
    for (int ks = 0; ks < 4; ++ks) qf[ks] = *(const bf16x8*)(XAQ + (size_t)rq * 1536 + 1024 + h * 64 + 16 * ks + 8 * hh);
    f32x16 o0, o1;
#pragma unroll
    for (int i = 0; i < 16; ++i) { o0[i] = 0.f; o1[i] = 0.f; }
    float carry = 0.f;
    int kb = (P >> 5) + qb;
    bf16x8 kf[4];
#pragma unroll
    for (int ks = 0; ks < 4; ++ks) kf[ks] = *(const bf16x8*)(Kb + (size_t)(32 * kb + ql) * 64 + 16 * ks + 8 * hh);
    for (; kb >= 0; --kb) {
        u32x2 va[2][2][2];
#pragma unroll
        for (int dh = 0; dh < 2; ++dh)
#pragma unroll
            for (int s = 0; s < 2; ++s) { const bf16_t* p = Vt + (size_t)(32 * dh + ql) * T + 32 * kb + 16 * s + 4 * hh; va[dh][s][0] = *(const u32x2*)p; va[dh][s][1] = *(const u32x2*)(p + 8); }
        bf16x8 kn[4];
        if (kb > 0) {
#pragma unroll
            for (int ks = 0; ks < 4; ++ks) kn[ks] = *(const bf16x8*)(Kb + (size_t)(32 * (kb - 1) + ql) * 64 + 16 * ks + 8 * hh);
        } else {
#pragma unroll
            for (int ks = 0; ks < 4; ++ks) kn[ks] = kf[ks];
        }
        f32x16 st;
#pragma unroll
        for (int i = 0; i < 16; ++i) st[i] = 0.f;
#pragma unroll
        for (int ks = 0; ks < 4; ++ks) st = MFMA32(kf[ks], qf[ks], st);
        float z[16], lb[16];
#pragma unroll
        for (int i = 0; i < 16; ++i) {
            z[i] = st[i] * 0.125f;
            const float sp = fmaxf(z[i], 0.f) + __logf(1.f + __expf(-fabsf(z[i])));
            const bool ok = (32 * kb + crow(i, hh)) < tabs;
            lb[i] = ok ? -sp : 0.f;
        }
        float G[4], Gx[4];
#pragma unroll
        for (int q = 0; q < 4; ++q) { G[q] = (lb[4 * q] + lb[4 * q + 1]) + (lb[4 * q + 2] + lb[4 * q + 3]); Gx[q] = lane_xor(G[q], lane, 32); }
        float pv[16];
        float suf = carry;
#pragma unroll
        for (int q = 3; q >= 0; --q) {
            float tl = suf + (hh == 0 ? Gx[q] : 0.f);
#pragma unroll
            for (int ii = 3; ii >= 0; --ii) {
                const int i = 4 * q + ii;
                const bool ok = (32 * kb + crow(i, hh)) < tabs;
                pv[i] = ok ? __expf(z[i] + lb[i] + tl) : 0.f;
                tl += lb[i];
            }
            suf += G[q] + Gx[q];
        }
        carry = suf;
        bf16x8 pb[2];
#pragma unroll
        for (int s = 0; s < 2; ++s) {
            u32x4 w; w.x = pk2(pv[8 * s], pv[8 * s + 1]); w.y = pk2(pv[8 * s + 2], pv[8 * s + 3]); w.z = pk2(pv[8 * s + 4], pv[8 * s + 5]); w.w = pk2(pv[8 * s + 6], pv[8 * s + 7]);
            pb[s] = __builtin_bit_cast(bf16x8, w);
        }
#pragma unroll
        for (int s = 0; s < 2; ++s) {
            u32x4 w0; w0.x = va[0][s][0].x; w0.y = va[0][s][0].y; w0.z = va[0][s][1].x; w0.w = va[0][s][1].y;
            u32x4 w1; w1.x = va[1][s][0].x; w1.y = va[1][s][0].y; w1.z = va[1][s][1].x; w1.w = va[1][s][1].y;
            o0 = MFMA32(__builtin_bit_cast(bf16x8, w0), pb[s], o0);
            o1 = MFMA32(__builtin_bit_cast(bf16x8, w1), pb[s], o1);
        }
#pragma unroll
        for (int ks = 0; ks < 4; ++ks) kf[ks] = kn[ks];
        if (__all(carry < -104.f)) break;
    }
#pragma unroll
    for (int q = 0; q < 4; ++q) {
        u32x2 w; w.x = pk2(o0[4 * q], o0[4 * q + 1]); w.y = pk2(o0[4 * q + 2], o0[4 * q + 3]);
        *(u32x2*)(MIX + (size_t)rq * 1024 + 512 + h * 64 + 8 * q + 4 * hh) = w;
        w.x = pk2(o1[4 * q], o1[4 * q + 1]); w.y = pk2(o1[4 * q + 2], o1[4 * q + 3]);
        *(u32x2*)(MIX + (size_t)rq * 1024 + 512 + h * 64 + 32 + 8 * q + 4 * hh) = w;
    }
}

DI void ret_unit(const KArgs& a, int j, int g, int b, int h, int es, LAS unsigned char* lds, int wave, int lane) {
    const int L = g ? 64 : 2048, rowbase = g ? MP + b * 64 : b * 2048, nch = L >> 6;
    const bf16_t* VT = (const bf16_t*)(a.ws + WS_VT) + (g ? (size_t)MP * 2048 + ((size_t)(b * 4 + h) * 512 + es * 64) * 64 : ((size_t)(b * 4 + h) * 512 + es * 64) * 2048);
    const float lg2 = log2f(1.f - exp2f(-5.f - (float)h));
    const int l31 = lane & 31, hh = lane >> 5, w4 = wave & 3;
    constexpr int RTS = 264;
    LAS bf16_t* RT = (LAS bf16_t*)lds;
    if (wave < 4) {
        const bf16_t* QR = (const bf16_t*)(a.ws + WS_QR); const bf16_t* KR = (const bf16_t*)(a.ws + WS_KR); bf16_t* OB = (bf16_t*)(a.ws + WS_OB);
        const int et = w4 & 1, lt = w4 >> 1;
        const float xi = exp2f(lg2 * (float)(32 * lt + l31 + 1));
        __syncthreads();
        int buf = 0;
        for (int c = 0; c < nch; ++c) {
            const int t0 = c * 64;
            const int rl = rowbase + t0 + 32 * lt + l31;
            f32x16 st0, st1, oc, oi;
#pragma unroll
            for (int i = 0; i < 16; ++i) { st0[i] = 0.f; st1[i] = 0.f; oc[i] = 0.f; oi[i] = 0.f; }
            const bf16_t* qp = QR + (size_t)rl * 1024 + h * 256 + 8 * hh;
            const bf16_t* kp = KR + (size_t)(rowbase + t0 + l31) * 1024 + h * 256 + 8 * hh;
            const LAS bf16_t* rp = RT + buf * (64 * RTS) + (32 * et + l31) * RTS + 8 * hh;
#pragma unroll 2
            for (int ks = 0; ks < 16; ++ks) {
                const bf16x8 qf = *(const bf16x8*)(qp + 16 * ks);
                const bf16x8 k0 = *(const bf16x8*)(kp + 16 * ks), k1 = *(const bf16x8*)(kp + 32 * 1024 + 16 * ks);
                const bf16x8 rf = *(const LAS bf16x8*)(rp + 16 * ks);
                st0 = MFMA32(k0, qf, st0); st1 = MFMA32(k1, qf, st1);
                oc = MFMA32(rf, qf, oc);
            }
#pragma unroll
            for (int mt = 0; mt < 2; ++mt) {
                float p[16];
#pragma unroll
                for (int i = 0; i < 16; ++i) { const int mm = 32 * mt + crow(i, hh), ll = 32 * lt + l31; const float dd = (float)(mm > ll ? mm - ll : ll - mm); p[i] = (mt ? st1[i] : st0[i]) * exp2f(lg2 * dd); }
#pragma unroll
                for (int s = 0; s < 2; ++s) {
                    u32x4 w; w.x = pk2(p[8 * s], p[8 * s + 1]); w.y = pk2(p[8 * s + 2], p[8 * s + 3]); w.z = pk2(p[8 * s + 4], p[8 * s + 5]); w.w = pk2(p[8 * s + 6], p[8 * s + 7]);
                    const bf16_t* vp = VT + (size_t)(32 * et + l31) * L + t0 + 32 * mt + 16 * s + 4 * hh;
                    const u32x2 v0 = *(const u32x2*)vp, v1 = *(const u32x2*)(vp + 8);
                    u32x4 va; va.x = v0.x; va.y = v0.y; va.z = v1.x; va.w = v1.y;
                    oi = MFMA32(__builtin_bit_cast(bf16x8, va), __builtin_bit_cast(bf16x8, w), oi);
                }
            }
#pragma unroll
            for (int q = 0; q < 4; ++q) {
                u32x2 w; w.x = pk2(oi[4 * q] + xi * oc[4 * q], oi[4 * q + 1] + xi * oc[4 * q + 1]); w.y = pk2(oi[4 * q + 2] + xi * oc[4 * q + 2], oi[4 * q + 3] + xi * oc[4 * q + 3]);
                *(u32x2*)(OB + (size_t)rl * 2048 + h * 512 + es * 64 + 32 * et + 8 * q + 4 * hh) = w;
            }
            __syncthreads();
            buf ^= 1;
        }
        __syncthreads();
    } else {
        const bf16_t* KT = (const bf16_t*)(a.ws + WS_KT) + (g ? (size_t)MP * 1024 + (size_t)(b * 4 + h) * 256 * 64 : (size_t)(b * 4 + h) * 256 * 2048);
        f32x16 R[2][2];
#pragma unroll
        for (int x = 0; x < 2; ++x)
#pragma unroll
            for (int y = 0; y < 2; ++y)
#pragma unroll
                for (int i = 0; i < 16; ++i) R[x][y][i] = 0.f;
        if (g) {
            const float* R0 = a.in[8] + ((size_t)((j * 8 + b) * 4 + h) * 256) * 512 + es * 64;
#pragma unroll
            for (int dti = 0; dti < 2; ++dti)
#pragma unroll
                for (int et = 0; et < 2; ++et)
#pragma unroll
                    for (int i = 0; i < 16; ++i) { R[dti][et][i] = R0[(size_t)(32 * (2 * w4 + dti) + crow(i, hh)) * 512 + 32 * et + l31]; if ((i & 3) == 3) asm volatile("" ::: "memory"); }
        }
#pragma unroll
        for (int dti = 0; dti < 2; ++dti)
#pragma unroll
            for (int et = 0; et < 2; ++et)
#pragma unroll
                for (int q = 0; q < 4; ++q) { u32x2 w; w.x = pk2(R[dti][et][4 * q], R[dti][et][4 * q + 1]); w.y = pk2(R[dti][et][4 * q + 2], R[dti][et][4 * q + 3]);
                    *(LAS u32x2*)(RT + (32 * et + l31) * RTS + 32 * (2 * w4 + dti) + 8 * q + 4 * hh) = w; }
        __syncthreads();
        const float g64 = exp2f(lg2 * 64.f);
        float z[8];
#pragma unroll
        for (int e = 0; e < 8; ++e) z[e] = exp2f(lg2 * (float)(63 - 8 * hh - e));
        const float ginv16 = exp2f(-16.f * lg2);
        int buf = 0;
        for (int c = 0; c < nch; ++c) {
            const int t0 = c * 64;
#pragma unroll
            for (int dti = 0; dti < 2; ++dti)
#pragma unroll
                for (int et = 0; et < 2; ++et)
#pragma unroll
                    for (int i = 0; i < 16; ++i) R[dti][et][i] *= g64;
            float zs = 1.f;
#pragma unroll
            for (int s = 0; s < 4; ++s) {
                const bf16x8 vb0 = *(const bf16x8*)(VT + (size_t)l31 * L + t0 + 16 * s + 8 * hh), vb1 = *(const bf16x8*)(VT + (size_t)(32 + l31) * L + t0 + 16 * s + 8 * hh);
#pragma unroll
                for (int dti = 0; dti < 2; ++dti) {
                    const u32x4 kw = *(const u32x4*)(KT + (size_t)(32 * (2 * w4 + dti) + l31) * L + t0 + 16 * s + 8 * hh);
                    u32x4 ks_; ks_.x = pk2(bflo(kw.x) * (z[0] * zs), bfhi(kw.x) * (z[1] * zs)); ks_.y = pk2(bflo(kw.y) * (z[2] * zs), bfhi(kw.y) * (z[3] * zs));
                    ks_.z = pk2(bflo(kw.z) * (z[4] * zs), bfhi(kw.z) * (z[5] * zs)); ks_.w = pk2(bflo(kw.w) * (z[6] * zs), bfhi(kw.w) * (z[7] * zs));
                    const bf16x8 ka = __builtin_bit_cast(bf16x8, ks_);
                    R[dti][0] = MFMA32(ka, vb0, R[dti][0]); R[dti][1] = MFMA32(ka, vb1, R[dti][1]);
                }
                zs *= ginv16;
            }
#pragma unroll
            for (int dti = 0; dti < 2; ++dti)
#pragma unroll
                for (int et = 0; et < 2; ++et)
#pragma unroll
                    for (int q = 0; q < 4; ++q) { u32x2 w; w.x = pk2(R[dti][et][4 * q], R[dti][et][4 * q + 1]); w.y = pk2(R[dti][et][4 * q + 2], R[dti][et][4 * q + 3]);
                        *(LAS u32x2*)(RT + (buf ^ 1) * (64 * RTS) + (32 * et + l31) * RTS + 32 * (2 * w4 + dti) + 8 * q + 4 * hh) = w; }
            __syncthreads();
            buf ^= 1;
        }
        float* Rout = a.out + (g ? O_RET_S : O_RET_P) + ((size_t)((j * 8 + b) * 4 + h) * 256) * 512 + es * 64;
#pragma unroll
        for (int dti = 0; dti < 2; ++dti)
#pragma unroll
            for (int et = 0; et < 2; ++et)
#pragma unroll
                for (int i = 0; i < 16; ++i) { Rout[(size_t)(32 * (2 * w4 + dti) + crow(i, hh)) * 512 + 32 * et + l31] = R[dti][et][i]; if ((i & 3) == 3) asm volatile("" ::: "memory"); }
        __syncthreads();
    }
}
DI void gn_phase(const KArgs& a, int gw, int NGW, int lane) {
    bf16_t* OB = (bf16_t*)(a.ws + WS_OB); const bf16_t* GG = (const bf16_t*)(a.ws + WS_GG);
    for (int it = gw; it < M * 4; it += NGW) {
        const size_t off = (size_t)(it >> 2) * 2048 + (it & 3) * 512 + lane * 8;
        const u32x4 ow = *(const u32x4*)(OB + off), gwv = *(const u32x4*)(GG + off);
        float o[8] = {bflo(ow.x), bfhi(ow.x), bflo(ow.y), bfhi(ow.y), bflo(ow.z), bfhi(ow.z), bflo(ow.w), bfhi(ow.w)};
        const float gg[8] = {bflo(gwv.x), bfhi(gwv.x), bflo(gwv.y), bfhi(gwv.y), bflo(gwv.z), bfhi(gwv.z), bflo(gwv.w), bfhi(gwv.w)};
        float s = 0.f;
#pragma unroll
        for (int e = 0; e < 8; ++e) s += o[e];
        const float mu = wave_sum(s, lane) * (1.f / 512.f);
        float v = 0.f;
#pragma unroll
        for (int e = 0; e < 8; ++e) { o[e] -= mu; v += o[e] * o[e]; }
        const float rstd = rsqrtf(wave_sum(v, lane) * (1.f / 512.f) + EPS);
        float y[8];
#pragma unroll
        for (int e = 0; e < 8; ++e) y[e] = gg[e] * sigmoidf_(gg[e]) * o[e] * rstd;
        u32x4 w; w.x = pk2(y[0], y[1]); w.y = pk2(y[2], y[3]); w.z = pk2(y[4], y[5]); w.w = pk2(y[6], y[7]);
        *(u32x4*)(OB + off) = w;
    }
}

DI void small_gemm_sample(const bf16_t* A, const bf16_t* Bt, int K, bf16_t* O, const bf16_t* PE, LAS unsigned char* lds, int tile, int wave, int lane) {
    const int tm = tile >> 4, tn = tile & 15, nh = wave & 1, kq = wave >> 1, l31 = lane & 31, hh = lane >> 5;
    const int kper = K >> 2;
    const bf16_t* ap = A + (size_t)(MP + 32 * tm + l31) * K + kq * kper + 8 * hh;
    const bf16_t* bp = Bt + (size_t)(64 * tn + 32 * nh + l31) * K + kq * kper + 8 * hh;
    f32x16 acc;
#pragma unroll
    for (int i = 0; i < 16; ++i) acc[i] = 0.f;
#pragma unroll 4
    for (int k = 0; k < kper; k += 16) {
        const bf16x8 av = *(const bf16x8*)(ap + k), bv = *(const bf16x8*)(bp + k);
        acc = MFMA32(av, bv, acc);
    }
    LAS float* red = (LAS float*)lds;
#pragma unroll
    for (int i = 0; i < 16; ++i) red[((kq * 2 + nh) * 16 + i) * 64 + lane] = acc[i];
    __syncthreads();
    {
        const int q = wave >> 1;
#pragma unroll
        for (int ii = 0; ii < 4; ++ii) {
            const int i = 4 * q + ii;
            float v = 0.f;
#pragma unroll
            for (int k4 = 0; k4 < 4; ++k4) v += red[((k4 * 2 + nh) * 16 + i) * 64 + lane];
            const size_t off = (size_t)(MP + 32 * tm + crow(i, hh)) * 1024 + 64 * tn + 32 * nh + l31;
            if (PE) v = sigmoidf_(v) * bf1(PE[off]);
            O[off] = (bf16_t)f2bf(v);
        }
    }
    __syncthreads();
}
__global__ void __launch_bounds__(NTHR, 2) hybrid_fwd(const KArgs a) {
    extern __shared__ __attribute__((aligned(16))) unsigned char lds_raw[];
    cg::grid_group grid = cg::this_grid();
    LAS unsigned char* lds = (LAS unsigned char*)lds_raw;
    const int G = gridDim.x, bx = blockIdx.x;
    const int vcu = (G % 8 == 0) ? (bx % 8) * (G / 8) + bx / 8 : bx;
    const int NGW = G * 8, NGT = G * NTHR;

    {
        const int tid = threadIdx.x, lane = tid & 63, wave = __builtin_amdgcn_readfirstlane(tid >> 6);
        prologue_phase(a, lds, vcu, G, tid, wave, lane);
        rowwise_phase(a, nullptr, nullptr, 0.f, a.in[9], vcu * 8 + wave, NGW, lane);
    }
    grid.sync();

    const KArgs a0 = a;
    for (int step = 0; step < 20; ++step) {
        KArgs a = a0;
        asm volatile("" : "+s"(a.ws), "+s"(a.out));
        unsigned char* ws = a.ws; const float* normg = a.in[9];
        int tid, lane, wave, gw, gt, bxs;
#define LAUNDER() do { tid = threadIdx.x; bxs = bx; asm volatile("" : "+v"(tid), "+s"(bxs)); lane = tid & 63; wave = __builtin_amdgcn_readfirstlane(tid >> 6); gw = vcu * 8 + wave; gt = vcu * NTHR + tid; } while (0)
        LAUNDER();
        const int i = step / 5, sb = step % 5, j = i >> 1;
        const bool odd = (i & 1) != 0;
        const bf16_t* yA = nullptr; const bf16_t* yB = nullptr; int yK = 0; const bf16_t* yPE = nullptr; bf16_t* yO = (bf16_t*)(ws + WS_Y);
        if (sb == 0 || sb == 2) {
            const int mf = i * 2 + (sb >> 1);
            {
                pg8::Gemm gm{(const bf16_t*)(ws + WS_H), (const bf16_t*)(ws + WS_WGU + (size_t)mf * SZ_WGU1), M, 5632, 1024};
                pg8::StaticOrder S; S.init(M, 5632, G, bxs);
                EpiSwiGLU E{(bf16_t*)(ws + WS_ACT)};
                pg8::gemm_phase<EpiSwiGLU, pg8::StaticOrder, true, true>(lds, gm, S, E);
            }
            grid.sync(); LAUNDER();
            yA = (const bf16_t*)(ws + WS_ACT); yB = (const bf16_t*)(ws + WS_WDN + (size_t)mf * SZ_WDN1); yK = FF;
        } else if (sb == 1) {
            if (!odd) {
                {
                    pg8::Gemm gm{(const bf16_t*)(ws + WS_H), (const bf16_t*)(ws + WS_WABI + (size_t)j * SZ_WABI1), M, 2560, 1024};
                    pg8::StaticOrder S; S.init(M, 2560, G, bxs);
                    EpiAB E{(bf16_t*)(ws + WS_XAQ), (bf16_t*)(ws + WS_KBP), (bf16_t*)(ws + WS_VTP), (bf16_t*)(ws + WS_KBS + (size_t)j * SZ_KBS1), (bf16_t*)(ws + WS_VTS + (size_t)j * SZ_KBS1), a.out, j};
                    pg8::gemm_phase<EpiAB, pg8::StaticOrder, true, true>(lds, gm, S, E);
                }
                grid.sync(); LAUNDER();
                for (int u = vcu; u < 128; u += G) { const int g = u >> 6, q = u & 63; lru_unit(a, j, g, q >> 3, q & 7, lds, tid, wave, lane); }
                {
                    unsigned* ctr = (unsigned*)(ws + WS_CTL) + 64 * j;
                    for (;;) {
                        unsigned t = 0; if (lane == 0) t = atomicAdd(ctr, 1u);
                        t = __builtin_amdgcn_readfirstlane(t);
                        if (t >= 128u + 4096u) break;
                        sb_task(a, j, (int)t, lane);
                    }
                }
                grid.sync(); LAUNDER();
                yA = (const bf16_t*)(ws + WS_MIXE); yB = (const bf16_t*)(ws + WS_WABO + (size_t)j * SZ_W1K); yK = 1024;
            } else {
                {
                    pg8::Gemm gm{(const bf16_t*)(ws + WS_H), (const bf16_t*)(ws + WS_WCI + (size_t)j * SZ_WCI1), M, 6144, 1024};
                    pg8::StaticOrder S; S.init(M, 6144, G, bxs);
                    EpiC E{(bf16_t*)(ws + WS_QR), (bf16_t*)(ws + WS_KR), (bf16_t*)(ws + WS_KT), (bf16_t*)(ws + WS_VT), (bf16_t*)(ws + WS_GG), (const float*)(ws + WS_TAB), (const float*)(ws + WS_TAB + SZ_TAB1)};
                    pg8::gemm_phase<EpiC, pg8::StaticOrder, true, true>(lds, gm, S, E);
                }
                grid.sync(); LAUNDER();
                for (int u = vcu; u < 512; u += G) { const int g = u >> 8, q = u & 255; ret_unit(a, j, g, q >> 5, (q >> 3) & 3, q & 7, lds, wave, lane); }
                grid.sync(); LAUNDER();
                gn_phase(a, gw, NGW, lane);
                grid.sync(); LAUNDER();
                yA = (const bf16_t*)(ws + WS_OB); yB = (const bf16_t*)(ws + WS_WCO + (size_t)j * SZ_WCO1); yK = 2048;
            }
        } else if (sb == 3) {
            yA = (const bf16_t*)(ws + WS_PB); yB = (const bf16_t*)(ws + WS_WPI + (size_t)i * SZ_WPI1); yK = 256; yO = (bf16_t*)(ws + WS_PE);
        } else {
            yA = (const bf16_t*)(ws + WS_H); yB = (const bf16_t*)(ws + WS_WPG + (size_t)i * SZ_W1K); yK = 1024; yPE = (const bf16_t*)(ws + WS_PE);
        }
        {
            pg8::Gemm gm{yA, yB, MP, 1024, yK};
            pg8::StaticOrder S; S.init(MP, 1024, G, bxs);
            EpiY E{yO, yPE};
            pg8::gemm_phase<EpiY, pg8::StaticOrder, true, true>(lds, gm, S, E);
            LAUNDER();
            for (int tl = vcu; tl < 256; tl += G) small_gemm_sample(yA, yB, yK, yO, yPE, lds, tl, wave, lane);
        }
        grid.sync(); LAUNDER();
        if (sb != 3) {
            const int nidx = (sb == 4) ? 3 : sb;
            const float* ga = normg + (size_t)(i * 8 + 2 * nidx + 1) * 1024;
            const float* gb = (step == 19) ? nullptr : normg + (size_t)(i * 8 + 2 * nidx + 2) * 1024;
            rowwise_phase(a, (const bf16_t*)(ws + WS_Y), ga, (nidx & 1) ? 1.f : 0.5f, gb, gw, NGW, lane);
            if (sb == 2) pconv_phase(a, i, gt, NGT);
            if (step != 19) grid.sync(); LAUNDER();
        }
    }
}

extern "C" void kernel_launch(void* const* d_in, const int* in_sizes, int n_in, void* d_out, int out_size, void* d_ws, size_t ws_size, hipStream_t stream) {
    static int grid = 0;
    if (grid == 0) {
        int dev = 0, cus = 0, per_cu = 0;
        if (hipGetDevice(&dev) != hipSuccess || hipDeviceGetAttribute(&cus, hipDeviceAttributeMultiprocessorCount, dev) != hipSuccess) { grid = -1; return; }
        if (hipFuncSetAttribute((const void*)hybrid_fwd, hipFuncAttributeMaxDynamicSharedMemorySize, LDS_BYTES) != hipSuccess) { fprintf(stderr, "hipFuncSetAttribute failed\n"); grid = -1; return; }
        if (hipOccupancyMaxActiveBlocksPerMultiprocessor(&per_cu, (const void*)hybrid_fwd, NTHR, LDS_BYTES) != hipSuccess || per_cu < 1) fprintf(stderr, "occupancy query: %d\n", per_cu);
        (void)hipGetLastError();
        grid = cus;
        if (n_in != 26 || (size_t)out_size != O_END || ws_size < WS_END) { fprintf(stderr, "kernel_launch: unexpected sizes n_in %d out %d ws %zu (need %zu)\n", n_in, out_size, ws_size, (size_t)WS_END); grid = -1; return; }
    }
    if (grid < 0) return;
    KArgs a{};
    for (int i = 0; i < 26; ++i) a.in[i] = (const float*)d_in[i];
    a.out = (float*)d_out; a.ws = (unsigned char*)d_ws;
    void* args[] = {&a};
    hipError_t e = hipLaunchCooperativeKernel((void*)hybrid_fwd, dim3(grid), dim3(NTHR), args, LDS_BYTES, stream);
    if (e != hipSuccess) fprintf(stderr, "cooperative launch failed: %s (grid %d)\n", hipGetErrorString(e), grid);
}
```

```cpp
#include <hip/hip_runtime.h>
#include <hip/hip_cooperative_groups.h>
#include <cstdio>
#include <cstdint>
namespace cg = cooperative_groups;
#define REP_GEMM 1
#define REP_SYNC 1
#define REP_PRO 1
#define REP_MIX 1
namespace pg8 {
#define PG8_LAS __attribute__((address_space(3)))
typedef unsigned short bf16_t;
typedef short bf16x8 __attribute__((ext_vector_type(8)));
typedef float f32x4 __attribute__((ext_vector_type(4)));
typedef unsigned u32x4 __attribute__((ext_vector_type(4)));
constexpr int BM = 256, BK = 64, HALF = 128, HTB = HALF * BK * 2  , STAGE_BYTES = 8 * HTB, NXCD = 8, WGM = 8;

__host__ __device__ __forceinline__ int lds_byte(int r, int c) { const int st = (r >> 4) * 2 + (c >> 5), rr = r & 15, cc = c & 31, ob = rr * 64 + cc * 2; return st * 1024 + (ob ^ (((ob >> 9) & 1) << 5)); }
__host__ __device__ __forceinline__ void stage_rc(int b, int& R, int& C) { const int st = b / 1024, sb = b % 1024, swz = sb ^ (((sb >> 9) & 1) << 5); R = (st >> 1) * 16 + swz / 64; C = (st & 1) * 32 + (swz % 64) / 2; }
__host__ __device__ __forceinline__ int perm32(int rho) { const int n = rho >> 4, i = rho & 15; return 8 * (i >> 2) + 4 * n + (i & 3); }

struct Unit { int pm, pn; };
struct Gemm { const bf16_t* A; const bf16_t* Bt; int M, N, K; };

struct StaticOrder {
    int nM, nN, nwg, G, c;
    __host__ __device__ void init(int M, int N, int G_, int c_) { nM = M / BM; nN = N / BM; nwg = nM * nN; G = G_; c = c_; }
    __host__ __device__ bool next(int i, Unit& u) const {
        const long L = (long)i * G + c; if (L >= nwg) return false;
        int wgid = (int)L; { const int q = nwg / NXCD, r = nwg % NXCD, xcd = wgid % NXCD, off = wgid / NXCD; wgid = (xcd < r ? xcd * (q + 1) : r * (q + 1) + (xcd - r) * q) + off; }
        const int nig = WGM * nN, gid = wgid / nig, fm = gid * WGM, gsz = (nM - fm) < WGM ? (nM - fm) : WGM;
        u.pm = fm + ((wgid % nig) % gsz); u.pn = (wgid % nig) / gsz; return true;
    }
    __device__ __forceinline__ void a_ready(const Unit&) const {}
    __device__ __forceinline__ void done(const Unit&) const {}
};

__device__ __forceinline__ unsigned cvt_pk_bf16(float lo, float hi) { unsigned r; asm volatile("v_cvt_pk_bf16_f32 %0, %1, %2" : "=v"(r) : "v"(lo), "v"(hi)); return r; }
template <class Epi, class Sched, bool ALIGN_EPI = false, bool SP2 = false>
__device__ __forceinline__ void gemm_phase(PG8_LAS unsigned char* lds, const Gemm g, const Sched& S, const Epi& E, const int wave_id) {
    int tid_l = (int)__builtin_amdgcn_mbcnt_hi(~0u, __builtin_amdgcn_mbcnt_lo(~0u, 0u)); asm volatile("" : "+v"(tid_l)); tid_l += 64 * wave_id;
    const int tid = tid_l, wid = __builtin_amdgcn_readfirstlane(tid >> 6), lane = tid & 63, wr = wid >> 2, wc = wid & 3, fr = lane & 15, fq = lane >> 4;
    const int K = g.K, nt = K / BK;
    unsigned voffA[2], voffB[2];
#pragma unroll
    for (int i = 0; i < 2; ++i) { int R, C; stage_rc(tid * 16 + i * 8192, R, C); const int Rb = Epi::PERM ? ((R & ~31) + perm32(R & 31)) : R;
        voffA[i] = (unsigned)(R * K + C) * 2u; voffB[i] = (unsigned)(Rb * K + C) * 2u; }
    const size_t kstep = (size_t)(BK * 2);
    const size_t hstep = (size_t)HALF * K * 2;
    const size_t tstep = 2 * hstep;
    const unsigned ldsw = (unsigned)wid * 1024u;
    const int aoff = lds_byte(wr * 64 + fr, fq * 8), boff = lds_byte(wc * 32 + fr, fq * 8);
#define PG8_SA(b, h) (((b) * 2 + (h)) * HTB)
#define PG8_SB(b, h) ((4 + (b) * 2 + (h)) * HTB)
#define PG8_STAGE(bufoff, gbase, voff) do { _Pragma("unroll") for (int _i = 0; _i < 2; ++_i) \
        __builtin_amdgcn_global_load_lds((const unsigned*)((const char*)(gbase) + (voff)[_i]), (PG8_LAS unsigned*)(lds + (bufoff) + ldsw + _i * 8192), 16, 0, 0); } while (0)
#define PG8_LDA(dst, b, h) do { _Pragma("unroll") for (int m = 0; m < 4; ++m) _Pragma("unroll") for (int k = 0; k < 2; ++k) dst[m][k] = *(const PG8_LAS bf16x8*)(lds + PG8_SA(b, h) + aoff + m * 2048 + k * 1024); } while (0)
#define PG8_LDB(dst, b, h) do { _Pragma("unroll") for (int n = 0; n < 2; ++n) _Pragma("unroll") for (int k = 0; k < 2; ++k) dst[n][k] = *(const PG8_LAS bf16x8*)(lds + PG8_SB(b, h) + boff + n * 2048 + k * 1024); } while (0)
#define PG8_MMA(ai, bj, At, Bt) do { __builtin_amdgcn_s_setprio(1); _Pragma("unroll") for (int m = 0; m < 4; ++m) _Pragma("unroll") for (int n = 0; n < 2; ++n) _Pragma("unroll") for (int k = 0; k < 2; ++k) \
        acc[ai][bj][m][n] = __builtin_amdgcn_mfma_f32_16x16x32_bf16(Bt[n][k], At[m][k], acc[ai][bj][m][n], 0, 0, 0); __builtin_amdgcn_s_setprio(0); } while (0)
#define PG8_WAIT_V(n) asm volatile("s_waitcnt vmcnt(" #n ")" ::: "memory")
#define PG8_WAIT_L(n) asm volatile("s_waitcnt lgkmcnt(" #n ")" ::: "memory")
#define PG8_BAR __builtin_amdgcn_s_barrier()
#define PG8_SCHED __builtin_amdgcn_sched_barrier(0)
    Unit cur, nxt; int ui = 0;
    if (!S.next(0, cur)) return;
    f32x4 acc[2][2][4][2];
#pragma unroll
    for (int a = 0; a < 2; ++a)
#pragma unroll
        for (int b = 0; b < 2; ++b)
#pragma unroll
            for (int m = 0; m < 4; ++m)
#pragma unroll
                for (int n = 0; n < 2; ++n) acc[a][b][m][n] = (f32x4){0.f, 0.f, 0.f, 0.f};
    bf16x8 At[4][2], B0[2][2], B1[2][2];
    const char* cA = (const char*)g.A + (size_t)cur.pm * tstep; const char* cB = (const char*)g.Bt + (size_t)cur.pn * tstep;
    S.a_ready(cur);
    if constexpr (SP2) {
        PG8_STAGE(PG8_SB(0, 0), cB, voffB); PG8_STAGE(PG8_SB(0, 1), cB + hstep, voffB); PG8_STAGE(PG8_SA(0, 0), cA, voffA); PG8_STAGE(PG8_SA(0, 1), cA + hstep, voffA);
        if (wr == 1) PG8_BAR;
        PG8_WAIT_V(2); PG8_BAR;
        PG8_STAGE(PG8_SB(1, 0), cB + kstep, voffB); PG8_STAGE(PG8_SA(1, 0), cA + kstep, voffA); PG8_STAGE(PG8_SB(1, 1), cB + hstep + kstep, voffB);
        PG8_WAIT_V(6); PG8_BAR;
    } else {
        PG8_STAGE(PG8_SB(0, 0), cB, voffB); PG8_STAGE(PG8_SA(0, 0), cA, voffA); PG8_STAGE(PG8_SB(0, 1), cB + hstep, voffB); PG8_STAGE(PG8_SA(0, 1), cA + hstep, voffA);
        if (wr == 1) PG8_BAR;
        PG8_WAIT_V(4); PG8_BAR;
        PG8_STAGE(PG8_SB(1, 0), cB + kstep, voffB); PG8_STAGE(PG8_SA(1, 0), cA + kstep, voffA); PG8_STAGE(PG8_SB(1, 1), cB + hstep + kstep, voffB);
        PG8_WAIT_V(6); PG8_BAR;
    }
    for (;;) {
        const bool has_next = S.next(ui + 1, nxt);
        const char* nA = has_next ? (const char*)g.A + (size_t)nxt.pm * tstep : cA; const char* nB = has_next ? (const char*)g.Bt + (size_t)nxt.pn * tstep : cB;
        for (int t = 0; t < nt; t += 2) {
            const bool last = (t == nt - 2);
            const char* a1 = cA + (size_t)(t + 1) * kstep;
            const char* a2 = last ? nA : cA + (size_t)(t + 2) * kstep; const char* b2 = last ? nB : cB + (size_t)(t + 2) * kstep;
            const char* a3 = a2 + kstep; const char* b3 = b2 + kstep;
            if (last && has_next) S.a_ready(nxt);
            if constexpr (SP2) {
            PG8_LDB(B0, 0, 0); PG8_LDB(B1, 0, 1); PG8_SCHED; PG8_LDA(At, 0, 0); PG8_STAGE(PG8_SA(1, 1), a1 + hstep, voffA);
            PG8_WAIT_V(8); PG8_WAIT_L(0); PG8_BAR; PG8_MMA(0, 0, At, B0); PG8_MMA(0, 1, At, B1); PG8_BAR; PG8_SCHED;
            PG8_LDA(At, 0, 1); PG8_STAGE(PG8_SB(0, 0), b2, voffB); PG8_STAGE(PG8_SB(0, 1), b2 + hstep, voffB); PG8_STAGE(PG8_SA(0, 0), a2, voffA);
            PG8_WAIT_V(8); PG8_WAIT_L(0); PG8_BAR; PG8_MMA(1, 0, At, B0); PG8_MMA(1, 1, At, B1); PG8_BAR; PG8_SCHED;
            PG8_LDB(B0, 1, 0); PG8_LDB(B1, 1, 1); PG8_SCHED; PG8_LDA(At, 1, 0); PG8_STAGE(PG8_SA(0, 1), a2 + hstep, voffA);
            PG8_WAIT_V(8); PG8_WAIT_L(0); PG8_BAR; PG8_MMA(0, 0, At, B0); PG8_MMA(0, 1, At, B1); PG8_BAR; PG8_SCHED;
            PG8_LDA(At, 1, 1); PG8_STAGE(PG8_SB(1, 0), b3, voffB); PG8_STAGE(PG8_SB(1, 1), b3 + hstep, voffB); PG8_STAGE(PG8_SA(1, 0), a3, voffA);
            PG8_WAIT_V(8); PG8_WAIT_L(0); PG8_BAR; PG8_MMA(1, 0, At, B0); PG8_MMA(1, 1, At, B1); PG8_BAR; PG8_SCHED;
            } else {
            PG8_LDB(B0, 0, 0); PG8_SCHED; PG8_LDA(At, 0, 0); PG8_STAGE(PG8_SA(1, 1), a1 + hstep, voffA);
            PG8_WAIT_L(8); PG8_BAR; PG8_WAIT_L(0); PG8_MMA(0, 0, At, B0); PG8_BAR; PG8_SCHED;
            PG8_LDB(B1, 0, 1); PG8_STAGE(PG8_SB(0, 0), b2, voffB);
            PG8_BAR; PG8_WAIT_L(0); PG8_MMA(0, 1, At, B1); PG8_BAR;
            PG8_LDA(At, 0, 1); PG8_STAGE(PG8_SA(0, 0), a2, voffA);
            PG8_BAR; PG8_WAIT_L(0); PG8_MMA(1, 0, At, B0); PG8_BAR; PG8_SCHED;
            PG8_STAGE(PG8_SB(0, 1), b2 + hstep, voffB);
            PG8_WAIT_V(6); PG8_BAR; PG8_MMA(1, 1, At, B1); PG8_BAR;
            PG8_LDB(B0, 1, 0); PG8_SCHED; PG8_LDA(At, 1, 0); PG8_STAGE(PG8_SA(0, 1), a2 + hstep, voffA);
            PG8_WAIT_L(8); PG8_BAR; PG8_WAIT_L(0); PG8_MMA(0, 0, At, B0); PG8_BAR; PG8_SCHED;
            PG8_LDB(B1, 1, 1); PG8_STAGE(PG8_SB(1, 0), b3, voffB);
            PG8_BAR; PG8_WAIT_L(0); PG8_MMA(0, 1, At, B1); PG8_BAR;
            PG8_LDA(At, 1, 1); PG8_STAGE(PG8_SA(1, 0), a3, voffA);
            PG8_BAR; PG8_WAIT_L(0); PG8_MMA(1, 0, At, B0); PG8_BAR; PG8_SCHED;
            PG8_STAGE(PG8_SB(1, 1), b3 + hstep, voffB);
            PG8_WAIT_V(6); PG8_BAR; PG8_MMA(1, 1, At, B1); PG8_BAR;
            }
        }
        if constexpr (ALIGN_EPI) { if (wr == 0) PG8_BAR; }
        if constexpr (!Epi::AFTER_DRAIN) { Unit cu = cur; int fr_l = fr, fq_l = fq; asm volatile("" : "+s"(cu.pm), "+s"(cu.pn), "+v"(fr_l), "+v"(fq_l)); E(acc, cu, wr, wc, fr_l, fq_l); S.done(cur); }
        if (!has_next) break;
#pragma unroll
        for (int a = 0; a < 2; ++a)
#pragma unroll
            for (int b = 0; b < 2; ++b)
#pragma unroll
                for (int m = 0; m < 4; ++m)
#pragma unroll
                    for (int n = 0; n < 2; ++n) acc[a][b][m][n] = (f32x4){0.f, 0.f, 0.f, 0.f};
        cur = nxt; cA = nA; cB = nB; ++ui;
        if constexpr (ALIGN_EPI) { if (wr == 1) PG8_BAR; }
    }
    PG8_WAIT_V(0);
    if constexpr (!ALIGN_EPI) { if (wr == 0) PG8_BAR; }
    PG8_BAR;
    if constexpr (Epi::AFTER_DRAIN) { E.fused(acc, cur, wr, wc, fr, fq, lds, wid, lane); S.done(cur); }
#undef PG8_SA
#undef PG8_SB
#undef PG8_STAGE
#undef PG8_LDA
#undef PG8_LDB
#undef PG8_MMA
#undef PG8_WAIT_V
#undef PG8_WAIT_L
#undef PG8_BAR
#undef PG8_SCHED
}
}

#define LAS __attribute__((address_space(3)))
typedef unsigned short bf16_t;
typedef short bf16x8 __attribute__((ext_vector_type(8)));
typedef float f32x4 __attribute__((ext_vector_type(4)));
typedef float f32x2 __attribute__((ext_vector_type(2)));
typedef float f32x16 __attribute__((ext_vector_type(16)));
typedef unsigned u32x4 __attribute__((ext_vector_type(4)));
typedef unsigned u32x2 __attribute__((ext_vector_type(2)));
#define DI __device__ __forceinline__
#define MFMA32(a, b, c) __builtin_amdgcn_mfma_f32_32x32x16_bf16((a), (b), (c), 0, 0, 0)

constexpr int M = 16896, MP = 16384, D = 1024, FF = 2816;
constexpr float EPS = 1e-6f;
constexpr int NTHR = 512;
constexpr int LDS_BYTES = 136 * 1024;

constexpr size_t O_Y = 0;
constexpr size_t O_LRUH_P = (size_t)M * 1024;
constexpr size_t O_CONV_P = O_LRUH_P + 8192;
constexpr size_t O_SBK_P = O_CONV_P + 24576;
constexpr size_t O_SBV_P = O_SBK_P + 16777216;
constexpr size_t O_RET_P = O_SBV_P + 16777216;
constexpr size_t O_LRUH_S = O_RET_P + 8388608;
constexpr size_t O_CONV_S = O_LRUH_S + 8192;
constexpr size_t O_SBK_S = O_CONV_S + 24576;
constexpr size_t O_SBV_S = O_SBK_S + 524288;
constexpr size_t O_RET_S = O_SBV_S + 524288;
constexpr size_t O_END = O_RET_S + 8388608;

constexpr size_t SZ_M1K = (size_t)M * 1024 * 2;
constexpr size_t WS_CTL = 0;
constexpr size_t WS_PAR = 65536;
constexpr int PO_H0 = 0, PO_CST = PO_H0 + 8192, PO_NG = PO_CST + 24576, PO_CW = PO_NG + 32768, PO_CB = PO_CW + 4096, PO_WR = PO_CB + 1024, PO_BR = PO_WR + 65536,
              PO_WI = PO_BR + 1024, PO_BI = PO_WI + 65536, PO_LAM = PO_BI + 1024, PO_END = PO_LAM + 1024;
static_assert((size_t)PO_END * 4 + 65536 <= (1u << 20), "param block");
constexpr size_t WS_WGU = 1u << 20;
constexpr size_t SZ_WGU1 = (size_t)5632 * 1024 * 2;
constexpr size_t WS_WDN = WS_WGU + 8 * SZ_WGU1;
constexpr size_t SZ_WDN1 = (size_t)1024 * 2816 * 2;
constexpr size_t WS_WPG = WS_WDN + 8 * SZ_WDN1;
constexpr size_t SZ_W1K = (size_t)1024 * 1024 * 2;
constexpr size_t WS_WPI = WS_WPG + 4 * SZ_W1K;
constexpr size_t SZ_WPI1 = (size_t)1024 * 256 * 2;
constexpr size_t WS_WABI = WS_WPI + 4 * SZ_WPI1;
constexpr size_t SZ_WABI1 = (size_t)2560 * 1024 * 2;
constexpr size_t WS_WABO = WS_WABI + 2 * SZ_WABI1;
constexpr size_t WS_WCI = WS_WABO + 2 * SZ_W1K;
constexpr size_t SZ_WCI1 = (size_t)6144 * 1024 * 2;
constexpr size_t WS_WCO = WS_WCI + 2 * SZ_WCI1;
constexpr size_t SZ_WCO1 = (size_t)1024 * 2048 * 2;
constexpr size_t WS_H = WS_WCO + 2 * SZ_WCO1;
constexpr size_t WS_ACT = WS_H + SZ_M1K;
constexpr size_t WS_Y = WS_ACT + (size_t)M * 2816 * 2;
constexpr size_t WS_PE = WS_Y + SZ_M1K;
constexpr size_t WS_KBS = WS_PE + SZ_M1K;
constexpr size_t SZ_KBS1 = (size_t)64 * 2112 * 64 * 2;
constexpr size_t WS_VTS = WS_KBS + 2 * SZ_KBS1;
constexpr size_t WS_TAB = WS_VTS + 2 * SZ_KBS1;
constexpr size_t SZ_TAB1 = (size_t)2112 * 128 * 4;
constexpr size_t WS_MIX = WS_TAB + 2 * SZ_TAB1;
constexpr size_t WS_XAQ = WS_MIX;
constexpr size_t WS_KBP = WS_XAQ + (size_t)M * 1536 * 2;
constexpr size_t WS_VTP = WS_KBP + (size_t)64 * 2048 * 64 * 2;
constexpr size_t WS_MIXE = WS_VTP + (size_t)64 * 2048 * 64 * 2;
constexpr size_t WS_KR = WS_MIX;
constexpr size_t WS_GG = WS_KR + SZ_M1K;
constexpr size_t WS_KT = WS_GG + 2 * SZ_M1K;
constexpr size_t WS_VT = WS_KT + SZ_M1K;
constexpr size_t WS_END = WS_VT + 2 * SZ_M1K;
constexpr size_t WS_PB = WS_MIX;
constexpr size_t WS_QR = WS_Y;
constexpr size_t WS_OB = WS_ACT;

struct KArgs { const float* in[26]; float* out; unsigned char* ws; };
#define PAR(a_, off_) ((const float*)((a_).ws + WS_PAR) + (off_))

DI float lane_xor(float v, int lane, int o) { return __builtin_bit_cast(float, __builtin_amdgcn_ds_bpermute((lane ^ o) << 2, __builtin_bit_cast(int, v))); }
DI float wave_sum(float v, int lane) {
#pragma unroll
    for (int o = 1; o < 64; o <<= 1) v += lane_xor(v, lane, o);
    return v;
}
DI unsigned f2bf(float f) { unsigned u = __float_as_uint(f); return (u + 0x7fffu + ((u >> 16) & 1u)) >> 16; }
DI unsigned pk2(float lo, float hi) { return f2bf(lo) | (f2bf(hi) << 16); }
DI float bflo(unsigned w) { return __uint_as_float(w << 16); }
DI float bfhi(unsigned w) { return __uint_as_float(w & 0xffff0000u); }
DI float bf1(bf16_t h) { return __uint_as_float((unsigned)h << 16); }
DI float sigmoidf_(float x) { return __builtin_amdgcn_rcpf(1.f + __expf(-x)); }
DI void row_dec(int r, int& g, int& b, int& t) { if (r < MP) { g = 0; b = r >> 11; t = r & 2047; } else { g = 1; const int q = r - MP; b = q >> 6; t = q & 63; } }
DI int crow(int reg, int h) { return (reg & 3) + 8 * (reg >> 2) + 4 * h; }
#define WAVE_LDS_SYNC() do { asm volatile("s_waitcnt lgkmcnt(0)" ::: "memory"); __builtin_amdgcn_wave_barrier(); asm volatile("" ::: "memory"); } while (0)

using pg8::Unit;
typedef const f32x4 (&AccRef)[2][2][4][2];

struct EpiSwiGLU {
    static constexpr bool PERM = true, AFTER_DRAIN = false;
    bf16_t* O;
    DI void operator()(AccRef acc, const Unit& u, int wr, int wc, int fr, int fq) const {
        const int row0 = u.pm * 256 + wr * 64 + fr, col0 = u.pn * 128 + wc * 32 + 8 * fq;
#pragma unroll
        for (int ai = 0; ai < 2; ++ai)
#pragma unroll
            for (int m = 0; m < 4; ++m) {
                float v[8];
#pragma unroll
                for (int n = 0; n < 2; ++n)
#pragma unroll
                    for (int i = 0; i < 4; ++i) { const float g = acc[ai][0][m][n][i], up = acc[ai][1][m][n][i]; v[n * 4 + i] = g * up * sigmoidf_(g); }
                u32x4 w; w.x = pk2(v[0], v[1]); w.y = pk2(v[2], v[3]); w.z = pk2(v[4], v[5]); w.w = pk2(v[6], v[7]);
                *(u32x4*)(O + (size_t)(row0 + ai * 128 + m * 16) * FF + col0) = w;
            }
    }
};
struct EpiY {
    static constexpr bool PERM = true, AFTER_DRAIN = false;
    bf16_t* O; const bf16_t* PE;
    DI void operator()(AccRef acc, const Unit& u, int wr, int wc, int fr, int fq) const {
        const int row0 = u.pm * 256 + wr * 64 + fr, col0 = u.pn * 256 + wc * 32 + 8 * fq;
#pragma unroll
        for (int ai = 0; ai < 2; ++ai)
#pragma unroll
            for (int m = 0; m < 4; ++m)
#pragma unroll
                for (int bj = 0; bj < 2; ++bj) {
                    const size_t off = (size_t)(row0 + ai * 128 + m * 16) * 1024 + col0 + bj * 128;
                    f32x4 v0 = acc[ai][bj][m][0], v1 = acc[ai][bj][m][1];
                    if (PE) {
                        const u32x4 p = *(const u32x4*)(PE + off);
                        v0[0] = sigmoidf_(v0[0]) * bflo(p.x); v0[1] = sigmoidf_(v0[1]) * bfhi(p.x); v0[2] = sigmoidf_(v0[2]) * bflo(p.y); v0[3] = sigmoidf_(v0[3]) * bfhi(p.y);
                        v1[0] = sigmoidf_(v1[0]) * bflo(p.z); v1[1] = sigmoidf_(v1[1]) * bfhi(p.z); v1[2] = sigmoidf_(v1[2]) * bflo(p.w); v1[3] = sigmoidf_(v1[3]) * bfhi(p.w);
                    }
                    u32x4 w; w.x = pk2(v0[0], v0[1]); w.y = pk2(v0[2], v0[3]); w.z = pk2(v1[0], v1[1]); w.w = pk2(v1[2], v1[3]);
                    *(u32x4*)(O + off) = w;
                }
    }
};
struct EpiAB {
    static constexpr bool PERM = true, AFTER_DRAIN = false;
    bf16_t* XAQ; bf16_t* KBP; bf16_t* VTP; bf16_t* KBS; bf16_t* VTS; float* out; int j;
    DI void operator()(AccRef acc, const Unit& u, int wr, int wc, int fr, int fq) const {
        const int row0 = u.pm * 256 + wr * 64 + fr, offc = wc * 32 + 8 * fq;
        if (u.pn < 6) {
#pragma unroll
            for (int ai = 0; ai < 2; ++ai)
#pragma unroll
                for (int m = 0; m < 4; ++m)
#pragma unroll
                    for (int bj = 0; bj < 2; ++bj) {
                        const f32x4 v0 = acc[ai][bj][m][0], v1 = acc[ai][bj][m][1];
                        u32x4 w; w.x = pk2(v0[0], v0[1]); w.y = pk2(v0[2], v0[3]); w.z = pk2(v1[0], v1[1]); w.w = pk2(v1[2], v1[3]);
                        *(u32x4*)(XAQ + (size_t)(row0 + ai * 128 + m * 16) * 1536 + u.pn * 256 + bj * 128 + offc) = w;
                    }
        } else {
            const bool isv = u.pn >= 8;
#pragma unroll
            for (int ai = 0; ai < 2; ++ai)
#pragma unroll
                for (int m = 0; m < 4; ++m) {
                    const int r = row0 + ai * 128 + m * 16; int g, b, t; row_dec(r, g, b, t);
                    float* of = out + (g ? (isv ? O_SBV_S : O_SBK_S) + (size_t)j * (512 * 512) + (size_t)(r - MP) * 512
                                         : (isv ? O_SBV_P : O_SBK_P) + (size_t)j * ((size_t)MP * 512) + (size_t)r * 512);
#pragma unroll
                    for (int bj = 0; bj < 2; ++bj) {
                        const int c = ((u.pn & 1) * 256) + bj * 128 + offc, head = c >> 6, d = c & 63;
                        const f32x4 v0 = acc[ai][bj][m][0], v1 = acc[ai][bj][m][1];
                        *(f32x4*)(of + c) = v0; *(f32x4*)(of + c + 4) = v1;
                        if (!isv) {
                            u32x4 w; w.x = pk2(v0[0], v0[1]); w.y = pk2(v0[2], v0[3]); w.z = pk2(v1[0], v1[1]); w.w = pk2(v1[2], v1[3]);
                            bf16_t* kb = g ? KBS + ((size_t)(b * 8 + head) * 2112 + 2048 + t) * 64 + d : KBP + ((size_t)(b * 8 + head) * 2048 + t) * 64 + d;
                            *(u32x4*)kb = w;
                        } else {
                            const size_t T = g ? 2112 : 2048;
                            bf16_t* vt = g ? VTS + ((size_t)(b * 8 + head) * 64 + d) * 2112 + 2048 + t : VTP + ((size_t)(b * 8 + head) * 64 + d) * 2048 + t;
#pragma unroll
                            for (int i = 0; i < 4; ++i) { vt[(size_t)i * T] = (bf16_t)f2bf(v0[i]); vt[(size_t)(4 + i) * T] = (bf16_t)f2bf(v1[i]); }
                        }
                    }
                }
        }
    }
};
struct EpiC {
    static constexpr bool PERM = true, AFTER_DRAIN = false;
    bf16_t* QR; bf16_t* KR; bf16_t* KT; bf16_t* VT; bf16_t* GG; const float* ctab; const float* stab;
    DI void operator()(AccRef acc, const Unit& u, int wr, int wc, int fr, int fq) const {
        const int row0 = u.pm * 256 + wr * 64 + fr, offc = wc * 32 + 8 * fq;
        if (u.pn < 8) {
            const bool isk = u.pn >= 4; const int head = u.pn & 3; const float sc = isk ? 0.0625f : 1.f;
            bf16_t* dst = isk ? KR : QR;
#pragma unroll
            for (int ai = 0; ai < 2; ++ai)
#pragma unroll
                for (int m = 0; m < 4; ++m) {
                    const int r = row0 + ai * 128 + m * 16; int g, b, t; row_dec(r, g, b, t);
                    const int pos = g ? 2048 + t : t;
                    const size_t T = g ? 64 : 2048;
                    bf16_t* kt = g ? KT + (size_t)MP * 1024 + ((size_t)(b * 4 + head) * 256 + offc) * 64 + t : KT + ((size_t)(b * 4 + head) * 256 + offc) * 2048 + t;
#pragma unroll
                    for (int n = 0; n < 2; ++n) {
                        const f32x4 cc = *(const f32x4*)(ctab + pos * 128 + offc + 4 * n), ss = *(const f32x4*)(stab + pos * 128 + offc + 4 * n);
                        const f32x4 x1 = acc[ai][0][m][n] * sc, x2 = acc[ai][1][m][n] * sc;
                        const f32x4 ra = x1 * cc - x2 * ss, rb = x2 * cc + x1 * ss;
                        u32x2 w1, w2; w1.x = pk2(ra[0], ra[1]); w1.y = pk2(ra[2], ra[3]); w2.x = pk2(rb[0], rb[1]); w2.y = pk2(rb[2], rb[3]);
                        *(u32x2*)(dst + (size_t)r * 1024 + head * 256 + offc + 4 * n) = w1;
                        *(u32x2*)(dst + (size_t)r * 1024 + head * 256 + 128 + offc + 4 * n) = w2;
                        if (isk) {
#pragma unroll
                            for (int i = 0; i < 4; ++i) { kt[(size_t)(4 * n + i) * T] = (bf16_t)(w1[i >> 1] >> (16 * (i & 1))); kt[(size_t)(128 + 4 * n + i) * T] = (bf16_t)(w2[i >> 1] >> (16 * (i & 1))); }
                        }
                        asm volatile("" ::: "memory");
                    }
                }
        } else if (u.pn < 16) {
#pragma unroll
            for (int ai = 0; ai < 2; ++ai)
#pragma unroll
                for (int m = 0; m < 4; ++m) {
                    const int r = row0 + ai * 128 + m * 16; int g, b, t; row_dec(r, g, b, t);
                    const size_t T = g ? 64 : 2048;
#pragma unroll
                    for (int bj = 0; bj < 2; ++bj) {
                        const int eg = (u.pn - 8) * 256 + bj * 128 + offc, head = eg >> 9, e = eg & 511;
                        bf16_t* vt = g ? VT + (size_t)MP * 2048 + ((size_t)(b * 4 + head) * 512 + e) * 64 + t : VT + ((size_t)(b * 4 + head) * 512 + e) * 2048 + t;
                        const f32x4 v0 = acc[ai][bj][m][0], v1 = acc[ai][bj][m][1];
#pragma unroll
                        for (int i = 0; i < 4; ++i) { vt[(size_t)i * T] = (bf16_t)f2bf(v0[i]); vt[(size_t)(4 + i) * T] = (bf16_t)f2bf(v1[i]); }
                    }
                }
        } else {
#pragma unroll
            for (int ai = 0; ai < 2; ++ai)
#pragma unroll
                for (int m = 0; m < 4; ++m)
#pragma unroll
                    for (int bj = 0; bj < 2; ++bj) {
                        const f32x4 v0 = acc[ai][bj][m][0], v1 = acc[ai][bj][m][1];
                        u32x4 w; w.x = pk2(v0[0], v0[1]); w.y = pk2(v0[2], v0[3]); w.z = pk2(v1[0], v1[1]); w.w = pk2(v1[2], v1[3]);
                        *(u32x4*)(GG + (size_t)(row0 + ai * 128 + m * 16) * 2048 + (u.pn - 16) * 256 + bj * 128 + offc) = w;
                    }
        }
    }
};

DI void tr_item(const float* in, size_t ldi, bf16_t* out, size_t ldo, int k0, int n0, int drow0, LAS float* scr, int lane) {
#pragma unroll 8
    for (int i = 0; i < 32; ++i) { const int kk = 2 * i + (lane >> 5); scr[kk * 33 + (lane & 31)] = in[(size_t)(k0 + kk) * ldi + n0 + (lane & 31)]; }
    WAVE_LDS_SYNC();
    const int c = lane & 7;
#pragma unroll
    for (int jj = 0; jj < 4; ++jj) { const int n = (lane >> 3) + 8 * jj; const LAS float* s = scr + (8 * c) * 33 + n;
        u32x4 o; o.x = pk2(s[0 * 33], s[1 * 33]); o.y = pk2(s[2 * 33], s[3 * 33]); o.z = pk2(s[4 * 33], s[5 * 33]); o.w = pk2(s[6 * 33], s[7 * 33]);
        *(u32x4*)(out + (size_t)(drow0 + n) * ldo + k0 + 8 * c) = o; }
    WAVE_LDS_SYNC();
}
DI void tr_plain(const float* W, int K, int N, bf16_t* WT, int it, LAS float* scr, int lane) {
    const int nblk = N / 32, kb = it / nblk, nb = it % nblk;
    tr_item(W, (size_t)N, WT, (size_t)K, kb * 64, nb * 32, nb * 32, scr, lane);
}

DI void prologue_phase(const KArgs& a, LAS unsigned char* lds, int vcu, int G, int tid, int wave, int lane) {
    unsigned char* ws = a.ws;
    LAS float* scr = (LAS float*)(lds + wave * 8704);
    const int gw = vcu * 8 + wave, NGW = G * 8;
    if (blockIdx.x == 0 && tid < 64) ((unsigned*)(ws + WS_CTL))[tid * 64] = 0u;
    constexpr int I_FFN = 1408, N_FFN = 8 * 3 * I_FFN;
    constexpr int I_PG = 512, I_PI = 128, I_ABI = 1280, I_ABO = 512, I_CI = 3072, I_CO = 1024, I_CV = 64;
    constexpr int E0 = N_FFN, E1 = E0 + 4 * I_PG, E2 = E1 + 4 * I_PI, E3 = E2 + 2 * I_ABI, E4 = E3 + 2 * I_ABO, E5 = E4 + 2 * I_CI, E6 = E5 + 2 * I_CO, E7 = E6 + 128 * I_CV;
    for (int it = gw; it < E7; it += NGW) {
        if (it < E0) {
            const int mf = it / (3 * I_FFN), r = it % (3 * I_FFN), kind = r / I_FFN, q = r % I_FFN;
            if (kind < 2) {
                const float* W = a.in[10 + kind] + (size_t)mf * 1024 * FF;
                const int kb = q / 88, nb = q % 88, n0 = nb * 32;
                tr_item(W, FF, (bf16_t*)(ws + WS_WGU + (size_t)mf * SZ_WGU1), 1024, kb * 64, n0, (n0 >> 7) * 256 + kind * 128 + (n0 & 127), scr, lane);
            } else {
                tr_plain(a.in[12] + (size_t)mf * FF * 1024, FF, 1024, (bf16_t*)(ws + WS_WDN + (size_t)mf * SZ_WDN1), q, scr, lane);
            }
        } else if (it < E1) { const int q = it - E0, l = q / I_PG; tr_plain(a.in[14] + (size_t)l * 1024 * 1024, 1024, 1024, (bf16_t*)(ws + WS_WPG + (size_t)l * SZ_W1K), q % I_PG, scr, lane); }
        else if (it < E2) { const int q = it - E1, l = q / I_PI; tr_plain(a.in[13] + (size_t)l * 256 * 1024, 256, 1024, (bf16_t*)(ws + WS_WPI + (size_t)l * SZ_WPI1), q % I_PI, scr, lane); }
        else if (it < E3) { const int q = it - E2, l = q / I_ABI; tr_plain(a.in[15] + (size_t)l * 1024 * 2560, 1024, 2560, (bf16_t*)(ws + WS_WABI + (size_t)l * SZ_WABI1), q % I_ABI, scr, lane); }
        else if (it < E4) { const int q = it - E3, l = q / I_ABO; tr_plain(a.in[16] + (size_t)l * 1024 * 1024, 1024, 1024, (bf16_t*)(ws + WS_WABO + (size_t)l * SZ_W1K), q % I_ABO, scr, lane); }
        else if (it < E5) { const int q = it - E4, l = q / I_CI; tr_plain(a.in[24] + (size_t)l * 1024 * 6144, 1024, 6144, (bf16_t*)(ws + WS_WCI + (size_t)l * SZ_WCI1), q % I_CI, scr, lane); }
        else if (it < E6) { const int q = it - E5, l = q / I_CO; tr_plain(a.in[25] + (size_t)l * 2048 * 1024, 2048, 1024, (bf16_t*)(ws + WS_WCO + (size_t)l * SZ_WCO1), q % I_CO, scr, lane); }
        else {
            const int q = it - E6, jbh = q / I_CV, r = q % I_CV, jb = jbh >> 3, h = jbh & 7, kb = r >> 1, nb = r & 1;
            tr_item(a.in[7] + (size_t)jb * 2048 * 512 + h * 64, 512, (bf16_t*)(ws + WS_VTS) + (size_t)jbh * 64 * 2112, 2112, kb * 64, nb * 32, nb * 32, scr, lane);
        }
    }
    const int gt = vcu * NTHR + tid, NGT = G * NTHR;
    {
        float* par = (float*)(ws + WS_PAR);
        for (int it = gt; it < PO_END; it += NGT) {
            float v;
            if (it < PO_CST) v = a.in[4][it - PO_H0]; else if (it < PO_NG) v = a.in[5][it - PO_CST]; else if (it < PO_CW) v = a.in[9][it - PO_NG];
            else if (it < PO_CB) v = a.in[17][it - PO_CW]; else if (it < PO_WR) v = a.in[18][it - PO_CB]; else if (it < PO_BR) v = a.in[19][it - PO_WR];
            else if (it < PO_WI) v = a.in[20][it - PO_BR]; else if (it < PO_BI) v = a.in[21][it - PO_WI]; else if (it < PO_LAM) v = a.in[22][it - PO_BI];
            else v = a.in[23][it - PO_LAM];
            par[it] = v;
        }
    }
    for (int it = gt; it < 2 * 8 * 2048 * 64; it += NGT) {
        const int d8 = it & 7, h = (it >> 3) & 7, t = (it >> 6) & 2047, jb = it >> 17;
        const float* s = a.in[6] + ((size_t)(jb * 2048 + t) * 512 + h * 64 + d8 * 8);
        const f32x4 v0 = *(const f32x4*)s, v1 = *(const f32x4*)(s + 4);
        u32x4 w; w.x = pk2(v0[0], v0[1]); w.y = pk2(v0[2], v0[3]); w.z = pk2(v1[0], v1[1]); w.w = pk2(v1[2], v1[3]);
        *(u32x4*)((bf16_t*)(ws + WS_KBS) + ((size_t)(jb * 8 + h) * 2112 + t) * 64 + d8 * 8) = w;
    }
    for (int it = gt; it < 2112 * 128; it += NGT) {
        const int pos = it >> 7, jf = it & 127;
        const float freq = exp2f(-(float)jf * (13.287712379549449f / 128.f));
        const float ang = (float)pos * freq;
        const double rev = (double)ang * 0.15915494309189535; const float fr = (float)(rev - floor(rev));
        ((float*)(ws + WS_TAB))[it] = __builtin_amdgcn_cosf(fr); ((float*)(ws + WS_TAB + SZ_TAB1))[it] = __builtin_amdgcn_sinf(fr);
    }
}
DI void pconv_phase(const KArgs& a, int l, int gt, int NGT) {
    bf16_t* PB = (bf16_t*)(a.ws + WS_PB);
    for (int it = gt; it < M * 32; it += NGT) {
        const int r = it >> 5, c8 = (it & 31) * 8;
        const float* s = (r < MP) ? a.in[2] + ((size_t)l * MP + r) * 256 + c8 : a.in[3] + ((size_t)l * 512 + (r - MP)) * 256 + c8;
        const f32x4 v0 = *(const f32x4*)s, v1 = *(const f32x4*)(s + 4);
        u32x4 w; w.x = pk2(v0[0], v0[1]); w.y = pk2(v0[2], v0[3]); w.z = pk2(v1[0], v1[1]); w.w = pk2(v1[2], v1[3]);
        *(u32x4*)(PB + (size_t)r * 256 + c8) = w;
    }
}
DI void rowwise_phase(const KArgs& a, const bf16_t* Y, const float* ga, float c, const float* gb, int gw, int NGW, int lane) {
    float* X = a.out; bf16_t* H = (bf16_t*)(a.ws + WS_H);
    for (int r = gw; r < M; r += NGW) {
        f32x4 x[4]; float ss = 0.f;
        if (Y) {
            f32x4 y[4];
#pragma unroll
            for (int q = 0; q < 4; ++q) { const int col = 4 * lane + 256 * q; const u32x2 w = *(const u32x2*)(Y + (size_t)r * 1024 + col);
                y[q] = (f32x4){bflo(w.x), bfhi(w.x), bflo(w.y), bfhi(w.y)}; x[q] = *(const f32x4*)(X + (size_t)r * 1024 + col);
                ss += (y[q][0] * y[q][0] + y[q][1] * y[q][1]) + (y[q][2] * y[q][2] + y[q][3] * y[q][3]); }
            const float rs = c * rsqrtf(wave_sum(ss, lane) * (1.f / 1024.f) + EPS);
#pragma unroll
            for (int q = 0; q < 4; ++q) { const int col = 4 * lane + 256 * q; const f32x4 g = *(const f32x4*)(ga + col); x[q] = x[q] + y[q] * g * rs; *(f32x4*)(X + (size_t)r * 1024 + col) = x[q]; }
        } else {
            const float* src = (r < MP) ? a.in[0] + (size_t)r * 1024 : a.in[1] + (size_t)(r - MP) * 1024;
#pragma unroll
            for (int q = 0; q < 4; ++q) { const int col = 4 * lane + 256 * q; x[q] = *(const f32x4*)(src + col); *(f32x4*)(X + (size_t)r * 1024 + col) = x[q]; }
        }
        if (gb) {
            float s2 = 0.f;
#pragma unroll
            for (int q = 0; q < 4; ++q) s2 += (x[q][0] * x[q][0] + x[q][1] * x[q][1]) + (x[q][2] * x[q][2] + x[q][3] * x[q][3]);
            const float rs2 = rsqrtf(wave_sum(s2, lane) * (1.f / 1024.f) + EPS);
#pragma unroll
            for (int q = 0; q < 4; ++q) { const int col = 4 * lane + 256 * q; const f32x4 g = *(const f32x4*)(gb + col); const f32x4 h = x[q] * g * rs2;
                u32x2 w; w.x = pk2(h[0], h[1]); w.y = pk2(h[2], h[3]); *(u32x2*)(H + (size_t)r * 1024 + col) = w; }
        }
    }
}
DI float lru_ldx(const bf16_t* XAQ, const float* cst, int g, int L, int rowbase, int ch, int t) {
    if (t >= 0) return (t < L) ? bf1(XAQ[(size_t)(rowbase + t) * 1536 + ch]) : 0.f;
    return g ? cst[(size_t)(3 + t) * 512] : 0.f;
}
DI void lru_unit(const KArgs& a, int j, int g, int b, int hb, LAS unsigned char* lds, int tid, int wave, int lane) {
    const bf16_t* XAQ = (const bf16_t*)(a.ws + WS_XAQ); bf16_t* MIX = (bf16_t*)(a.ws + WS_MIXE);
    const int L = g ? 64 : 2048, rowbase = g ? MP + b * 64 : b * 2048;
    LAS float* XC = (LAS float*)lds;
    LAS float* AA = XC + 128 * 65;
    LAS float* UU = AA + 128 * 64;
    LAS float* SEG = UU + 128 * 64;
    const int c = tid & 63, seg = tid >> 6, ch = hb * 64 + c;
    const float* cw = PAR(a, PO_CW) + (size_t)j * 4 * 512 + ch;
    const float w0 = cw[0], w1 = cw[512], w2 = cw[1024], w3 = cw[1536], cb = PAR(a, PO_CB)[j * 512 + ch];
    const int tb = wave >> 1, chh = wave & 1, hh = lane >> 5, oc = chh * 32 + (lane & 31);
    bf16x8 Wr[4], Wi[4];
    {
        const float* wr_ = PAR(a, PO_WR) + ((size_t)(j * 8 + hb) * 64) * 64 + oc; const float* wi_ = PAR(a, PO_WI) + ((size_t)(j * 8 + hb) * 64) * 64 + oc;
#pragma unroll
        for (int ks = 0; ks < 4; ++ks)
#pragma unroll
            for (int e = 0; e < 8; ++e) { const int i = 16 * ks + 8 * hh + e; Wr[ks][e] = (short)f2bf(wr_[(size_t)i * 64]); Wi[ks][e] = (short)f2bf(wi_[(size_t)i * 64]); }
    }
    const float br = PAR(a, PO_BR)[j * 512 + hb * 64 + oc], bi = PAR(a, PO_BI)[j * 512 + hb * 64 + oc];
    const float lam = PAR(a, PO_LAM)[j * 512 + hb * 64 + oc];
    const float spl = (lam > 0.f ? 0.f : -lam) + log1pf(__expf(-fabsf(lam)));
    float carry = g ? PAR(a, PO_H0)[(size_t)(j * 8 + b) * 512 + ch] : 0.f;
    const float* cst = PAR(a, PO_CST) + (size_t)(j * 8 + b) * 3 * 512 + ch;
    const int nchunk = (L + 127) / 128;
    for (int ck = 0; ck < nchunk; ++ck) {
        const int t0 = ck * 128;
        {
            float xm3, xm2, xm1;
            const int ts = t0 + 16 * seg;
#define ldx(t_) lru_ldx(XAQ, cst, g, L, rowbase, ch, (t_))
            xm3 = ldx(ts - 3); xm2 = ldx(ts - 2); xm1 = ldx(ts - 1);
#pragma unroll 4
            for (int q = 0; q < 16; ++q) { const float x0 = ldx(ts + q); XC[(16 * seg + q) * 65 + c] = cb + w0 * xm3 + w1 * xm2 + w2 * xm1 + w3 * x0; xm3 = xm2; xm2 = xm1; xm1 = x0; }
#undef ldx
        }
        __syncthreads();
        {
            f32x16 ar, ai;
#pragma unroll
            for (int i = 0; i < 16; ++i) { ar[i] = 0.f; ai[i] = 0.f; }
            const int tokA = 32 * tb + (lane & 31);
#pragma unroll
            for (int ks = 0; ks < 4; ++ks) {
                bf16x8 A; const LAS float* s = XC + tokA * 65 + 16 * ks + 8 * hh;
#pragma unroll
                for (int e = 0; e < 8; ++e) A[e] = (short)f2bf(s[e]);
                ar = MFMA32(A, Wr[ks], ar); ai = MFMA32(A, Wi[ks], ai);
            }
#pragma unroll
            for (int i = 0; i < 16; ++i) {
                const int tl = 32 * tb + crow(i, hh);
                const float rg = sigmoidf_(ar[i] + br), ig = sigmoidf_(ai[i] + bi);
                const float la = -8.f * rg * spl;
                float av = __expf(la), uv = sqrtf(-expm1f(2.f * la)) * ig * XC[tl * 65 + oc];
                if (t0 + tl >= L) { av = 1.f; uv = 0.f; }
                AA[tl * 64 + oc] = av; UU[tl * 64 + oc] = uv;
            }
        }
        __syncthreads();
        {
            float A = 1.f, Hh = 0.f;
#pragma unroll 4
            for (int q = 0; q < 16; ++q) { const float av = AA[(16 * seg + q) * 64 + c], uv = UU[(16 * seg + q) * 64 + c]; Hh = av * Hh + uv; A *= av; }
            SEG[(seg * 64 + c) * 2] = A; SEG[(seg * 64 + c) * 2 + 1] = Hh;
        }
        __syncthreads();
        {
            float hin = carry;
            for (int s = 0; s < seg; ++s) hin = SEG[(s * 64 + c) * 2] * hin + SEG[(s * 64 + c) * 2 + 1];
            float hend = hin;
            for (int s = seg; s < 8; ++s) hend = SEG[(s * 64 + c) * 2] * hend + SEG[(s * 64 + c) * 2 + 1];
            carry = hend;
            float h = hin;
#pragma unroll 4
            for (int q = 0; q < 16; ++q) {
                const int tl = 16 * seg + q, t = t0 + tl;
                h = AA[tl * 64 + c] * h + UU[tl * 64 + c];
                if (t < L) {
                    const float gv = bf1(XAQ[(size_t)(rowbase + t) * 1536 + 512 + ch]);
                    const float gl = gv * sigmoidf_(1.5957691216057308f * (gv + 0.044715f * gv * gv * gv));
                    MIX[(size_t)(rowbase + t) * 1024 + ch] = (bf16_t)f2bf(gl * h);
                }
            }
        }
        __syncthreads();
    }
    if (seg == 0) {
        a.out[(g ? O_LRUH_S : O_LRUH_P) + (size_t)(j * 8 + b) * 512 + ch] = carry;
#pragma unroll
        for (int k = 0; k < 3; ++k) a.out[(g ? O_CONV_S : O_CONV_P) + ((size_t)(j * 8 + b) * 3 + k) * 512 + ch] = bf1(XAQ[(size_t)(rowbase + L - 3 + k) * 1536 + ch]);
    }
}
DI void sb_task(const KArgs& a, int j, int task, int lane) {
    int g, b, h, qb;
    if (task < 128) { g = 1; b = task >> 4; h = (task >> 1) & 7; qb = task & 1; }
    else { const int q = task - 128; g = 0; b = q >> 9; h = (q >> 6) & 7; qb = 63 - (q & 63); }
    const int P = g ? 2048 : 0, T = g ? 2112 : 2048, rowbase = g ? MP + b * 64 : b * 2048;
    const bf16_t* XAQ = (const bf16_t*)(a.ws + WS_XAQ); bf16_t* MIX = (bf16_t*)(a.ws + WS_MIXE);
    const bf16_t* Kb = g ? (const bf16_t*)(a.ws + WS_KBS) + (size_t)j * (SZ_KBS1 / 2) + (size_t)(b * 8 + h) * 2112 * 64 : (const bf16_t*)(a.ws + WS_KBP) + (size_t)(b * 8 + h) * 2048 * 64;
    const bf16_t* Vt = g ? (const bf16_t*)(a.ws + WS_VTS) + (size_t)j * (SZ_KBS1 / 2) + (size_t)(b * 8 + h) * 64 * 2112 : (const bf16_t*)(a.ws + WS_VTP) + (size_t)(b * 8 + h) * 64 * 2048;
    const int ql = lane & 31, hh = lane >> 5;
    const int rq = rowbase + 32 * qb + ql, tabs = P + 32 * qb + ql;
    bf16x8 qf[4];
#pragma unroll
    for (int ks = 0; ks < 4; ++ks) qf[ks] = *(const bf16x8*)(XAQ + (size_t)rq * 1536 + 1024 + h * 64 + 16 * ks + 8 * hh);
    f32x16 o0, o1;
#pragma unroll
    for (int i = 0; i < 16; ++i) { o0[i] = 0.f; o1[i] = 0.f; }
    float carry = 0.f;
    int kb = (P >> 5) + qb;
    bf16x8 kf[4];
#pragma unroll
    for (int ks = 0; ks < 4; ++ks) kf[ks] = *(const bf16x8*)(Kb + (size_t)(32 * kb + ql) * 64 + 16 * ks + 8 * hh);
    for (; kb >= 0; --kb) {
        u32x2 va[2][2][2];
#pragma unroll
        for (int dh = 0; dh < 2; ++dh)
#pragma unroll
            for (int s = 0; s < 2; ++s) { const bf16_t* p = Vt + (size_t)(32 * dh + ql) * T + 32 * kb + 16 * s + 4 * hh; va[dh][s][0] = *(const u32x2*)p; va[dh][s][1] = *(const u32x2*)(p + 8); }
        bf16x8 kn[4];
        if (kb > 0) {
#pragma unroll
            for (int ks = 0; ks < 4; ++ks) kn[ks] = *(const bf16x8*)(Kb + (size_t)(32 * (kb - 1) + ql) * 64 + 16 * ks + 8 * hh);
        } else {
#pragma unroll
            for (int ks = 0; ks < 4; ++ks) kn[ks] = kf[ks];
        }
        f32x16 st;
#pragma unroll
        for (int i = 0; i < 16; ++i) st[i] = 0.f;
#pragma unroll
        for (int ks = 0; ks < 4; ++ks) st = MFMA32(kf[ks], qf[ks], st);
        float z[16], lb[16];
#pragma unroll
        for (int i = 0; i < 16; ++i) {
            z[i] = st[i] * 0.125f;
            const float sp = fmaxf(z[i], 0.f) + __logf(1.f + __expf(-fabsf(z[i])));
            const bool ok = (32 * kb + crow(i, hh)) < tabs;
            lb[i] = ok ? -sp : 0.f;
        }
        float G[4], Gx[4];
#pragma unroll
        for (int q = 0; q < 4; ++q) { G[q] = (lb[4 * q] + lb[4 * q + 1]) + (lb[4 * q + 2] + lb[4 * q + 3]); Gx[q] = lane_xor(G[q], lane, 32); }
        float pv[16];
        float suf = carry;
#pragma unroll
        for (int q = 3; q >= 0; --q) {
            float tl = suf + (hh == 0 ? Gx[q] : 0.f);
#pragma unroll
            for (int ii = 3; ii >= 0; --ii) {
                const int i = 4 * q + ii;
                const bool ok = (32 * kb + crow(i, hh)) < tabs;
                pv[i] = ok ? __expf(z[i] + lb[i] + tl) : 0.f;
                tl += lb[i];
            }
            suf += G[q] + Gx[q];
        }
        carry = suf;
        bf16x8 pb[2];
#pragma unroll
        for (int s = 0; s < 2; ++s) {
            u32x4 w; w.x = pk2(pv[8 * s], pv[8 * s + 1]); w.y = pk2(pv[8 * s + 2], pv[8 * s + 3]); w.z = pk2(pv[8 * s + 4], pv[8 * s + 5]); w.w = pk2(pv[8 * s + 6], pv[8 * s + 7]);
            pb[s] = __builtin_bit_cast(bf16x8, w);
        }
#pragma unroll
        for (int s = 0; s < 2; ++s) {
            u32x4 w0; w0.x = va[0][s][0].x; w0.y = va[0][s][0].y; w0.z = va[0][s][1].x; w0.w = va[0][s][1].y;
            u32x4 w1; w1.x = va[1][s][0].x; w1.y = va[1][s][0].y; w1.z = va[1][s][1].x; w1.w = va[1][s][1].y;
            o0 = MFMA32(__builtin_bit_cast(bf16x8, w0), pb[s], o0);
            o1 = MFMA32(__builtin_bit_cast(bf16x8, w1), pb[s], o1);
        }
#pragma unroll
        for (int ks = 0; ks < 4; ++ks) kf[ks] = kn[ks];
        if (__all(carry < -104.f)) break;
    }
#pragma unroll
    for (int q = 0; q < 4; ++q) {
        u32x2 w; w.x = pk2(o0[4 * q], o0[4 * q + 1]); w.y = pk2(o0[4 * q + 2], o0[4 * q + 3]);
        *(u32x2*)(MIX + (size_t)rq * 1024 + 512 + h * 64 + 8 * q + 4 * hh) = w;
        w.x = pk2(o1[4 * q], o1[4 * q + 1]); w.y = pk2(o1[4 * q + 2], o1[4 * q + 3]);
        *(u32x2*)(MIX + (size_t)rq * 1024 + 512 + h * 64 + 32 + 8 * q + 4 * hh) = w;
    }
}

DI void ret_unit(const KArgs& a, int j, int g, int b, int h, int es, LAS unsigned char* lds, int wave, int lane) {
    const int L = g ? 64 : 2048, rowbase = g ? MP + b * 64 : b * 2048, nch = L >> 6;
    const bf16_t* VT = (const bf16_t*)(a.ws + WS_VT) + (g ? (size_t)MP * 2048 + ((size_t)(b * 4 + h) * 512 + es * 64) * 64 : ((size_t)(b * 4 + h) * 512 + es * 64) * 2048);
    const float lg2 = log2f(1.f - exp2f(-5.f - (float)h));
    const int l31 = lane & 31, hh = lane >> 5, w4 = wave & 3;
    constexpr int RTS = 264;
    LAS bf16_t* RT = (LAS bf16_t*)lds;
    if (wave < 4) {
        const bf16_t* QR = (const bf16_t*)(a.ws + WS_QR); const bf16_t* KR = (const bf16_t*)(a.ws + WS_KR); bf16_t* OB = (bf16_t*)(a.ws + WS_OB);
        const int et = w4 & 1, lt = w4 >> 1;
        const float xi = exp2f(lg2 * (float)(32 * lt + l31 + 1));
        __syncthreads();
        int buf = 0;
        for (int c = 0; c < nch; ++c) {
            const int t0 = c * 64;
            const int rl = rowbase + t0 + 32 * lt + l31;
            f32x16 st0, st1, oc, oi;
#pragma unroll
            for (int i = 0; i < 16; ++i) { st0[i] = 0.f; st1[i] = 0.f; oc[i] = 0.f; oi[i] = 0.f; }
            const bf16_t* qp = QR + (size_t)rl * 1024 + h * 256 + 8 * hh;
            const bf16_t* kp = KR + (size_t)(rowbase + t0 + l31) * 1024 + h * 256 + 8 * hh;
            const LAS bf16_t* rp = RT + buf * (64 * RTS) + (32 * et + l31) * RTS + 8 * hh;
#pragma unroll 2
            for (int ks = 0; ks < 16; ++ks) {
                const bf16x8 qf = *(const bf16x8*)(qp + 16 * ks);
                const bf16x8 k0 = *(const bf16x8*)(kp + 16 * ks), k1 = *(const bf16x8*)(kp + 32 * 1024 + 16 * ks);
                const bf16x8 rf = *(const LAS bf16x8*)(rp + 16 * ks);
                st0 = MFMA32(k0, qf, st0); st1 = MFMA32(k1, qf, st1);
                oc = MFMA32(rf, qf, oc);
            }
#pragma unroll
            for (int mt = 0; mt < 2; ++mt) {
                float p[16];
#pragma unroll
                for (int i = 0; i < 16; ++i) { const int mm = 32 * mt + crow(i, hh), ll = 32 * lt + l31; const float dd = (float)(mm > ll ? mm - ll : ll - mm); p[i] = (mt ? st1[i] : st0[i]) * exp2f(lg2 * dd); }
#pragma unroll
                for (int s = 0; s < 2; ++s) {
                    u32x4 w; w.x = pk2(p[8 * s], p[8 * s + 1]); w.y = pk2(p[8 * s + 2], p[8 * s + 3]); w.z = pk2(p[8 * s + 4], p[8 * s + 5]); w.w = pk2(p[8 * s + 6], p[8 * s + 7]);
                    const bf16_t* vp = VT + (size_t)(32 * et + l31) * L + t0 + 32 * mt + 16 * s + 4 * hh;
                    const u32x2 v0 = *(const u32x2*)vp, v1 = *(const u32x2*)(vp + 8);
                    u32x4 va; va.x = v0.x; va.y = v0.y; va.z = v1.x; va.w = v1.y;
                    oi = MFMA32(__builtin_bit_cast(bf16x8, va), __builtin_bit_cast(bf16x8, w), oi);
                }
            }
#pragma unroll
            for (int q = 0; q < 4; ++q) {
                u32x2 w; w.x = pk2(oi[4 * q] + xi * oc[4 * q], oi[4 * q + 1] + xi * oc[4 * q + 1]); w.y = pk2(oi[4 * q + 2] + xi * oc[4 * q + 2], oi[4 * q + 3] + xi * oc[4 * q + 3]);
                *(u32x2*)(OB + (size_t)rl * 2048 + h * 512 + es * 64 + 32 * et + 8 * q + 4 * hh) = w;
            }
            __syncthreads();
            buf ^= 1;
        }
        __syncthreads();
    } else {
        const bf16_t* KT = (const bf16_t*)(a.ws + WS_KT) + (g ? (size_t)MP * 1024 + (size_t)(b * 4 + h) * 256 * 64 : (size_t)(b * 4 + h) * 256 * 2048);
        f32x16 R[2][2];
#pragma unroll
        for (int x = 0; x < 2; ++x)
#pragma unroll
            for (int y = 0; y < 2; ++y)
#pragma unroll
                for (int i = 0; i < 16; ++i) R[x][y][i] = 0.f;
        if (g) {
            const float* R0 = a.in[8] + ((size_t)((j * 8 + b) * 4 + h) * 256) * 512 + es * 64;
#pragma unroll
            for (int dti = 0; dti < 2; ++dti)
#pragma unroll
                for (int et = 0; et < 2; ++et)
#pragma unroll
                    for (int q = 0; q < 4; ++q) {
                        const float* pp = R0 + (size_t)(32 * (2 * w4 + dti) + 8 * q + 4 * hh) * 512 + 32 * et + l31; asm volatile("" : "+v"(pp));
#pragma unroll
                        for (int ii = 0; ii < 4; ++ii) R[dti][et][4 * q + ii] = pp[ii * 512];
                    }
        }
#pragma unroll
        for (int dti = 0; dti < 2; ++dti)
#pragma unroll
            for (int et = 0; et < 2; ++et)
#pragma unroll
                for (int q = 0; q < 4; ++q) { u32x2 w; w.x = pk2(R[dti][et][4 * q], R[dti][et][4 * q + 1]); w.y = pk2(R[dti][et][4 * q + 2], R[dti][et][4 * q + 3]);
                    *(LAS u32x2*)(RT + (32 * et + l31) * RTS + 32 * (2 * w4 + dti) + 8 * q + 4 * hh) = w; }
        __syncthreads();
        const float g64 = exp2f(lg2 * 64.f);
        float z[8];
#pragma unroll
        for (int e = 0; e < 8; ++e) z[e] = exp2f(lg2 * (float)(63 - 8 * hh - e));
        const float ginv16 = exp2f(-16.f * lg2);
        int buf = 0;
        for (int c = 0; c < nch; ++c) {
            const int t0 = c * 64;
#pragma unroll
            for (int dti = 0; dti < 2; ++dti)
#pragma unroll
                for (int et = 0; et < 2; ++et)
#pragma unroll
                    for (int i = 0; i < 16; ++i) R[dti][et][i] *= g64;
            float zs = 1.f;
#pragma unroll
            for (int s = 0; s < 4; ++s) {
                const bf16x8 vb0 = *(const bf16x8*)(VT + (size_t)l31 * L + t0 + 16 * s + 8 * hh), vb1 = *(const bf16x8*)(VT + (size_t)(32 + l31) * L + t0 + 16 * s + 8 * hh);
#pragma unroll
                for (int dti = 0; dti < 2; ++dti) {
                    const u32x4 kw = *(const u32x4*)(KT + (size_t)(32 * (2 * w4 + dti) + l31) * L + t0 + 16 * s + 8 * hh);
                    u32x4 ks_; ks_.x = pk2(bflo(kw.x) * (z[0] * zs), bfhi(kw.x) * (z[1] * zs)); ks_.y = pk2(bflo(kw.y) * (z[2] * zs), bfhi(kw.y) * (z[3] * zs));
                    ks_.z = pk2(bflo(kw.z) * (z[4] * zs), bfhi(kw.z) * (z[5] * zs)); ks_.w = pk2(bflo(kw.w) * (z[6] * zs), bfhi(kw.w) * (z[7] * zs));
                    const bf16x8 ka = __builtin_bit_cast(bf16x8, ks_);
                    R[dti][0] = MFMA32(ka, vb0, R[dti][0]); R[dti][1] = MFMA32(ka, vb1, R[dti][1]);
                }
                zs *= ginv16;
            }
#pragma unroll
            for (int dti = 0; dti < 2; ++dti)
#pragma unroll
                for (int et = 0; et < 2; ++et)
#pragma unroll
                    for (int q = 0; q < 4; ++q) { u32x2 w; w.x = pk2(R[dti][et][4 * q], R[dti][et][4 * q + 1]); w.y = pk2(R[dti][et][4 * q + 2], R[dti][et][4 * q + 3]);
                        *(LAS u32x2*)(RT + (buf ^ 1) * (64 * RTS) + (32 * et + l31) * RTS + 32 * (2 * w4 + dti) + 8 * q + 4 * hh) = w; }
            __syncthreads();
            buf ^= 1;
        }
        float* Rout = a.out + (g ? O_RET_S : O_RET_P) + ((size_t)((j * 8 + b) * 4 + h) * 256) * 512 + es * 64;
#pragma unroll
        for (int dti = 0; dti < 2; ++dti)
#pragma unroll
            for (int et = 0; et < 2; ++et)
#pragma unroll
                for (int q = 0; q < 4; ++q) {
                    float* pp = Rout + (size_t)(32 * (2 * w4 + dti) + 8 * q + 4 * hh) * 512 + 32 * et + l31; asm volatile("" : "+v"(pp));
#pragma unroll
                    for (int ii = 0; ii < 4; ++ii) pp[ii * 512] = R[dti][et][4 * q + ii];
                }
        __syncthreads();
    }
}
DI void gn_phase(const KArgs& a, int gw, int NGW, int lane) {
    bf16_t* OB = (bf16_t*)(a.ws + WS_OB); const bf16_t* GG = (const bf16_t*)(a.ws + WS_GG);
    for (int it = gw; it < M * 4; it += NGW) {
        const size_t off = (size_t)(it >> 2) * 2048 + (it & 3) * 512 + lane * 8;
        const u32x4 ow = *(const u32x4*)(OB + off), gwv = *(const u32x4*)(GG + off);
        float o[8] = {bflo(ow.x), bfhi(ow.x), bflo(ow.y), bfhi(ow.y), bflo(ow.z), bfhi(ow.z), bflo(ow.w), bfhi(ow.w)};
        const float gg[8] = {bflo(gwv.x), bfhi(gwv.x), bflo(gwv.y), bfhi(gwv.y), bflo(gwv.z), bfhi(gwv.z), bflo(gwv.w), bfhi(gwv.w)};
        float s = 0.f;
#pragma unroll
        for (int e = 0; e < 8; ++e) s += o[e];
        const float mu = wave_sum(s, lane) * (1.f / 512.f);
        float v = 0.f;
#pragma unroll
        for (int e = 0; e < 8; ++e) { o[e] -= mu; v += o[e] * o[e]; }
        const float rstd = rsqrtf(wave_sum(v, lane) * (1.f / 512.f) + EPS);
        float y[8];
#pragma unroll
        for (int e = 0; e < 8; ++e) y[e] = gg[e] * sigmoidf_(gg[e]) * o[e] * rstd;
        u32x4 w; w.x = pk2(y[0], y[1]); w.y = pk2(y[2], y[3]); w.z = pk2(y[4], y[5]); w.w = pk2(y[6], y[7]);
        *(u32x4*)(OB + off) = w;
    }
}

DI void small_gemm_sample(const bf16_t* A, const bf16_t* Bt, int K, bf16_t* O, const bf16_t* PE, LAS unsigned char* lds, int tile, int wave, int lane) {
    const int tm = tile >> 4, tn = tile & 15, nh = wave & 1, kq = wave >> 1, l31 = lane & 31, hh = lane >> 5;
    const int kper = K >> 2;
    const bf16_t* ap = A + (size_t)(MP + 32 * tm + l31) * K + kq * kper + 8 * hh;
    const bf16_t* bp = Bt + (size_t)(64 * tn + 32 * nh + l31) * K + kq * kper + 8 * hh;
    f32x16 acc;
#pragma unroll
    for (int i = 0; i < 16; ++i) acc[i] = 0.f;
#pragma unroll 4
    for (int k = 0; k < kper; k += 16) {
        const bf16x8 av = *(const bf16x8*)(ap + k), bv = *(const bf16x8*)(bp + k);
        acc = MFMA32(av, bv, acc);
    }
    LAS float* red = (LAS float*)lds;
#pragma unroll
    for (int i = 0; i < 16; ++i) red[((kq * 2 + nh) * 16 + i) * 64 + lane] = acc[i];
    __syncthreads();
    {
        const int q = wave >> 1;
#pragma unroll
        for (int ii = 0; ii < 4; ++ii) {
            const int i = 4 * q + ii;
            float v = 0.f;
#pragma unroll
            for (int k4 = 0; k4 < 4; ++k4) v += red[((k4 * 2 + nh) * 16 + i) * 64 + lane];
            const size_t off = (size_t)(MP + 32 * tm + crow(i, hh)) * 1024 + 64 * tn + 32 * nh + l31;
            if (PE) v = sigmoidf_(v) * bf1(PE[off]);
            O[off] = (bf16_t)f2bf(v);
        }
    }
    __syncthreads();
}
#if REP_GEMM > 1
struct GOrder {
    pg8::StaticOrder b; int cnt;
    DI void init(int M_, int N_, int G_, int c_) { b.init(M_, N_, G_, c_); cnt = (b.nwg - c_ + G_ - 1) / G_; if (cnt < 0) cnt = 0; }
    DI bool next(int i, pg8::Unit& u) const { if (i >= cnt * REP_GEMM) return false; return b.next(i % cnt, u); }
    DI void a_ready(const pg8::Unit&) const {}
    DI void done(const pg8::Unit&) const {}
};
#else
typedef pg8::StaticOrder GOrder;
#endif
#define XB_TMO      128
#define XB_XCNT(j)  (256  + 64 * (j))
#define XB_XSUB(j)  (1280 + 64 * (j))
#define XB_XGEN(j)  (2304 + 64 * (j))
#define XB_TOP      3328
#define XB_TOPGEN   3392
#define XCD_BAR_WORDS 3456
#define XB_SPIN_CAP (1u << 18)

__device__ __forceinline__ unsigned xb_ld(unsigned* p)              { return __hip_atomic_load(p, __ATOMIC_RELAXED, __HIP_MEMORY_SCOPE_AGENT); }
__device__ __forceinline__ unsigned xb_add(unsigned* p, unsigned v) { return __hip_atomic_fetch_add(p, v, __ATOMIC_RELAXED, __HIP_MEMORY_SCOPE_AGENT); }
__device__ __forceinline__ unsigned xb_xcc_id() { return (unsigned)__builtin_amdgcn_s_getreg((3 << 11) | 20) & 0xFu; }
#define XB_SPIN(cond, bar) do { unsigned _sp = 0; while (cond) { __builtin_amdgcn_s_sleep(1); \
    if ((++_sp & 255u) == 0u) { if (xb_ld(&(bar)[XB_TMO])) break; if (_sp > XB_SPIN_CAP) { atomicAdd(&(bar)[XB_TMO], 1u); break; } } } } while (0)

struct XcdBarrier {
    unsigned* bar; unsigned x;
    volatile LAS unsigned* st;
};

__device__ __forceinline__ XcdBarrier xcd_barrier_post(unsigned* bar, volatile LAS unsigned* st) {
    XcdBarrier b; b.bar = bar; b.x = xb_xcc_id(); b.st = st;
    if (threadIdx.x == 0) (void)xb_add(&bar[XB_XCNT(b.x)], 1u);
    return b;
}
__device__ __forceinline__ void xcd_barrier_complete(unsigned* bar, unsigned x, unsigned& nloc, unsigned& nx) {
    const unsigned G = gridDim.x * gridDim.y * gridDim.z;
    unsigned sum, cnt, mine, sp = 0u;
    for (;;) {
        sum = 0u; cnt = 0u; mine = 0u;
#pragma unroll
        for (unsigned j = 0; j < 16; ++j) { const unsigned c = xb_ld(&bar[XB_XCNT(j)]); sum += c; cnt += (c > 0u) ? 1u : 0u; mine = (j == x) ? c : mine; }
        if (sum == G) break;
        __builtin_amdgcn_s_sleep(1);
        if ((++sp & 255u) == 0u) { if (xb_ld(&bar[XB_TMO])) break; if (sp > XB_SPIN_CAP) { atomicAdd(&bar[XB_TMO], 1u); break; } }
    }
    nloc = mine > 0u ? mine : 1u; nx = cnt > 0u ? cnt : 1u;
}

__device__ __forceinline__ void xcd_barrier(const XcdBarrier& b) {
    asm volatile("s_waitcnt vmcnt(0)" ::: "memory");
    __syncthreads();
    if (threadIdx.x == 0) {
        unsigned* bar = b.bar;
        __builtin_amdgcn_s_waitcnt(0);
        unsigned nloc = b.st[0], nx = b.st[1];
        if (nloc == 0u) { xcd_barrier_complete(bar, b.x, nloc, nx); b.st[0] = nloc; b.st[1] = nx; }
        const unsigned old = xb_add(&bar[XB_XSUB(b.x)], 1u);
        const unsigned gen = old / nloc;
        if (old + 1u == (gen + 1u) * nloc) {
            __builtin_amdgcn_fence(__ATOMIC_RELEASE, "agent");
            asm volatile("s_waitcnt vmcnt(0)" ::: "memory");
            const unsigned og = xb_add(&bar[XB_TOP], 1u);
            const unsigned tg = og / nx;
            if (og + 1u == (tg + 1u) * nx) xb_add(&bar[XB_TOPGEN], 1u);
            else XB_SPIN(xb_ld(&bar[XB_TOPGEN]) == tg, bar);
            __builtin_amdgcn_fence(__ATOMIC_ACQUIRE, "agent");
            xb_add(&bar[XB_XGEN(b.x)], 1u);
            asm volatile("s_waitcnt vmcnt(0)" ::: "memory");
        } else {
            XB_SPIN(xb_ld(&bar[XB_XGEN(b.x)]) == gen, bar);
            __builtin_amdgcn_fence(__ATOMIC_ACQUIRE, "agent");
            asm volatile("s_waitcnt vmcnt(0)" ::: "memory");
        }
    }
    __syncthreads();
}


__global__ void __launch_bounds__(NTHR, 2) hybrid_fwd(const KArgs a) {
    extern __shared__ __attribute__((aligned(16))) unsigned char lds_raw[];
    cg::grid_group grid = cg::this_grid();
    LAS unsigned char* lds = (LAS unsigned char*)lds_raw;
    if (threadIdx.x < 16) ((LAS unsigned*)(lds + LDS_BYTES - 64))[threadIdx.x] = 0u;
    __syncthreads();
    const int G = gridDim.x, bx = blockIdx.x;
    const int vcu = (G % 8 == 0) ? (bx % 8) * (G / 8) + bx / 8 : bx;
    const int NGW = G * 8, NGT = G * NTHR;

    {
        const int tid = threadIdx.x, lane = tid & 63, wave = __builtin_amdgcn_readfirstlane(tid >> 6);
        for (int r_ = 0; r_ < REP_PRO; ++r_) prologue_phase(a, lds, vcu, G, tid, wave, lane);
        rowwise_phase(a, nullptr, nullptr, 0.f, a.in[9], vcu * 8 + wave, NGW, lane);
    }
    grid.sync();

    const KArgs a0 = a;
    XcdBarrier xbar = xcd_barrier_post((unsigned*)(a.ws + WS_CTL + 16384), (volatile LAS unsigned*)(lds + LDS_BYTES - 64));
    const int wave0 = __builtin_amdgcn_readfirstlane((int)threadIdx.x >> 6);
    for (int step = 0; step < 20; ++step) {
        KArgs a = a0;
        asm volatile("" : "+s"(a.ws), "+s"(a.out));
        unsigned char* ws = a.ws; const float* normg = PAR(a, PO_NG);
        int tid, lane, wave, gw, gt, bxs;
#define LAUNDER() do { lane = (int)__builtin_amdgcn_mbcnt_hi(~0u, __builtin_amdgcn_mbcnt_lo(~0u, 0u)); bxs = bx; asm volatile("" : "+v"(lane), "+s"(bxs)); wave = wave0; tid = wave * 64 + lane; gw = vcu * 8 + wave; gt = vcu * NTHR + tid; } while (0)
        LAUNDER();
#define GSYNC() do { for (int r_ = 0; r_ < REP_SYNC; ++r_) xcd_barrier(xbar); LAUNDER(); } while (0)
        const int i = step / 5, sb = step % 5, j = i >> 1;
        const bool odd = (i & 1) != 0;
        const bf16_t* yA = nullptr; const bf16_t* yB = nullptr; int yK = 0; const bf16_t* yPE = nullptr; bf16_t* yO = (bf16_t*)(ws + WS_Y);
        if (sb == 0 || sb == 2) {
            const int mf = i * 2 + (sb >> 1);
            {
                pg8::Gemm gm{(const bf16_t*)(ws + WS_H), (const bf16_t*)(ws + WS_WGU + (size_t)mf * SZ_WGU1), M, 5632, 1024};
                GOrder S; S.init(M, 5632, G, bxs);
                EpiSwiGLU E{(bf16_t*)(ws + WS_ACT)};
                pg8::gemm_phase<EpiSwiGLU, GOrder, true, true>(lds, gm, S, E, wave0);
            }
            GSYNC();
            yA = (const bf16_t*)(ws + WS_ACT); yB = (const bf16_t*)(ws + WS_WDN + (size_t)mf * SZ_WDN1); yK = FF;
        } else if (sb == 1) {
            if (!odd) {
                {
                    pg8::Gemm gm{(const bf16_t*)(ws + WS_H), (const bf16_t*)(ws + WS_WABI + (size_t)j * SZ_WABI1), M, 2560, 1024};
                    GOrder S; S.init(M, 2560, G, bxs);
                    EpiAB E{(bf16_t*)(ws + WS_XAQ), (bf16_t*)(ws + WS_KBP), (bf16_t*)(ws + WS_VTP), (bf16_t*)(ws + WS_KBS + (size_t)j * SZ_KBS1), (bf16_t*)(ws + WS_VTS + (size_t)j * SZ_KBS1), a.out, j};
                    pg8::gemm_phase<EpiAB, GOrder, true, true>(lds, gm, S, E, wave0);
                }
                GSYNC();
                for (int r_ = 0; r_ < REP_MIX; ++r_) for (int u = vcu; u < 128; u += G) { const int g = u >> 6, q = u & 63; lru_unit(a, j, g, q >> 3, q & 7, lds, tid, wave, lane); }
                {
                    unsigned* ctr = (unsigned*)(ws + WS_CTL) + 64 * j;
                    for (;;) {
                        unsigned t = 0; if (lane == 0) t = atomicAdd(ctr, 1u);
                        t = __builtin_amdgcn_readfirstlane(t);
                        if (t >= 128u + 4096u) break;
                        sb_task(a, j, (int)t, lane);
                    }
                }
                GSYNC();
                yA = (const bf16_t*)(ws + WS_MIXE); yB = (const bf16_t*)(ws + WS_WABO + (size_t)j * SZ_W1K); yK = 1024;
            } else {
                {
                    pg8::Gemm gm{(const bf16_t*)(ws + WS_H), (const bf16_t*)(ws + WS_WCI + (size_t)j * SZ_WCI1), M, 6144, 1024};
                    GOrder S; S.init(M, 6144, G, bxs);
                    EpiC E{(bf16_t*)(ws + WS_QR), (bf16_t*)(ws + WS_KR), (bf16_t*)(ws + WS_KT), (bf16_t*)(ws + WS_VT), (bf16_t*)(ws + WS_GG), (const float*)(ws + WS_TAB), (const float*)(ws + WS_TAB + SZ_TAB1)};
                    pg8::gemm_phase<EpiC, GOrder, true, true>(lds, gm, S, E, wave0);
                }
                GSYNC();
                for (int r_ = 0; r_ < REP_MIX; ++r_) for (int u = vcu; u < 512; u += G) { const int g = u >> 8, q = u & 255; ret_unit(a, j, g, q >> 5, (q >> 3) & 3, q & 7, lds, wave, lane); }
                GSYNC();
                gn_phase(a, gw, NGW, lane);
                GSYNC();
                yA = (const bf16_t*)(ws + WS_OB); yB = (const bf16_t*)(ws + WS_WCO + (size_t)j * SZ_WCO1); yK = 2048;
            }
        } else if (sb == 3) {
            yA = (const bf16_t*)(ws + WS_PB); yB = (const bf16_t*)(ws + WS_WPI + (size_t)i * SZ_WPI1); yK = 256; yO = (bf16_t*)(ws + WS_PE);
        } else {
            yA = (const bf16_t*)(ws + WS_H); yB = (const bf16_t*)(ws + WS_WPG + (size_t)i * SZ_W1K); yK = 1024; yPE = (const bf16_t*)(ws + WS_PE);
        }
        {
            pg8::Gemm gm{yA, yB, MP, 1024, yK};
            GOrder S; S.init(MP, 1024, G, bxs);
            EpiY E{yO, yPE};
            pg8::gemm_phase<EpiY, GOrder, true, true>(lds, gm, S, E, wave0);
            LAUNDER();
            for (int r_ = 0; r_ < REP_GEMM; ++r_) for (int tl = vcu; tl < 256; tl += G) small_gemm_sample(yA, yB, yK, yO, yPE, lds, tl, wave, lane);
        }
        GSYNC();
        if (sb != 3) {
            const int nidx = (sb == 4) ? 3 : sb;
            const float* ga = normg + (size_t)(i * 8 + 2 * nidx + 1) * 1024;
            const float* gb = (step == 19) ? nullptr : normg + (size_t)(i * 8 + 2 * nidx + 2) * 1024;
            rowwise_phase(a, (const bf16_t*)(ws + WS_Y), ga, (nidx & 1) ? 1.f : 0.5f, gb, gw, NGW, lane);
            if (sb == 2) pconv_phase(a, i, gt, NGT);
            if (step != 19) GSYNC();
        }
    }
}

extern "C" void kernel_launch(void* const* d_in, const int* in_sizes, int n_in, void* d_out, int out_size, void* d_ws, size_t ws_size, hipStream_t stream) {
    static int grid = 0;
    if (grid == 0) {
        int dev = 0, cus = 0, per_cu = 0;
        if (hipGetDevice(&dev) != hipSuccess || hipDeviceGetAttribute(&cus, hipDeviceAttributeMultiprocessorCount, dev) != hipSuccess) { grid = -1; return; }
        if (hipFuncSetAttribute((const void*)hybrid_fwd, hipFuncAttributeMaxDynamicSharedMemorySize, LDS_BYTES) != hipSuccess) { fprintf(stderr, "hipFuncSetAttribute failed\n"); grid = -1; return; }
        if (hipOccupancyMaxActiveBlocksPerMultiprocessor(&per_cu, (const void*)hybrid_fwd, NTHR, LDS_BYTES) != hipSuccess || per_cu < 1) fprintf(stderr, "occupancy query: %d\n", per_cu);
        (void)hipGetLastError();
        grid = cus;
        if (n_in != 26 || (size_t)out_size != O_END || ws_size < WS_END) { fprintf(stderr, "kernel_launch: unexpected sizes n_in %d out %d ws %zu (need %zu)\n", n_in, out_size, ws_size, (size_t)WS_END); grid = -1; return; }
    }
    if (grid < 0) return;
    if (hipMemsetAsync((char*)d_ws + WS_CTL, 0, 32768, stream) != hipSuccess) { fprintf(stderr, "memset failed\n"); return; }
    KArgs a{};
    for (int i = 0; i < 26; ++i) a.in[i] = (const float*)d_in[i];
    a.out = (float*)d_out; a.ws = (unsigned char*)d_ws;
    void* args[] = {&a};
    hipError_t e = hipLaunchCooperativeKernel((void*)hybrid_fwd, dim3(grid), dim3(NTHR), args, LDS_BYTES, stream);
    if (e != hipSuccess) fprintf(stderr, "cooperative launch failed: %s (grid %d)\n", hipGetErrorString(e), grid);
}
```

```cpp
#include <hip/hip_runtime.h>
#include <hip/hip_cooperative_groups.h>
#include <cstdio>
#include <cstdint>
namespace cg = cooperative_groups;
#define REP_GEMM 1
#define REP_SYNC 1
#define REP_PRO 1
#define REP_MIX 1
namespace pg8 {
#define PG8_LAS __attribute__((address_space(3)))
typedef unsigned short bf16_t;
typedef short bf16x8 __attribute__((ext_vector_type(8)));
typedef float f32x4 __attribute__((ext_vector_type(4)));
typedef unsigned u32x4 __attribute__((ext_vector_type(4)));
constexpr int BM = 256, BK = 64, HALF = 128, HTB = HALF * BK * 2  , STAGE_BYTES = 8 * HTB, NXCD = 8, WGM = 8;

__host__ __device__ __forceinline__ int lds_byte(int r, int c) { const int st = (r >> 4) * 2 + (c >> 5), rr = r & 15, cc = c & 31, ob = rr * 64 + cc * 2; return st * 1024 + (ob ^ (((ob >> 9) & 1) << 5)); }
__host__ __device__ __forceinline__ void stage_rc(int b, int& R, int& C) { const int st = b / 1024, sb = b % 1024, swz = sb ^ (((sb >> 9) & 1) << 5); R = (st >> 1) * 16 + swz / 64; C = (st & 1) * 32 + (swz % 64) / 2; }
__host__ __device__ __forceinline__ int perm32(int rho) { const int n = rho >> 4, i = rho & 15; return 8 * (i >> 2) + 4 * n + (i & 3); }

struct Unit { int pm, pn; };
struct Gemm { const bf16_t* A; const bf16_t* Bt; int M, N, K; };

struct StaticOrder {
    int nM, nN, nwg, G, c;
    __host__ __device__ void init(int M, int N, int G_, int c_) { nM = M / BM; nN = N / BM; nwg = nM * nN; G = G_; c = c_; }
    __host__ __device__ bool next(int i, Unit& u) const {
        const long L = (long)i * G + c; if (L >= nwg) return false;
        int wgid = (int)L; { const int q = nwg / NXCD, r = nwg % NXCD, xcd = wgid % NXCD, off = wgid / NXCD; wgid = (xcd < r ? xcd * (q + 1) : r * (q + 1) + (xcd - r) * q) + off; }
        const int nig = WGM * nN, gid = wgid / nig, fm = gid * WGM, gsz = (nM - fm) < WGM ? (nM - fm) : WGM;
        u.pm = fm + ((wgid % nig) % gsz); u.pn = (wgid % nig) / gsz; return true;
    }
    __device__ __forceinline__ void a_ready(const Unit&) const {}
    __device__ __forceinline__ void done(const Unit&) const {}
};

__device__ __forceinline__ unsigned cvt_pk_bf16(float lo, float hi) { unsigned r; asm volatile("v_cvt_pk_bf16_f32 %0, %1, %2" : "=v"(r) : "v"(lo), "v"(hi)); return r; }
template <class Epi, class Sched, bool ALIGN_EPI = false, bool SP2 = false>
__device__ __forceinline__ void gemm_phase(PG8_LAS unsigned char* lds, const Gemm g, const Sched& S, const Epi& E, const int wave_id) {
    int tid_l = (int)__builtin_amdgcn_mbcnt_hi(~0u, __builtin_amdgcn_mbcnt_lo(~0u, 0u)); asm volatile("" : "+v"(tid_l)); tid_l += 64 * wave_id;
    const int tid = tid_l, wid = __builtin_amdgcn_readfirstlane(tid >> 6), lane = tid & 63, wr = wid >> 2, wc = wid & 3, fr = lane & 15, fq = lane >> 4;
    const int K = g.K, nt = K / BK;
    unsigned voffA[2], voffB[2];
#pragma unroll
    for (int i = 0; i < 2; ++i) { int R, C; stage_rc(tid * 16 + i * 8192, R, C); const int Rb = Epi::PERM ? ((R & ~31) + perm32(R & 31)) : R;
        voffA[i] = (unsigned)(R * K + C) * 2u; voffB[i] = (unsigned)(Rb * K + C) * 2u; }
    const size_t kstep = (size_t)(BK * 2);
    const size_t hstep = (size_t)HALF * K * 2;
    const size_t tstep = 2 * hstep;
    const unsigned ldsw = (unsigned)wid * 1024u;
    const int aoff = lds_byte(wr * 64 + fr, fq * 8), boff = lds_byte(wc * 32 + fr, fq * 8);
#define PG8_SA(b, h) (((b) * 2 + (h)) * HTB)
#define PG8_SB(b, h) ((4 + (b) * 2 + (h)) * HTB)
#define PG8_STAGE(bufoff, gbase, voff) do { _Pragma("unroll") for (int _i = 0; _i < 2; ++_i) \
        __builtin_amdgcn_global_load_lds((const unsigned*)((const char*)(gbase) + (voff)[_i]), (PG8_LAS unsigned*)(lds + (bufoff) + ldsw + _i * 8192), 16, 0, 0); } while (0)
#define PG8_LDA(dst, b, h) do { _Pragma("unroll") for (int m = 0; m < 4; ++m) _Pragma("unroll") for (int k = 0; k < 2; ++k) dst[m][k] = *(const PG8_LAS bf16x8*)(lds + PG8_SA(b, h) + aoff + m * 2048 + k * 1024); } while (0)
#define PG8_LDB(dst, b, h) do { _Pragma("unroll") for (int n = 0; n < 2; ++n) _Pragma("unroll") for (int k = 0; k < 2; ++k) dst[n][k] = *(const PG8_LAS bf16x8*)(lds + PG8_SB(b, h) + boff + n * 2048 + k * 1024); } while (0)
#define PG8_MMA(ai, bj, At, Bt) do { __builtin_amdgcn_s_setprio(1); _Pragma("unroll") for (int m = 0; m < 4; ++m) _Pragma("unroll") for (int n = 0; n < 2; ++n) _Pragma("unroll") for (int k = 0; k < 2; ++k) \
        acc[ai][bj][m][n] = __builtin_amdgcn_mfma_f32_16x16x32_bf16(Bt[n][k], At[m][k], acc[ai][bj][m][n], 0, 0, 0); __builtin_amdgcn_s_setprio(0); } while (0)
#define PG8_WAIT_V(n) asm volatile("s_waitcnt vmcnt(" #n ")" ::: "memory")
#define PG8_WAIT_L(n) asm volatile("s_waitcnt lgkmcnt(" #n ")" ::: "memory")
#define PG8_BAR __builtin_amdgcn_s_barrier()
#define PG8_SCHED __builtin_amdgcn_sched_barrier(0)
    Unit cur, nxt; int ui = 0;
    if (!S.next(0, cur)) return;
    f32x4 acc[2][2][4][2];
#pragma unroll
    for (int a = 0; a < 2; ++a)
#pragma unroll
        for (int b = 0; b < 2; ++b)
#pragma unroll
            for (int m = 0; m < 4; ++m)
#pragma unroll
                for (int n = 0; n < 2; ++n) acc[a][b][m][n] = (f32x4){0.f, 0.f, 0.f, 0.f};
    bf16x8 At[4][2], B0[2][2], B1[2][2];
    const char* cA = (const char*)g.A + (size_t)cur.pm * tstep; const char* cB = (const char*)g.Bt + (size_t)cur.pn * tstep;
    S.a_ready(cur);
    if constexpr (SP2) {
        PG8_STAGE(PG8_SB(0, 0), cB, voffB); PG8_STAGE(PG8_SB(0, 1), cB + hstep, voffB); PG8_STAGE(PG8_SA(0, 0), cA, voffA); PG8_STAGE(PG8_SA(0, 1), cA + hstep, voffA);
        if (wr == 1) PG8_BAR;
        PG8_WAIT_V(2); PG8_BAR;
        PG8_STAGE(PG8_SB(1, 0), cB + kstep, voffB); PG8_STAGE(PG8_SA(1, 0), cA + kstep, voffA); PG8_STAGE(PG8_SB(1, 1), cB + hstep + kstep, voffB);
        PG8_WAIT_V(6); PG8_BAR;
    } else {
        PG8_STAGE(PG8_SB(0, 0), cB, voffB); PG8_STAGE(PG8_SA(0, 0), cA, voffA); PG8_STAGE(PG8_SB(0, 1), cB + hstep, voffB); PG8_STAGE(PG8_SA(0, 1), cA + hstep, voffA);
        if (wr == 1) PG8_BAR;
        PG8_WAIT_V(4); PG8_BAR;
        PG8_STAGE(PG8_SB(1, 0), cB + kstep, voffB); PG8_STAGE(PG8_SA(1, 0), cA + kstep, voffA); PG8_STAGE(PG8_SB(1, 1), cB + hstep + kstep, voffB);
        PG8_WAIT_V(6); PG8_BAR;
    }
    for (;;) {
        const bool has_next = S.next(ui + 1, nxt);
        const char* nA = has_next ? (const char*)g.A + (size_t)nxt.pm * tstep : cA; const char* nB = has_next ? (const char*)g.Bt + (size_t)nxt.pn * tstep : cB;
        for (int t = 0; t < nt; t += 2) {
            const bool last = (t == nt - 2);
            const char* a1 = cA + (size_t)(t + 1) * kstep;
            const char* a2 = last ? nA : cA + (size_t)(t + 2) * kstep; const char* b2 = last ? nB : cB + (size_t)(t + 2) * kstep;
            const char* a3 = a2 + kstep; const char* b3 = b2 + kstep;
            if (last && has_next) S.a_ready(nxt);
            if constexpr (SP2) {
            PG8_LDB(B0, 0, 0); PG8_LDB(B1, 0, 1); PG8_SCHED; PG8_LDA(At, 0, 0); PG8_STAGE(PG8_SA(1, 1), a1 + hstep, voffA);
            PG8_WAIT_V(8); PG8_WAIT_L(0); PG8_BAR; PG8_MMA(0, 0, At, B0); PG8_MMA(0, 1, At, B1); PG8_BAR; PG8_SCHED;
            PG8_LDA(At, 0, 1); PG8_STAGE(PG8_SB(0, 0), b2, voffB); PG8_STAGE(PG8_SB(0, 1), b2 + hstep, voffB); PG8_STAGE(PG8_SA(0, 0), a2, voffA);
            PG8_WAIT_V(8); PG8_WAIT_L(0); PG8_BAR; PG8_MMA(1, 0, At, B0); PG8_MMA(1, 1, At, B1); PG8_BAR; PG8_SCHED;
            PG8_LDB(B0, 1, 0); PG8_LDB(B1, 1, 1); PG8_SCHED; PG8_LDA(At, 1, 0); PG8_STAGE(PG8_SA(0, 1), a2 + hstep, voffA);
            PG8_WAIT_V(8); PG8_WAIT_L(0); PG8_BAR; PG8_MMA(0, 0, At, B0); PG8_MMA(0, 1, At, B1); PG8_BAR; PG8_SCHED;
            PG8_LDA(At, 1, 1); PG8_STAGE(PG8_SB(1, 0), b3, voffB); PG8_STAGE(PG8_SB(1, 1), b3 + hstep, voffB); PG8_STAGE(PG8_SA(1, 0), a3, voffA);
            PG8_WAIT_V(8); PG8_WAIT_L(0); PG8_BAR; PG8_MMA(1, 0, At, B0); PG8_MMA(1, 1, At, B1); PG8_BAR; PG8_SCHED;
            } else {
            PG8_LDB(B0, 0, 0); PG8_SCHED; PG8_LDA(At, 0, 0); PG8_STAGE(PG8_SA(1, 1), a1 + hstep, voffA);
            PG8_WAIT_L(8); PG8_BAR; PG8_WAIT_L(0); PG8_MMA(0, 0, At, B0); PG8_BAR; PG8_SCHED;
            PG8_LDB(B1, 0, 1); PG8_STAGE(PG8_SB(0, 0), b2, voffB);
            PG8_BAR; PG8_WAIT_L(0); PG8_MMA(0, 1, At, B1); PG8_BAR;
            PG8_LDA(At, 0, 1); PG8_STAGE(PG8_SA(0, 0), a2, voffA);
            PG8_BAR; PG8_WAIT_L(0); PG8_MMA(1, 0, At, B0); PG8_BAR; PG8_SCHED;
            PG8_STAGE(PG8_SB(0, 1), b2 + hstep, voffB);
            PG8_WAIT_V(6); PG8_BAR; PG8_MMA(1, 1, At, B1); PG8_BAR;
            PG8_LDB(B0, 1, 0); PG8_SCHED; PG8_LDA(At, 1, 0); PG8_STAGE(PG8_SA(0, 1), a2 + hstep, voffA);
            PG8_WAIT_L(8); PG8_BAR; PG8_WAIT_L(0); PG8_MMA(0, 0, At, B0); PG8_BAR; PG8_SCHED;
            PG8_LDB(B1, 1, 1); PG8_STAGE(PG8_SB(1, 0), b3, voffB);
            PG8_BAR; PG8_WAIT_L(0); PG8_MMA(0, 1, At, B1); PG8_BAR;
            PG8_LDA(At, 1, 1); PG8_STAGE(PG8_SA(1, 0), a3, voffA);
            PG8_BAR; PG8_WAIT_L(0); PG8_MMA(1, 0, At, B0); PG8_BAR; PG8_SCHED;
            PG8_STAGE(PG8_SB(1, 1), b3 + hstep, voffB);
            PG8_WAIT_V(6); PG8_BAR; PG8_MMA(1, 1, At, B1); PG8_BAR;
            }
        }
        if constexpr (ALIGN_EPI) { if (wr == 0) PG8_BAR; }
        if constexpr (!Epi::AFTER_DRAIN) { Unit cu = cur; int fr_l = fr, fq_l = fq; asm volatile("" : "+s"(cu.pm), "+s"(cu.pn), "+v"(fr_l), "+v"(fq_l)); E(acc, cu, wr, wc, fr_l, fq_l); S.done(cur); }
        if (!has_next) break;
#pragma unroll
        for (int a = 0; a < 2; ++a)
#pragma unroll
            for (int b = 0; b < 2; ++b)
#pragma unroll
                for (int m = 0; m < 4; ++m)
#pragma unroll
                    for (int n = 0; n < 2; ++n) acc[a][b][m][n] = (f32x4){0.f, 0.f, 0.f, 0.f};
        cur = nxt; cA = nA; cB = nB; ++ui;
        if constexpr (ALIGN_EPI) { if (wr == 1) PG8_BAR; }
    }
    PG8_WAIT_V(0);
    if constexpr (!ALIGN_EPI) { if (wr == 0) PG8_BAR; }
    PG8_BAR;
    if constexpr (Epi::AFTER_DRAIN) { E.fused(acc, cur, wr, wc, fr, fq, lds, wid, lane); S.done(cur); }
#undef PG8_SA
#undef PG8_SB
#undef PG8_STAGE
#undef PG8_LDA
#undef PG8_LDB
#undef PG8_MMA
#undef PG8_WAIT_V
#undef PG8_WAIT_L
#undef PG8_BAR
#undef PG8_SCHED
}
}

#define LAS __attribute__((address_space(3)))
typedef unsigned short bf16_t;
typedef short bf16x8 __attribute__((ext_vector_type(8)));
typedef float f32x4 __attribute__((ext_vector_type(4)));
typedef float f32x2 __attribute__((ext_vector_type(2)));
typedef float f32x16 __attribute__((ext_vector_type(16)));
typedef unsigned u32x4 __attribute__((ext_vector_type(4)));
typedef unsigned u32x2 __attribute__((ext_vector_type(2)));
#define DI __device__ __forceinline__
#define MFMA32(a, b, c) __builtin_amdgcn_mfma_f32_32x32x16_bf16((a), (b), (c), 0, 0, 0)

constexpr int M = 16896, MP = 16384, D = 1024, FF = 2816;
constexpr float EPS = 1e-6f;
constexpr int NTHR = 512;
constexpr int LDS_BYTES = 136 * 1024;

constexpr size_t O_Y = 0;
constexpr size_t O_LRUH_P = (size_t)M * 1024;
constexpr size_t O_CONV_P = O_LRUH_P + 8192;
constexpr size_t O_SBK_P = O_CONV_P + 24576;
constexpr size_t O_SBV_P = O_SBK_P + 16777216;
constexpr size_t O_RET_P = O_SBV_P + 16777216;
constexpr size_t O_LRUH_S = O_RET_P + 8388608;
constexpr size_t O_CONV_S = O_LRUH_S + 8192;
constexpr size_t O_SBK_S = O_CONV_S + 24576;
constexpr size_t O_SBV_S = O_SBK_S + 524288;
constexpr size_t O_RET_S = O_SBV_S + 524288;
constexpr size_t O_END = O_RET_S + 8388608;

constexpr size_t SZ_M1K = (size_t)M * 1024 * 2;
constexpr size_t WS_CTL = 0;
constexpr size_t WS_PAR = 65536;
constexpr int PO_H0 = 0, PO_CST = PO_H0 + 8192, PO_NG = PO_CST + 24576, PO_CW = PO_NG + 32768, PO_CB = PO_CW + 4096, PO_WR = PO_CB + 1024, PO_BR = PO_WR + 65536,
              PO_WI = PO_BR + 1024, PO_BI = PO_WI + 65536, PO_LAM = PO_BI + 1024, PO_END = PO_LAM + 1024;
static_assert((size_t)PO_END * 4 + 65536 <= (1u << 20), "param block");
constexpr size_t WS_WGU = 1u << 20;
constexpr size_t SZ_WGU1 = (size_t)5632 * 1024 * 2;
constexpr size_t WS_WDN = WS_WGU + 8 * SZ_WGU1;
constexpr size_t SZ_WDN1 = (size_t)1024 * 2816 * 2;
constexpr size_t WS_WPG = WS_WDN + 8 * SZ_WDN1;
constexpr size_t SZ_W1K = (size_t)1024 * 1024 * 2;
constexpr size_t WS_WPI = WS_WPG + 4 * SZ_W1K;
constexpr size_t SZ_WPI1 = (size_t)1024 * 256 * 2;
constexpr size_t WS_WABI = WS_WPI + 4 * SZ_WPI1;
constexpr size_t SZ_WABI1 = (size_t)2560 * 1024 * 2;
constexpr size_t WS_WABO = WS_WABI + 2 * SZ_WABI1;
constexpr size_t WS_WCI = WS_WABO + 2 * SZ_W1K;
constexpr size_t SZ_WCI1 = (size_t)6144 * 1024 * 2;
constexpr size_t WS_WCO = WS_WCI + 2 * SZ_WCI1;
constexpr size_t SZ_WCO1 = (size_t)1024 * 2048 * 2;
constexpr size_t WS_H = WS_WCO + 2 * SZ_WCO1;
constexpr size_t WS_ACT = WS_H + SZ_M1K;
constexpr size_t WS_Y = WS_ACT + (size_t)M * 2816 * 2;
constexpr size_t WS_PE = WS_Y + SZ_M1K;
constexpr size_t WS_KBS = WS_PE + SZ_M1K;
constexpr size_t SZ_KBS1 = (size_t)64 * 2112 * 64 * 2;
constexpr size_t WS_VTS = WS_KBS + 2 * SZ_KBS1;
constexpr size_t WS_TAB = WS_VTS + 2 * SZ_KBS1;
constexpr size_t SZ_TAB1 = (size_t)2112 * 128 * 4;
constexpr size_t WS_MIX = WS_TAB + 2 * SZ_TAB1;
constexpr size_t WS_XAQ = WS_MIX;
constexpr size_t WS_KBP = WS_XAQ + (size_t)M * 1536 * 2;
constexpr size_t WS_VTP = WS_KBP + (size_t)64 * 2048 * 64 * 2;
constexpr size_t WS_MIXE = WS_VTP + (size_t)64 * 2048 * 64 * 2;
constexpr size_t WS_KR = WS_MIX;
constexpr size_t WS_GG = WS_KR + SZ_M1K;
constexpr size_t WS_KT = WS_GG + 2 * SZ_M1K;
constexpr size_t WS_VT = WS_KT + SZ_M1K;
constexpr size_t WS_END = WS_VT + 2 * SZ_M1K;
constexpr size_t WS_PB = WS_MIX;
constexpr size_t WS_QR = WS_Y;
constexpr size_t WS_OB = WS_ACT;

struct KArgs { const float* in[26]; float* out; unsigned char* ws; };
#define PAR(a_, off_) ((const float*)((a_).ws + WS_PAR) + (off_))

DI float lane_xor(float v, int lane, int o) { return __builtin_bit_cast(float, __builtin_amdgcn_ds_bpermute((lane ^ o) << 2, __builtin_bit_cast(int, v))); }
DI float wave_sum(float v, int lane) {
#pragma unroll
    for (int o = 1; o < 64; o <<= 1) v += lane_xor(v, lane, o);
    return v;
}
DI unsigned f2bf(float f) { unsigned u = __float_as_uint(f); return (u + 0x7fffu + ((u >> 16) & 1u)) >> 16; }
DI unsigned pk2(float lo, float hi) { return f2bf(lo) | (f2bf(hi) << 16); }
DI float bflo(unsigned w) { return __uint_as_float(w << 16); }
DI float bfhi(unsigned w) { return __uint_as_float(w & 0xffff0000u); }
DI float bf1(bf16_t h) { return __uint_as_float((unsigned)h << 16); }
DI float sigmoidf_(float x) { return __builtin_amdgcn_rcpf(1.f + __expf(-x)); }
DI void row_dec(int r, int& g, int& b, int& t) { if (r < MP) { g = 0; b = r >> 11; t = r & 2047; } else { g = 1; const int q = r - MP; b = q >> 6; t = q & 63; } }
DI int crow(int reg, int h) { return (reg & 3) + 8 * (reg >> 2) + 4 * h; }
#define WAVE_LDS_SYNC() do { asm volatile("s_waitcnt lgkmcnt(0)" ::: "memory"); __builtin_amdgcn_wave_barrier(); asm volatile("" ::: "memory"); } while (0)

using pg8::Unit;
typedef const f32x4 (&AccRef)[2][2][4][2];

struct EpiSwiGLU {
    static constexpr bool PERM = true, AFTER_DRAIN = false;
    bf16_t* O;
    DI void operator()(AccRef acc, const Unit& u, int wr, int wc, int fr, int fq) const {
        const int row0 = u.pm * 256 + wr * 64 + fr, col0 = u.pn * 128 + wc * 32 + 8 * fq;
#pragma unroll
        for (int ai = 0; ai < 2; ++ai)
#pragma unroll
            for (int m = 0; m < 4; ++m) {
                float v[8];
#pragma unroll
                for (int n = 0; n < 2; ++n)
#pragma unroll
                    for (int i = 0; i < 4; ++i) { const float g = acc[ai][0][m][n][i], up = acc[ai][1][m][n][i]; v[n * 4 + i] = g * up * sigmoidf_(g); }
                u32x4 w; w.x = pk2(v[0], v[1]); w.y = pk2(v[2], v[3]); w.z = pk2(v[4], v[5]); w.w = pk2(v[6], v[7]);
                *(u32x4*)(O + (size_t)(row0 + ai * 128 + m * 16) * FF + col0) = w;
            }
    }
};
struct EpiY {
    static constexpr bool PERM = true, AFTER_DRAIN = false;
    bf16_t* O; const bf16_t* PE;
    DI void operator()(AccRef acc, const Unit& u, int wr, int wc, int fr, int fq) const {
        const int row0 = u.pm * 256 + wr * 64 + fr, col0 = u.pn * 256 + wc * 32 + 8 * fq;
#pragma unroll
        for (int ai = 0; ai < 2; ++ai)
#pragma unroll
            for (int m = 0; m < 4; ++m)
#pragma unroll
                for (int bj = 0; bj < 2; ++bj) {
                    const size_t off = (size_t)(row0 + ai * 128 + m * 16) * 1024 + col0 + bj * 128;
                    f32x4 v0 = acc[ai][bj][m][0], v1 = acc[ai][bj][m][1];
                    if (PE) {
                        const u32x4 p = *(const u32x4*)(PE + off);
                        v0[0] = sigmoidf_(v0[0]) * bflo(p.x); v0[1] = sigmoidf_(v0[1]) * bfhi(p.x); v0[2] = sigmoidf_(v0[2]) * bflo(p.y); v0[3] = sigmoidf_(v0[3]) * bfhi(p.y);
                        v1[0] = sigmoidf_(v1[0]) * bflo(p.z); v1[1] = sigmoidf_(v1[1]) * bfhi(p.z); v1[2] = sigmoidf_(v1[2]) * bflo(p.w); v1[3] = sigmoidf_(v1[3]) * bfhi(p.w);
                    }
                    u32x4 w; w.x = pk2(v0[0], v0[1]); w.y = pk2(v0[2], v0[3]); w.z = pk2(v1[0], v1[1]); w.w = pk2(v1[2], v1[3]);
                    *(u32x4*)(O + off) = w;
                }
    }
};
struct EpiAB {
    static constexpr bool PERM = true, AFTER_DRAIN = false;
    bf16_t* XAQ; bf16_t* KBP; bf16_t* VTP; bf16_t* KBS; bf16_t* VTS; float* out; int j;
    DI void operator()(AccRef acc, const Unit& u, int wr, int wc, int fr, int fq) const {
        const int row0 = u.pm * 256 + wr * 64 + fr, offc = wc * 32 + 8 * fq;
        if (u.pn < 6) {
#pragma unroll
            for (int ai = 0; ai < 2; ++ai)
#pragma unroll
                for (int m = 0; m < 4; ++m)
#pragma unroll
                    for (int bj = 0; bj < 2; ++bj) {
                        const f32x4 v0 = acc[ai][bj][m][0], v1 = acc[ai][bj][m][1];
                        u32x4 w; w.x = pk2(v0[0], v0[1]); w.y = pk2(v0[2], v0[3]); w.z = pk2(v1[0], v1[1]); w.w = pk2(v1[2], v1[3]);
                        *(u32x4*)(XAQ + (size_t)(row0 + ai * 128 + m * 16) * 1536 + u.pn * 256 + bj * 128 + offc) = w;
                    }
        } else {
            const bool isv = u.pn >= 8;
#pragma unroll
            for (int ai = 0; ai < 2; ++ai)
#pragma unroll
                for (int m = 0; m < 4; ++m) {
                    const int r = row0 + ai * 128 + m * 16; int g, b, t; row_dec(r, g, b, t);
                    float* of = out + (g ? (isv ? O_SBV_S : O_SBK_S) + (size_t)j * (512 * 512) + (size_t)(r - MP) * 512
                                         : (isv ? O_SBV_P : O_SBK_P) + (size_t)j * ((size_t)MP * 512) + (size_t)r * 512);
#pragma unroll
                    for (int bj = 0; bj < 2; ++bj) {
                        const int c = ((u.pn & 1) * 256) + bj * 128 + offc, head = c >> 6, d = c & 63;
                        const f32x4 v0 = acc[ai][bj][m][0], v1 = acc[ai][bj][m][1];
                        *(f32x4*)(of + c) = v0; *(f32x4*)(of + c + 4) = v1;
                        if (!isv) {
                            u32x4 w; w.x = pk2(v0[0], v0[1]); w.y = pk2(v0[2], v0[3]); w.z = pk2(v1[0], v1[1]); w.w = pk2(v1[2], v1[3]);
                            bf16_t* kb = g ? KBS + ((size_t)(b * 8 + head) * 2112 + 2048 + t) * 64 + d : KBP + ((size_t)(b * 8 + head) * 2048 + t) * 64 + d;
                            *(u32x4*)kb = w;
                        } else {
                            const size_t T = g ? 2112 : 2048;
                            bf16_t* vt = g ? VTS + ((size_t)(b * 8 + head) * 64 + d) * 2112 + 2048 + t : VTP + ((size_t)(b * 8 + head) * 64 + d) * 2048 + t;
#pragma unroll
                            for (int i = 0; i < 4; ++i) { vt[(size_t)i * T] = (bf16_t)f2bf(v0[i]); vt[(size_t)(4 + i) * T] = (bf16_t)f2bf(v1[i]); }
                        }
                    }
                }
        }
    }
};
struct EpiC {
    static constexpr bool PERM = true, AFTER_DRAIN = false;
    bf16_t* QR; bf16_t* KR; bf16_t* KT; bf16_t* VT; bf16_t* GG; const float* ctab; const float* stab;
    DI void operator()(AccRef acc, const Unit& u, int wr, int wc, int fr, int fq) const {
        const int row0 = u.pm * 256 + wr * 64 + fr, offc = wc * 32 + 8 * fq;
        if (u.pn < 8) {
            const bool isk = u.pn >= 4; const int head = u.pn & 3; const float sc = isk ? 0.0625f : 1.f;
            bf16_t* dst = isk ? KR : QR;
#pragma unroll
            for (int ai = 0; ai < 2; ++ai)
#pragma unroll
                for (int m = 0; m < 4; ++m) {
                    const int r = row0 + ai * 128 + m * 16; int g, b, t; row_dec(r, g, b, t);
                    const int pos = g ? 2048 + t : t;
                    const size_t T = g ? 64 : 2048;
                    bf16_t* kt = g ? KT + (size_t)MP * 1024 + ((size_t)(b * 4 + head) * 256 + offc) * 64 + t : KT + ((size_t)(b * 4 + head) * 256 + offc) * 2048 + t;
#pragma unroll
                    for (int n = 0; n < 2; ++n) {
                        const f32x4 cc = *(const f32x4*)(ctab + pos * 128 + offc + 4 * n), ss = *(const f32x4*)(stab + pos * 128 + offc + 4 * n);
                        const f32x4 x1 = acc[ai][0][m][n] * sc, x2 = acc[ai][1][m][n] * sc;
                        const f32x4 ra = x1 * cc - x2 * ss, rb = x2 * cc + x1 * ss;
                        u32x2 w1, w2; w1.x = pk2(ra[0], ra[1]); w1.y = pk2(ra[2], ra[3]); w2.x = pk2(rb[0], rb[1]); w2.y = pk2(rb[2], rb[3]);
                        *(u32x2*)(dst + (size_t)r * 1024 + head * 256 + offc + 4 * n) = w1;
                        *(u32x2*)(dst + (size_t)r * 1024 + head * 256 + 128 + offc + 4 * n) = w2;
                        if (isk) {
#pragma unroll
                            for (int i = 0; i < 4; ++i) { kt[(size_t)(4 * n + i) * T] = (bf16_t)(w1[i >> 1] >> (16 * (i & 1))); kt[(size_t)(128 + 4 * n + i) * T] = (bf16_t)(w2[i >> 1] >> (16 * (i & 1))); }
                        }
                        asm volatile("" ::: "memory");
                    }
                }
        } else if (u.pn < 16) {
#pragma unroll
            for (int ai = 0; ai < 2; ++ai)
#pragma unroll
                for (int m = 0; m < 4; ++m) {
                    const int r = row0 + ai * 128 + m * 16; int g, b, t; row_dec(r, g, b, t);
                    const size_t T = g ? 64 : 2048;
#pragma unroll
                    for (int bj = 0; bj < 2; ++bj) {
                        const int eg = (u.pn - 8) * 256 + bj * 128 + offc, head = eg >> 9, e = eg & 511;
                        bf16_t* vt = g ? VT + (size_t)MP * 2048 + ((size_t)(b * 4 + head) * 512 + e) * 64 + t : VT + ((size_t)(b * 4 + head) * 512 + e) * 2048 + t;
                        const f32x4 v0 = acc[ai][bj][m][0], v1 = acc[ai][bj][m][1];
#pragma unroll
                        for (int i = 0; i < 4; ++i) { vt[(size_t)i * T] = (bf16_t)f2bf(v0[i]); vt[(size_t)(4 + i) * T] = (bf16_t)f2bf(v1[i]); }
                    }
                }
        } else {
#pragma unroll
            for (int ai = 0; ai < 2; ++ai)
#pragma unroll
                for (int m = 0; m < 4; ++m)
#pragma unroll
                    for (int bj = 0; bj < 2; ++bj) {
                        const f32x4 v0 = acc[ai][bj][m][0], v1 = acc[ai][bj][m][1];
                        u32x4 w; w.x = pk2(v0[0], v0[1]); w.y = pk2(v0[2], v0[3]); w.z = pk2(v1[0], v1[1]); w.w = pk2(v1[2], v1[3]);
                        *(u32x4*)(GG + (size_t)(row0 + ai * 128 + m * 16) * 2048 + (u.pn - 16) * 256 + bj * 128 + offc) = w;
                    }
        }
    }
};

DI void tr_item(const float* in, size_t ldi, bf16_t* out, size_t ldo, int k0, int n0, int drow0, LAS float* scr, int lane) {
#pragma unroll 8
    for (int i = 0; i < 32; ++i) { const int kk = 2 * i + (lane >> 5); scr[kk * 33 + (lane & 31)] = in[(size_t)(k0 + kk) * ldi + n0 + (lane & 31)]; }
    WAVE_LDS_SYNC();
    const int c = lane & 7;
#pragma unroll
    for (int jj = 0; jj < 4; ++jj) { const int n = (lane >> 3) + 8 * jj; const LAS float* s = scr + (8 * c) * 33 + n;
        u32x4 o; o.x = pk2(s[0 * 33], s[1 * 33]); o.y = pk2(s[2 * 33], s[3 * 33]); o.z = pk2(s[4 * 33], s[5 * 33]); o.w = pk2(s[6 * 33], s[7 * 33]);
        *(u32x4*)(out + (size_t)(drow0 + n) * ldo + k0 + 8 * c) = o; }
    WAVE_LDS_SYNC();
}
DI void tr_plain(const float* W, int K, int N, bf16_t* WT, int it, LAS float* scr, int lane) {
    const int nblk = N / 32, kb = it / nblk, nb = it % nblk;
    tr_item(W, (size_t)N, WT, (size_t)K, kb * 64, nb * 32, nb * 32, scr, lane);
}

DI void prologue_phase(const KArgs& a, LAS unsigned char* lds, int vcu, int G, int tid, int wave, int lane) {
    unsigned char* ws = a.ws;
    LAS float* scr = (LAS float*)(lds + wave * 8704);
    const int gw = vcu * 8 + wave, NGW = G * 8;
    if (blockIdx.x == 0 && tid < 64) ((unsigned*)(ws + WS_CTL))[tid * 64] = 0u;
    constexpr int I_FFN = 1408, N_FFN = 8 * 3 * I_FFN;
    constexpr int I_PG = 512, I_PI = 128, I_ABI = 1280, I_ABO = 512, I_CI = 3072, I_CO = 1024, I_CV = 64;
    constexpr int E0 = N_FFN, E1 = E0 + 4 * I_PG, E2 = E1 + 4 * I_PI, E3 = E2 + 2 * I_ABI, E4 = E3 + 2 * I_ABO, E5 = E4 + 2 * I_CI, E6 = E5 + 2 * I_CO, E7 = E6 + 128 * I_CV;
    for (int it = gw; it < E7; it += NGW) {
        if (it < E0) {
            const int mf = it / (3 * I_FFN), r = it % (3 * I_FFN), kind = r / I_FFN, q = r % I_FFN;
            if (kind < 2) {
                const float* W = a.in[10 + kind] + (size_t)mf * 1024 * FF;
                const int kb = q / 88, nb = q % 88, n0 = nb * 32;
                tr_item(W, FF, (bf16_t*)(ws + WS_WGU + (size_t)mf * SZ_WGU1), 1024, kb * 64, n0, (n0 >> 7) * 256 + kind * 128 + (n0 & 127), scr, lane);
            } else {
                tr_plain(a.in[12] + (size_t)mf * FF * 1024, FF, 1024, (bf16_t*)(ws + WS_WDN + (size_t)mf * SZ_WDN1), q, scr, lane);
            }
        } else if (it < E1) { const int q = it - E0, l = q / I_PG; tr_plain(a.in[14] + (size_t)l * 1024 * 1024, 1024, 1024, (bf16_t*)(ws + WS_WPG + (size_t)l * SZ_W1K), q % I_PG, scr, lane); }
        else if (it < E2) { const int q = it - E1, l = q / I_PI; tr_plain(a.in[13] + (size_t)l * 256 * 1024, 256, 1024, (bf16_t*)(ws + WS_WPI + (size_t)l * SZ_WPI1), q % I_PI, scr, lane); }
        else if (it < E3) { const int q = it - E2, l = q / I_ABI; tr_plain(a.in[15] + (size_t)l * 1024 * 2560, 1024, 2560, (bf16_t*)(ws + WS_WABI + (size_t)l * SZ_WABI1), q % I_ABI, scr, lane); }
        else if (it < E4) { const int q = it - E3, l = q / I_ABO; tr_plain(a.in[16] + (size_t)l * 1024 * 1024, 1024, 1024, (bf16_t*)(ws + WS_WABO + (size_t)l * SZ_W1K), q % I_ABO, scr, lane); }
        else if (it < E5) { const int q = it - E4, l = q / I_CI; tr_plain(a.in[24] + (size_t)l * 1024 * 6144, 1024, 6144, (bf16_t*)(ws + WS_WCI + (size_t)l * SZ_WCI1), q % I_CI, scr, lane); }
        else if (it < E6) { const int q = it - E5, l = q / I_CO; tr_plain(a.in[25] + (size_t)l * 2048 * 1024, 2048, 1024, (bf16_t*)(ws + WS_WCO + (size_t)l * SZ_WCO1), q % I_CO, scr, lane); }
        else {
            const int q = it - E6, jbh = q / I_CV, r = q % I_CV, jb = jbh >> 3, h = jbh & 7, kb = r >> 1, nb = r & 1;
            tr_item(a.in[7] + (size_t)jb * 2048 * 512 + h * 64, 512, (bf16_t*)(ws + WS_VTS) + (size_t)jbh * 64 * 2112, 2112, kb * 64, nb * 32, nb * 32, scr, lane);
        }
    }
    const int gt = vcu * NTHR + tid, NGT = G * NTHR;
    {
        float* par = (float*)(ws + WS_PAR);
        for (int it = gt; it < PO_END; it += NGT) {
            float v;
            if (it < PO_CST) v = a.in[4][it - PO_H0]; else if (it < PO_NG) v = a.in[5][it - PO_CST]; else if (it < PO_CW) v = a.in[9][it - PO_NG];
            else if (it < PO_CB) v = a.in[17][it - PO_CW]; else if (it < PO_WR) v = a.in[18][it - PO_CB]; else if (it < PO_BR) v = a.in[19][it - PO_WR];
            else if (it < PO_WI) v = a.in[20][it - PO_BR]; else if (it < PO_BI) v = a.in[21][it - PO_WI]; else if (it < PO_LAM) v = a.in[22][it - PO_BI];
            else v = a.in[23][it - PO_LAM];
            par[it] = v;
        }
    }
    for (int it = gt; it < 2 * 8 * 2048 * 64; it += NGT) {
        const int d8 = it & 7, h = (it >> 3) & 7, t = (it >> 6) & 2047, jb = it >> 17;
        const float* s = a.in[6] + ((size_t)(jb * 2048 + t) * 512 + h * 64 + d8 * 8);
        const f32x4 v0 = *(const f32x4*)s, v1 = *(const f32x4*)(s + 4);
        u32x4 w; w.x = pk2(v0[0], v0[1]); w.y = pk2(v0[2], v0[3]); w.z = pk2(v1[0], v1[1]); w.w = pk2(v1[2], v1[3]);
        *(u32x4*)((bf16_t*)(ws + WS_KBS) + ((size_t)(jb * 8 + h) * 2112 + t) * 64 + d8 * 8) = w;
    }
    for (int it = gt; it < 2112 * 128; it += NGT) {
        const int pos = it >> 7, jf = it & 127;
        const float freq = exp2f(-(float)jf * (13.287712379549449f / 128.f));
        const float ang = (float)pos * freq;
        const double rev = (double)ang * 0.15915494309189535; const float fr = (float)(rev - floor(rev));
        ((float*)(ws + WS_TAB))[it] = __builtin_amdgcn_cosf(fr); ((float*)(ws + WS_TAB + SZ_TAB1))[it] = __builtin_amdgcn_sinf(fr);
    }
}
DI void pconv_phase(const KArgs& a, int l, int gt, int NGT) {
    bf16_t* PB = (bf16_t*)(a.ws + WS_PB);
    for (int it = gt; it < M * 32; it += NGT) {
        const int r = it >> 5, c8 = (it & 31) * 8;
        const float* s = (r < MP) ? a.in[2] + ((size_t)l * MP + r) * 256 + c8 : a.in[3] + ((size_t)l * 512 + (r - MP)) * 256 + c8;
        const f32x4 v0 = *(const f32x4*)s, v1 = *(const f32x4*)(s + 4);
        u32x4 w; w.x = pk2(v0[0], v0[1]); w.y = pk2(v0[2], v0[3]); w.z = pk2(v1[0], v1[1]); w.w = pk2(v1[2], v1[3]);
        *(u32x4*)(PB + (size_t)r * 256 + c8) = w;
    }
}
DI void rowwise_phase(const KArgs& a, const bf16_t* Y, const float* ga, float c, const float* gb, int gw, int NGW, int lane) {
    float* X = a.out; bf16_t* H = (bf16_t*)(a.ws + WS_H);
    for (int r = gw; r < M; r += NGW) {
        f32x4 x[4]; float ss = 0.f;
        if (Y) {
            f32x4 y[4];
#pragma unroll
            for (int q = 0; q < 4; ++q) { const int col = 4 * lane + 256 * q; const u32x2 w = *(const u32x2*)(Y + (size_t)r * 1024 + col);
                y[q] = (f32x4){bflo(w.x), bfhi(w.x), bflo(w.y), bfhi(w.y)}; x[q] = *(const f32x4*)(X + (size_t)r * 1024 + col);
                ss += (y[q][0] * y[q][0] + y[q][1] * y[q][1]) + (y[q][2] * y[q][2] + y[q][3] * y[q][3]); }
            const float rs = c * rsqrtf(wave_sum(ss, lane) * (1.f / 1024.f) + EPS);
#pragma unroll
            for (int q = 0; q < 4; ++q) { const int col = 4 * lane + 256 * q; const f32x4 g = *(const f32x4*)(ga + col); x[q] = x[q] + y[q] * g * rs; *(f32x4*)(X + (size_t)r * 1024 + col) = x[q]; }
        } else {
            const float* src = (r < MP) ? a.in[0] + (size_t)r * 1024 : a.in[1] + (size_t)(r - MP) * 1024;
#pragma unroll
            for (int q = 0; q < 4; ++q) { const int col = 4 * lane + 256 * q; x[q] = *(const f32x4*)(src + col); *(f32x4*)(X + (size_t)r * 1024 + col) = x[q]; }
        }
        if (gb) {
            float s2 = 0.f;
#pragma unroll
            for (int q = 0; q < 4; ++q) s2 += (x[q][0] * x[q][0] + x[q][1] * x[q][1]) + (x[q][2] * x[q][2] + x[q][3] * x[q][3]);
            const float rs2 = rsqrtf(wave_sum(s2, lane) * (1.f / 1024.f) + EPS);
#pragma unroll
            for (int q = 0; q < 4; ++q) { const int col = 4 * lane + 256 * q; const f32x4 g = *(const f32x4*)(gb + col); const f32x4 h = x[q] * g * rs2;
                u32x2 w; w.x = pk2(h[0], h[1]); w.y = pk2(h[2], h[3]); *(u32x2*)(H + (size_t)r * 1024 + col) = w; }
        }
    }
}
DI float lru_ldx(const bf16_t* XAQ, const float* cst, int g, int L, int rowbase, int ch, int t) {
    if (t >= 0) return (t < L) ? bf1(XAQ[(size_t)(rowbase + t) * 1536 + ch]) : 0.f;
    return g ? cst[(size_t)(3 + t) * 512] : 0.f;
}
DI void lru_unit(const KArgs& a, int j, int g, int b, int hb, LAS unsigned char* lds, int tid, int wave, int lane) {
    const bf16_t* XAQ = (const bf16_t*)(a.ws + WS_XAQ); bf16_t* MIX = (bf16_t*)(a.ws + WS_MIXE);
    const int L = g ? 64 : 2048, rowbase = g ? MP + b * 64 : b * 2048;
    LAS float* XC = (LAS float*)lds;
    LAS float* AA = XC + 128 * 65;
    LAS float* UU = AA + 128 * 64;
    LAS float* SEG = UU + 128 * 64;
    const int c = tid & 63, seg = tid >> 6, ch = hb * 64 + c;
    const float* cw = PAR(a, PO_CW) + (size_t)j * 4 * 512 + ch;
    const float w0 = cw[0], w1 = cw[512], w2 = cw[1024], w3 = cw[1536], cb = PAR(a, PO_CB)[j * 512 + ch];
    const int tb = wave >> 1, chh = wave & 1, hh = lane >> 5, oc = chh * 32 + (lane & 31);
    bf16x8 Wr[4], Wi[4];
    {
        const float* wr_ = PAR(a, PO_WR) + ((size_t)(j * 8 + hb) * 64) * 64 + oc; const float* wi_ = PAR(a, PO_WI) + ((size_t)(j * 8 + hb) * 64) * 64 + oc;
#pragma unroll
        for (int ks = 0; ks < 4; ++ks)
#pragma unroll
            for (int e = 0; e < 8; ++e) { const int i = 16 * ks + 8 * hh + e; Wr[ks][e] = (short)f2bf(wr_[(size_t)i * 64]); Wi[ks][e] = (short)f2bf(wi_[(size_t)i * 64]); }
    }
    const float br = PAR(a, PO_BR)[j * 512 + hb * 64 + oc], bi = PAR(a, PO_BI)[j * 512 + hb * 64 + oc];
    const float lam = PAR(a, PO_LAM)[j * 512 + hb * 64 + oc];
    const float spl = (lam > 0.f ? 0.f : -lam) + log1pf(__expf(-fabsf(lam)));
    float carry = g ? PAR(a, PO_H0)[(size_t)(j * 8 + b) * 512 + ch] : 0.f;
    const float* cst = PAR(a, PO_CST) + (size_t)(j * 8 + b) * 3 * 512 + ch;
    const int nchunk = (L + 127) / 128;
    for (int ck = 0; ck < nchunk; ++ck) {
        const int t0 = ck * 128;
        {
            float xm3, xm2, xm1;
            const int ts = t0 + 16 * seg;
#define ldx(t_) lru_ldx(XAQ, cst, g, L, rowbase, ch, (t_))
            xm3 = ldx(ts - 3); xm2 = ldx(ts - 2); xm1 = ldx(ts - 1);
#pragma unroll 4
            for (int q = 0; q < 16; ++q) { const float x0 = ldx(ts + q); XC[(16 * seg + q) * 65 + c] = cb + w0 * xm3 + w1 * xm2 + w2 * xm1 + w3 * x0; xm3 = xm2; xm2 = xm1; xm1 = x0; }
#undef ldx
        }
        __syncthreads();
        {
            f32x16 ar, ai;
#pragma unroll
            for (int i = 0; i < 16; ++i) { ar[i] = 0.f; ai[i] = 0.f; }
            const int tokA = 32 * tb + (lane & 31);
#pragma unroll
            for (int ks = 0; ks < 4; ++ks) {
                bf16x8 A; const LAS float* s = XC + tokA * 65 + 16 * ks + 8 * hh;
#pragma unroll
                for (int e = 0; e < 8; ++e) A[e] = (short)f2bf(s[e]);
                ar = MFMA32(A, Wr[ks], ar); ai = MFMA32(A, Wi[ks], ai);
            }
#pragma unroll
            for (int i = 0; i < 16; ++i) {
                const int tl = 32 * tb + crow(i, hh);
                const float rg = sigmoidf_(ar[i] + br), ig = sigmoidf_(ai[i] + bi);
                const float la = -8.f * rg * spl;
                float av = __expf(la), uv = sqrtf(-expm1f(2.f * la)) * ig * XC[tl * 65 + oc];
                if (t0 + tl >= L) { av = 1.f; uv = 0.f; }
                AA[tl * 64 + oc] = av; UU[tl * 64 + oc] = uv;
            }
        }
        __syncthreads();
        {
            float A = 1.f, Hh = 0.f;
#pragma unroll 4
            for (int q = 0; q < 16; ++q) { const float av = AA[(16 * seg + q) * 64 + c], uv = UU[(16 * seg + q) * 64 + c]; Hh = av * Hh + uv; A *= av; }
            SEG[(seg * 64 + c) * 2] = A; SEG[(seg * 64 + c) * 2 + 1] = Hh;
        }
        __syncthreads();
        {
            float hin = carry;
            for (int s = 0; s < seg; ++s) hin = SEG[(s * 64 + c) * 2] * hin + SEG[(s * 64 + c) * 2 + 1];
            float hend = hin;
            for (int s = seg; s < 8; ++s) hend = SEG[(s * 64 + c) * 2] * hend + SEG[(s * 64 + c) * 2 + 1];
            carry = hend;
            float h = hin;
#pragma unroll 4
            for (int q = 0; q < 16; ++q) {
                const int tl = 16 * seg + q, t = t0 + tl;
                h = AA[tl * 64 + c] * h + UU[tl * 64 + c];
                if (t < L) {
                    const float gv = bf1(XAQ[(size_t)(rowbase + t) * 1536 + 512 + ch]);
                    const float gl = gv * sigmoidf_(1.5957691216057308f * (gv + 0.044715f * gv * gv * gv));
                    MIX[(size_t)(rowbase + t) * 1024 + ch] = (bf16_t)f2bf(gl * h);
                }
            }
        }
        __syncthreads();
    }
    if (seg == 0) {
        a.out[(g ? O_LRUH_S : O_LRUH_P) + (size_t)(j * 8 + b) * 512 + ch] = carry;
#pragma unroll
        for (int k = 0; k < 3; ++k) a.out[(g ? O_CONV_S : O_CONV_P) + ((size_t)(j * 8 + b) * 3 + k) * 512 + ch] = bf1(XAQ[(size_t)(rowbase + L - 3 + k) * 1536 + ch]);
    }
}
DI void sb_task(const KArgs& a, int j, int task, int lane) {
    int g, b, h, qb;
    if (task < 128) { g = 1; b = task >> 4; h = (task >> 1) & 7; qb = task & 1; }
    else { const int q = task - 128; g = 0; b = q >> 9; h = (q >> 6) & 7; qb = 63 - (q & 63); }
    const int P = g ? 2048 : 0, T = g ? 2112 : 2048, rowbase = g ? MP + b * 64 : b * 2048;
    const bf16_t* XAQ = (const bf16_t*)(a.ws + WS_XAQ); bf16_t* MIX = (bf16_t*)(a.ws + WS_MIXE);
    const bf16_t* Kb = g ? (const bf16_t*)(a.ws + WS_KBS) + (size_t)j * (SZ_KBS1 / 2) + (size_t)(b * 8 + h) * 2112 * 64 : (const bf16_t*)(a.ws + WS_KBP) + (size_t)(b * 8 + h) * 2048 * 64;
    const bf16_t* Vt = g ? (const bf16_t*)(a.ws + WS_VTS) + (size_t)j * (SZ_KBS1 / 2) + (size_t)(b * 8 + h) * 64 * 2112 : (const bf16_t*)(a.ws + WS_VTP) + (size_t)(b * 8 + h) * 64 * 2048;
    const int ql = lane & 31, hh = lane >> 5;
    const int rq = rowbase + 32 * qb + ql, tabs = P + 32 * qb + ql;
    bf16x8 qf[4];
#pragma unroll
    for (int ks = 0; ks < 4; ++ks) qf[ks] = *(const bf16x8*)(XAQ + (size_t)rq * 1536 + 1024 + h * 64 + 16 * ks + 8 * hh);
    f32x16 o0, o1;
#pragma unroll
    for (int i = 0; i < 16; ++i) { o0[i] = 0.f; o1[i] = 0.f; }
    float carry = 0.f;
    int kb = (P >> 5) + qb;
    bf16x8 kf[4];
#pragma unroll
    for (int ks = 0; ks < 4; ++ks) kf[ks] = *(const bf16x8*)(Kb + (size_t)(32 * kb + ql) * 64 + 16 * ks + 8 * hh);
    for (; kb >= 0; --kb) {
        u32x2 va[2][2][2];
#pragma unroll
        for (int dh = 0; dh < 2; ++dh)
#pragma unroll
            for (int s = 0; s < 2; ++s) { const bf16_t* p = Vt + (size_t)(32 * dh + ql) * T + 32 * kb + 16 * s + 4 * hh; va[dh][s][0] = *(const u32x2*)p; va[dh][s][1] = *(const u32x2*)(p + 8); }
        bf16x8 kn[4];
        if (kb > 0) {
#pragma unroll
            for (int ks = 0; ks < 4; ++ks) kn[ks] = *(const bf16x8*)(Kb + (size_t)(32 * (kb - 1) + ql) * 64 + 16 * ks + 8 * hh);
        } else {
#pragma unroll
            for (int ks = 0; ks < 4; ++ks) kn[ks] = kf[ks];
        }
        f32x16 st;
#pragma unroll
        for (int i = 0; i < 16; ++i) st[i] = 0.f;
#pragma unroll
        for (int ks = 0; ks < 4; ++ks) st = MFMA32(kf[ks], qf[ks], st);
        float z[16], lb[16];
#pragma unroll
        for (int i = 0; i < 16; ++i) {
            z[i] = st[i] * 0.125f;
            const float sp = fmaxf(z[i], 0.f) + __logf(1.f + __expf(-fabsf(z[i])));
            const bool ok = (32 * kb + crow(i, hh)) < tabs;
            lb[i] = ok ? -sp : 0.f;
        }
        float G[4], Gx[4];
#pragma unroll
        for (int q = 0; q < 4; ++q) { G[q] = (lb[4 * q] + lb[4 * q + 1]) + (lb[4 * q + 2] + lb[4 * q + 3]); Gx[q] = lane_xor(G[q], lane, 32); }
        float pv[16];
        float suf = carry;
#pragma unroll
        for (int q = 3; q >= 0; --q) {
            float tl = suf + (hh == 0 ? Gx[q] : 0.f);
#pragma unroll
            for (int ii = 3; ii >= 0; --ii) {
                const int i = 4 * q + ii;
                const bool ok = (32 * kb + crow(i, hh)) < tabs;
                pv[i] = ok ? __expf(z[i] + lb[i] + tl) : 0.f;
                tl += lb[i];
            }
            suf += G[q] + Gx[q];
        }
        carry = suf;
        bf16x8 pb[2];
#pragma unroll
        for (int s = 0; s < 2; ++s) {
            u32x4 w; w.x = pk2(pv[8 * s], pv[8 * s + 1]); w.y = pk2(pv[8 * s + 2], pv[8 * s + 3]); w.z = pk2(pv[8 * s + 4], pv[8 * s + 5]); w.w = pk2(pv[8 * s + 6], pv[8 * s + 7]);
            pb[s] = __builtin_bit_cast(bf16x8, w);
        }
#pragma unroll
        for (int s = 0; s < 2; ++s) {
            u32x4 w0; w0.x = va[0][s][0].x; w0.y = va[0][s][0].y; w0.z = va[0][s][1].x; w0.w = va[0][s][1].y;
            u32x4 w1; w1.x = va[1][s][0].x; w1.y = va[1][s][0].y; w1.z = va[1][s][1].x; w1.w = va[1][s][1].y;
            o0 = MFMA32(__builtin_bit_cast(bf16x8, w0), pb[s], o0);
            o1 = MFMA32(__builtin_bit_cast(bf16x8, w1), pb[s], o1);
        }
#pragma unroll
        for (int ks = 0; ks < 4; ++ks) kf[ks] = kn[ks];
        if (__all(carry < -104.f)) break;
    }
#pragma unroll
    for (int q = 0; q < 4; ++q) {
        u32x2 w; w.x = pk2(o0[4 * q], o0[4 * q + 1]); w.y = pk2(o0[4 * q + 2], o0[4 * q + 3]);
        *(u32x2*)(MIX + (size_t)rq * 1024 + 512 + h * 64 + 8 * q + 4 * hh) = w;
        w.x = pk2(o1[4 * q], o1[4 * q + 1]); w.y = pk2(o1[4 * q + 2], o1[4 * q + 3]);
        *(u32x2*)(MIX + (size_t)rq * 1024 + 512 + h * 64 + 32 + 8 * q + 4 * hh) = w;
    }
}

DI void ret_unit(const KArgs& a, int j, int g, int b, int h, int es, LAS unsigned char* lds, int wave, int lane_in) {
    int lane = lane_in; asm volatile("" : "+v"(lane));
    const int L = g ? 64 : 2048, rowbase = g ? MP + b * 64 : b * 2048, nch = L >> 6;
    const bf16_t* VT = (const bf16_t*)(a.ws + WS_VT) + (g ? (size_t)MP * 2048 + ((size_t)(b * 4 + h) * 512 + es * 64) * 64 : ((size_t)(b * 4 + h) * 512 + es * 64) * 2048);
    const float lg2 = log2f(1.f - exp2f(-5.f - (float)h));
    const int l31 = lane & 31, hh = lane >> 5, w4 = wave & 3;
    constexpr int RTS = 264;
    LAS bf16_t* RT = (LAS bf16_t*)lds;
    LAS bf16_t* QS = RT + 2 * 64 * RTS;
    LAS bf16_t* KS = QS + 64 * RTS;
    const int tid = wave * 64 + lane, srow = tid >> 3, scol = (tid & 7) * 32;
    const bf16_t* qg = (const bf16_t*)(a.ws + WS_QR) + (size_t)(rowbase + srow) * 1024 + h * 256 + scol;
    const bf16_t* kg = (const bf16_t*)(a.ws + WS_KR) + (size_t)(rowbase + srow) * 1024 + h * 256 + scol;
    u32x4 sq[4], sk[4];
#pragma unroll
    for (int k = 0; k < 4; ++k) { sq[k] = *(const u32x4*)(qg + 8 * k); sk[k] = *(const u32x4*)(kg + 8 * k); }
#pragma unroll
    for (int k = 0; k < 4; ++k) { *(LAS u32x4*)(QS + srow * RTS + scol + 8 * k) = sq[k]; *(LAS u32x4*)(KS + srow * RTS + scol + 8 * k) = sk[k]; }
    if (wave < 4) {
        bf16_t* OB = (bf16_t*)(a.ws + WS_OB);
        const int et = w4 & 1, lt = w4 >> 1;
        const float xi = exp2f(lg2 * (float)(32 * lt + l31 + 1));
        __syncthreads();
        int buf = 0;
        for (int c = 0; c < nch; ++c) {
            const int t0 = c * 64;
            const bool more = c + 1 < nch;
            if (more) {
#pragma unroll
                for (int k = 0; k < 4; ++k) { sq[k] = *(const u32x4*)(qg + (size_t)(t0 + 64) * 1024 + 8 * k); sk[k] = *(const u32x4*)(kg + (size_t)(t0 + 64) * 1024 + 8 * k); }
            }
            const int rl = rowbase + t0 + 32 * lt + l31;
            int l31c = l31; asm volatile("" : "+v"(l31c));
            u32x2 vv[2][2][2];
#pragma unroll
            for (int mt = 0; mt < 2; ++mt)
#pragma unroll
                for (int s = 0; s < 2; ++s) { const bf16_t* vp = VT + (size_t)(32 * et + l31) * L + t0 + 32 * mt + 16 * s + 4 * hh; vv[mt][s][0] = *(const u32x2*)vp; vv[mt][s][1] = *(const u32x2*)(vp + 8); }
            f32x16 st0, st1, oc, oi;
#pragma unroll
            for (int i = 0; i < 16; ++i) { st0[i] = 0.f; st1[i] = 0.f; oc[i] = 0.f; oi[i] = 0.f; }
            const LAS bf16_t* qp = QS + (32 * lt + l31) * RTS + 8 * hh;
            const LAS bf16_t* kp = KS + l31 * RTS + 8 * hh;
            const LAS bf16_t* rp = RT + buf * (64 * RTS) + (32 * et + l31) * RTS + 8 * hh;
#pragma unroll 2
            for (int ks = 0; ks < 16; ++ks) {
                const bf16x8 qf = *(const LAS bf16x8*)(qp + 16 * ks);
                const bf16x8 k0 = *(const LAS bf16x8*)(kp + 16 * ks), k1 = *(const LAS bf16x8*)(kp + 32 * RTS + 16 * ks);
                const bf16x8 rf = *(const LAS bf16x8*)(rp + 16 * ks);
                st0 = MFMA32(k0, qf, st0); st1 = MFMA32(k1, qf, st1);
                oc = MFMA32(rf, qf, oc);
            }
#pragma unroll
            for (int mt = 0; mt < 2; ++mt) {
                float p[16];
#pragma unroll
                for (int i = 0; i < 16; ++i) { const int mm = 32 * mt + crow(i, hh), ll = 32 * lt + l31c; const float dd = (float)(mm > ll ? mm - ll : ll - mm); p[i] = (mt ? st1[i] : st0[i]) * exp2f(lg2 * dd); }
#pragma unroll
                for (int s = 0; s < 2; ++s) {
                    u32x4 w; w.x = pk2(p[8 * s], p[8 * s + 1]); w.y = pk2(p[8 * s + 2], p[8 * s + 3]); w.z = pk2(p[8 * s + 4], p[8 * s + 5]); w.w = pk2(p[8 * s + 6], p[8 * s + 7]);
                    u32x4 va; va.x = vv[mt][s][0].x; va.y = vv[mt][s][0].y; va.z = vv[mt][s][1].x; va.w = vv[mt][s][1].y;
                    oi = MFMA32(__builtin_bit_cast(bf16x8, va), __builtin_bit_cast(bf16x8, w), oi);
                }
            }
#pragma unroll
            for (int q = 0; q < 4; ++q) {
                u32x2 w; w.x = pk2(oi[4 * q] + xi * oc[4 * q], oi[4 * q + 1] + xi * oc[4 * q + 1]); w.y = pk2(oi[4 * q + 2] + xi * oc[4 * q + 2], oi[4 * q + 3] + xi * oc[4 * q + 3]);
                *(u32x2*)(OB + (size_t)rl * 2048 + h * 512 + es * 64 + 32 * et + 8 * q + 4 * hh) = w;
            }
            __syncthreads();
            if (more) {
#pragma unroll
                for (int k = 0; k < 4; ++k) { *(LAS u32x4*)(QS + srow * RTS + scol + 8 * k) = sq[k]; *(LAS u32x4*)(KS + srow * RTS + scol + 8 * k) = sk[k]; }
            }
            __syncthreads();
            buf ^= 1;
        }
    } else {
        const bf16_t* KT = (const bf16_t*)(a.ws + WS_KT) + (g ? (size_t)MP * 1024 + (size_t)(b * 4 + h) * 256 * 64 : (size_t)(b * 4 + h) * 256 * 2048);
        f32x16 R[2][2];
#pragma unroll
        for (int x = 0; x < 2; ++x)
#pragma unroll
            for (int y = 0; y < 2; ++y)
#pragma unroll
                for (int i = 0; i < 16; ++i) R[x][y][i] = 0.f;
        if (g) {
            const float* R0 = a.in[8] + ((size_t)((j * 8 + b) * 4 + h) * 256) * 512 + es * 64;
#pragma unroll
            for (int dti = 0; dti < 2; ++dti)
#pragma unroll
                for (int et = 0; et < 2; ++et)
#pragma unroll
                    for (int q = 0; q < 4; ++q) {
                        const float* pp = R0 + (size_t)(32 * (2 * w4 + dti) + 8 * q + 4 * hh) * 512 + 32 * et + l31; asm volatile("" : "+v"(pp));
#pragma unroll
                        for (int ii = 0; ii < 4; ++ii) R[dti][et][4 * q + ii] = pp[ii * 512];
                    }
        }
#pragma unroll
        for (int dti = 0; dti < 2; ++dti)
#pragma unroll
            for (int et = 0; et < 2; ++et)
#pragma unroll
                for (int q = 0; q < 4; ++q) { u32x2 w; w.x = pk2(R[dti][et][4 * q], R[dti][et][4 * q + 1]); w.y = pk2(R[dti][et][4 * q + 2], R[dti][et][4 * q + 3]);
                    *(LAS u32x2*)(RT + (32 * et + l31) * RTS + 32 * (2 * w4 + dti) + 8 * q + 4 * hh) = w; }
        const bf16_t* ktp = KT + (size_t)(32 * (2 * w4) + l31) * L + 8 * hh;
        const bf16_t* vtp = VT + (size_t)l31 * L + 8 * hh;
        __syncthreads();
        const float g64 = exp2f(lg2 * 64.f);
        float z[8];
#pragma unroll
        for (int e = 0; e < 8; ++e) z[e] = exp2f(lg2 * (float)(63 - 8 * hh - e));
        const float ginv16 = exp2f(-16.f * lg2);
        int buf = 0;
        for (int c = 0; c < nch; ++c) {
            const int t0 = c * 64;
            const bool more = c + 1 < nch;
            if (more) {
#pragma unroll
                for (int k = 0; k < 4; ++k) { sq[k] = *(const u32x4*)(qg + (size_t)(t0 + 64) * 1024 + 8 * k); sk[k] = *(const u32x4*)(kg + (size_t)(t0 + 64) * 1024 + 8 * k); }
            }
            u32x4 kw[2][4]; bf16x8 vb[2][4];
#pragma unroll
            for (int x = 0; x < 2; ++x)
#pragma unroll
                for (int s = 0; s < 4; ++s) { kw[x][s] = *(const u32x4*)(ktp + (size_t)(32 * x) * L + t0 + 16 * s); vb[x][s] = *(const bf16x8*)(vtp + (size_t)(32 * x) * L + t0 + 16 * s); }
#pragma unroll
            for (int dti = 0; dti < 2; ++dti)
#pragma unroll
                for (int et = 0; et < 2; ++et)
#pragma unroll
                    for (int i = 0; i < 16; ++i) R[dti][et][i] *= g64;
            float zs = 1.f;
#pragma unroll
            for (int s = 0; s < 4; ++s) {
#pragma unroll
                for (int dti = 0; dti < 2; ++dti) {
                    const u32x4 kx = kw[dti][s];
                    u32x4 ks_; ks_.x = pk2(bflo(kx.x) * (z[0] * zs), bfhi(kx.x) * (z[1] * zs)); ks_.y = pk2(bflo(kx.y) * (z[2] * zs), bfhi(kx.y) * (z[3] * zs));
                    ks_.z = pk2(bflo(kx.z) * (z[4] * zs), bfhi(kx.z) * (z[5] * zs)); ks_.w = pk2(bflo(kx.w) * (z[6] * zs), bfhi(kx.w) * (z[7] * zs));
                    const bf16x8 ka = __builtin_bit_cast(bf16x8, ks_);
                    R[dti][0] = MFMA32(ka, vb[0][s], R[dti][0]); R[dti][1] = MFMA32(ka, vb[1][s], R[dti][1]);
                }
                zs *= ginv16;
            }
#pragma unroll
            for (int dti = 0; dti < 2; ++dti)
#pragma unroll
                for (int et = 0; et < 2; ++et)
#pragma unroll
                    for (int q = 0; q < 4; ++q) { u32x2 w; w.x = pk2(R[dti][et][4 * q], R[dti][et][4 * q + 1]); w.y = pk2(R[dti][et][4 * q + 2], R[dti][et][4 * q + 3]);
                        *(LAS u32x2*)(RT + (buf ^ 1) * (64 * RTS) + (32 * et + l31) * RTS + 32 * (2 * w4 + dti) + 8 * q + 4 * hh) = w; }
            __syncthreads();
            if (more) {
#pragma unroll
                for (int k = 0; k < 4; ++k) { *(LAS u32x4*)(QS + srow * RTS + scol + 8 * k) = sq[k]; *(LAS u32x4*)(KS + srow * RTS + scol + 8 * k) = sk[k]; }
            }
            __syncthreads();
            buf ^= 1;
        }
        float* Rout = a.out + (g ? O_RET_S : O_RET_P) + ((size_t)((j * 8 + b) * 4 + h) * 256) * 512 + es * 64;
#pragma unroll
        for (int dti = 0; dti < 2; ++dti)
#pragma unroll
            for (int et = 0; et < 2; ++et)
#pragma unroll
                for (int q = 0; q < 4; ++q) {
                    float* pp = Rout + (size_t)(32 * (2 * w4 + dti) + 8 * q + 4 * hh) * 512 + 32 * et + l31; asm volatile("" : "+v"(pp));
#pragma unroll
                    for (int ii = 0; ii < 4; ++ii) pp[ii * 512] = R[dti][et][4 * q + ii];
                }
    }
}
DI void gn_phase(const KArgs& a, int gw, int NGW, int lane) {
    bf16_t* OB = (bf16_t*)(a.ws + WS_OB); const bf16_t* GG = (const bf16_t*)(a.ws + WS_GG);
    for (int it = gw; it < M * 4; it += NGW) {
        const size_t off = (size_t)(it >> 2) * 2048 + (it & 3) * 512 + lane * 8;
        const u32x4 ow = *(const u32x4*)(OB + off), gwv = *(const u32x4*)(GG + off);
        float o[8] = {bflo(ow.x), bfhi(ow.x), bflo(ow.y), bfhi(ow.y), bflo(ow.z), bfhi(ow.z), bflo(ow.w), bfhi(ow.w)};
        const float gg[8] = {bflo(gwv.x), bfhi(gwv.x), bflo(gwv.y), bfhi(gwv.y), bflo(gwv.z), bfhi(gwv.z), bflo(gwv.w), bfhi(gwv.w)};
        float s = 0.f;
#pragma unroll
        for (int e = 0; e < 8; ++e) s += o[e];
        const float mu = wave_sum(s, lane) * (1.f / 512.f);
        float v = 0.f;
#pragma unroll
        for (int e = 0; e < 8; ++e) { o[e] -= mu; v += o[e] * o[e]; }
        const float rstd = rsqrtf(wave_sum(v, lane) * (1.f / 512.f) + EPS);
        float y[8];
#pragma unroll
        for (int e = 0; e < 8; ++e) y[e] = gg[e] * sigmoidf_(gg[e]) * o[e] * rstd;
        u32x4 w; w.x = pk2(y[0], y[1]); w.y = pk2(y[2], y[3]); w.z = pk2(y[4], y[5]); w.w = pk2(y[6], y[7]);
        *(u32x4*)(OB + off) = w;
    }
}

DI void small_gemm_sample(const bf16_t* A, const bf16_t* Bt, int K, bf16_t* O, const bf16_t* PE, LAS unsigned char* lds, int tile, int wave, int lane) {
    const int tm = tile >> 4, tn = tile & 15, nh = wave & 1, kq = wave >> 1, l31 = lane & 31, hh = lane >> 5;
    const int kper = K >> 2;
    const bf16_t* ap = A + (size_t)(MP + 32 * tm + l31) * K + kq * kper + 8 * hh;
    const bf16_t* bp = Bt + (size_t)(64 * tn + 32 * nh + l31) * K + kq * kper + 8 * hh;
    f32x16 acc;
#pragma unroll
    for (int i = 0; i < 16; ++i) acc[i] = 0.f;
#pragma unroll 4
    for (int k = 0; k < kper; k += 16) {
        const bf16x8 av = *(const bf16x8*)(ap + k), bv = *(const bf16x8*)(bp + k);
        acc = MFMA32(av, bv, acc);
    }
    LAS float* red = (LAS float*)lds;
#pragma unroll
    for (int i = 0; i < 16; ++i) red[((kq * 2 + nh) * 16 + i) * 64 + lane] = acc[i];
    __syncthreads();
    {
        const int q = wave >> 1;
#pragma unroll
        for (int ii = 0; ii < 4; ++ii) {
            const int i = 4 * q + ii;
            float v = 0.f;
#pragma unroll
            for (int k4 = 0; k4 < 4; ++k4) v += red[((k4 * 2 + nh) * 16 + i) * 64 + lane];
            const size_t off = (size_t)(MP + 32 * tm + crow(i, hh)) * 1024 + 64 * tn + 32 * nh + l31;
            if (PE) v = sigmoidf_(v) * bf1(PE[off]);
            O[off] = (bf16_t)f2bf(v);
        }
    }
    __syncthreads();
}
#if REP_GEMM > 1
struct GOrder {
    pg8::StaticOrder b; int cnt;
    DI void init(int M_, int N_, int G_, int c_) { b.init(M_, N_, G_, c_); cnt = (b.nwg - c_ + G_ - 1) / G_; if (cnt < 0) cnt = 0; }
    DI bool next(int i, pg8::Unit& u) const { if (i >= cnt * REP_GEMM) return false; return b.next(i % cnt, u); }
    DI void a_ready(const pg8::Unit&) const {}
    DI void done(const pg8::Unit&) const {}
};
#else
typedef pg8::StaticOrder GOrder;
#endif
#define XB_TMO      128
#define XB_XCNT(j)  (256  + 64 * (j))
#define XB_XSUB(j)  (1280 + 64 * (j))
#define XB_XGEN(j)  (2304 + 64 * (j))
#define XB_TOP      3328
#define XB_TOPGEN   3392
#define XCD_BAR_WORDS 3456
#define XB_SPIN_CAP (1u << 18)

__device__ __forceinline__ unsigned xb_ld(unsigned* p)              { return __hip_atomic_load(p, __ATOMIC_RELAXED, __HIP_MEMORY_SCOPE_AGENT); }
__device__ __forceinline__ unsigned xb_add(unsigned* p, unsigned v) { return __hip_atomic_fetch_add(p, v, __ATOMIC_RELAXED, __HIP_MEMORY_SCOPE_AGENT); }
__device__ __forceinline__ unsigned xb_xcc_id() { return (unsigned)__builtin_amdgcn_s_getreg((3 << 11) | 20) & 0xFu; }
#define XB_SPIN(cond, bar) do { unsigned _sp = 0; while (cond) { __builtin_amdgcn_s_sleep(1); \
    if ((++_sp & 255u) == 0u) { if (xb_ld(&(bar)[XB_TMO])) break; if (_sp > XB_SPIN_CAP) { atomicAdd(&(bar)[XB_TMO], 1u); break; } } } } while (0)

struct XcdBarrier {
    unsigned* bar; unsigned x;
    volatile LAS unsigned* st;
};

__device__ __forceinline__ XcdBarrier xcd_barrier_post(unsigned* bar, volatile LAS unsigned* st) {
    XcdBarrier b; b.bar = bar; b.x = xb_xcc_id(); b.st = st;
    if (threadIdx.x == 0) (void)xb_add(&bar[XB_XCNT(b.x)], 1u);
    return b;
}
__device__ __forceinline__ void xcd_barrier_complete(unsigned* bar, unsigned x, unsigned& nloc, unsigned& nx) {
    const unsigned G = gridDim.x * gridDim.y * gridDim.z;
    unsigned sum, cnt, mine, sp = 0u;
    for (;;) {
        sum = 0u; cnt = 0u; mine = 0u;
#pragma unroll
        for (unsigned j = 0; j < 16; ++j) { const unsigned c = xb_ld(&bar[XB_XCNT(j)]); sum += c; cnt += (c > 0u) ? 1u : 0u; mine = (j == x) ? c : mine; }
        if (sum == G) break;
        __builtin_amdgcn_s_sleep(1);
        if ((++sp & 255u) == 0u) { if (xb_ld(&bar[XB_TMO])) break; if (sp > XB_SPIN_CAP) { atomicAdd(&bar[XB_TMO], 1u); break; } }
    }
    nloc = mine > 0u ? mine : 1u; nx = cnt > 0u ? cnt : 1u;
}

__device__ __forceinline__ void xcd_barrier(const XcdBarrier& b) {
    asm volatile("s_waitcnt vmcnt(0)" ::: "memory");
    __syncthreads();
    if (threadIdx.x == 0) {
        unsigned* bar = b.bar;
        __builtin_amdgcn_s_waitcnt(0);
        unsigned nloc = b.st[0], nx = b.st[1];
        if (nloc == 0u) { xcd_barrier_complete(bar, b.x, nloc, nx); b.st[0] = nloc; b.st[1] = nx; }
        const unsigned old = xb_add(&bar[XB_XSUB(b.x)], 1u);
        const unsigned gen = old / nloc;
        if (old + 1u == (gen + 1u) * nloc) {
            __builtin_amdgcn_fence(__ATOMIC_RELEASE, "agent");
            asm volatile("s_waitcnt vmcnt(0)" ::: "memory");
            const unsigned og = xb_add(&bar[XB_TOP], 1u);
            const unsigned tg = og / nx;
            if (og + 1u == (tg + 1u) * nx) xb_add(&bar[XB_TOPGEN], 1u);
            else XB_SPIN(xb_ld(&bar[XB_TOPGEN]) == tg, bar);
            __builtin_amdgcn_fence(__ATOMIC_ACQUIRE, "agent");
            xb_add(&bar[XB_XGEN(b.x)], 1u);
            asm volatile("s_waitcnt vmcnt(0)" ::: "memory");
        } else {
            XB_SPIN(xb_ld(&bar[XB_XGEN(b.x)]) == gen, bar);
            __builtin_amdgcn_fence(__ATOMIC_ACQUIRE, "agent");
            asm volatile("s_waitcnt vmcnt(0)" ::: "memory");
        }
    }
    __syncthreads();
}


__global__ void __launch_bounds__(NTHR, 2) hybrid_fwd(const KArgs a) {
    extern __shared__ __attribute__((aligned(16))) unsigned char lds_raw[];
    cg::grid_group grid = cg::this_grid();
    LAS unsigned char* lds = (LAS unsigned char*)lds_raw;
    if (threadIdx.x < 16) ((LAS unsigned*)(lds + LDS_BYTES - 64))[threadIdx.x] = 0u;
    __syncthreads();
    const int G = gridDim.x, bx = blockIdx.x;
    const int vcu = (G % 8 == 0) ? (bx % 8) * (G / 8) + bx / 8 : bx;
    const int NGW = G * 8, NGT = G * NTHR;

    {
        const int tid = threadIdx.x, lane = tid & 63, wave = __builtin_amdgcn_readfirstlane(tid >> 6);
        for (int r_ = 0; r_ < REP_PRO; ++r_) prologue_phase(a, lds, vcu, G, tid, wave, lane);
        rowwise_phase(a, nullptr, nullptr, 0.f, a.in[9], vcu * 8 + wave, NGW, lane);
    }
    grid.sync();

    const KArgs a0 = a;
    XcdBarrier xbar = xcd_barrier_post((unsigned*)(a.ws + WS_CTL + 16384), (volatile LAS unsigned*)(lds + LDS_BYTES - 64));
    const int wave0 = __builtin_amdgcn_readfirstlane((int)threadIdx.x >> 6);
    for (int step = 0; step < 20; ++step) {
        KArgs a = a0;
        asm volatile("" : "+s"(a.ws), "+s"(a.out));
        unsigned char* ws = a.ws; const float* normg = PAR(a, PO_NG);
        int tid, lane, wave, gw, gt, bxs;
#define LAUNDER() do { lane = (int)__builtin_amdgcn_mbcnt_hi(~0u, __builtin_amdgcn_mbcnt_lo(~0u, 0u)); bxs = bx; asm volatile("" : "+v"(lane), "+s"(bxs)); wave = wave0; tid = wave * 64 + lane; gw = vcu * 8 + wave; gt = vcu * NTHR + tid; } while (0)
        LAUNDER();
#define GSYNC() do { for (int r_ = 0; r_ < REP_SYNC; ++r_) xcd_barrier(xbar); LAUNDER(); } while (0)
        const int i = step / 5, sb = step % 5, j = i >> 1;
        const bool odd = (i & 1) != 0;
        const bf16_t* yA = nullptr; const bf16_t* yB = nullptr; int yK = 0; const bf16_t* yPE = nullptr; bf16_t* yO = (bf16_t*)(ws + WS_Y);
        if (sb == 0 || sb == 2) {
            const int mf = i * 2 + (sb >> 1);
            {
                pg8::Gemm gm{(const bf16_t*)(ws + WS_H), (const bf16_t*)(ws + WS_WGU + (size_t)mf * SZ_WGU1), M, 5632, 1024};
                GOrder S; S.init(M, 5632, G, bxs);
                EpiSwiGLU E{(bf16_t*)(ws + WS_ACT)};
                pg8::gemm_phase<EpiSwiGLU, GOrder, true, true>(lds, gm, S, E, wave0);
            }
            GSYNC();
            yA = (const bf16_t*)(ws + WS_ACT); yB = (const bf16_t*)(ws + WS_WDN + (size_t)mf * SZ_WDN1); yK = FF;
        } else if (sb == 1) {
            if (!odd) {
                {
                    pg8::Gemm gm{(const bf16_t*)(ws + WS_H), (const bf16_t*)(ws + WS_WABI + (size_t)j * SZ_WABI1), M, 2560, 1024};
                    GOrder S; S.init(M, 2560, G, bxs);
                    EpiAB E{(bf16_t*)(ws + WS_XAQ), (bf16_t*)(ws + WS_KBP), (bf16_t*)(ws + WS_VTP), (bf16_t*)(ws + WS_KBS + (size_t)j * SZ_KBS1), (bf16_t*)(ws + WS_VTS + (size_t)j * SZ_KBS1), a.out, j};
                    pg8::gemm_phase<EpiAB, GOrder, true, true>(lds, gm, S, E, wave0);
                }
                GSYNC();
                for (int r_ = 0; r_ < REP_MIX; ++r_) for (int u = vcu; u < 128; u += G) { const int g = u >> 6, q = u & 63; lru_unit(a, j, g, q >> 3, q & 7, lds, tid, wave, lane); }
                {
                    unsigned* ctr = (unsigned*)(ws + WS_CTL) + 64 * j;
                    for (;;) {
                        unsigned t = 0; if (lane == 0) t = atomicAdd(ctr, 1u);
                        t = __builtin_amdgcn_readfirstlane(t);
                        if (t >= 128u + 4096u) break;
                        sb_task(a, j, (int)t, lane);
                    }
                }
                GSYNC();
                yA = (const bf16_t*)(ws + WS_MIXE); yB = (const bf16_t*)(ws + WS_WABO + (size_t)j * SZ_W1K); yK = 1024;
            } else {
                {
                    pg8::Gemm gm{(const bf16_t*)(ws + WS_H), (const bf16_t*)(ws + WS_WCI + (size_t)j * SZ_WCI1), M, 6144, 1024};
                    GOrder S; S.init(M, 6144, G, bxs);
                    EpiC E{(bf16_t*)(ws + WS_QR), (bf16_t*)(ws + WS_KR), (bf16_t*)(ws + WS_KT), (bf16_t*)(ws + WS_VT), (bf16_t*)(ws + WS_GG), (const float*)(ws + WS_TAB), (const float*)(ws + WS_TAB + SZ_TAB1)};
                    pg8::gemm_phase<EpiC, GOrder, true, true>(lds, gm, S, E, wave0);
                }
                GSYNC();
                for (int r_ = 0; r_ < REP_MIX; ++r_) for (int u = vcu; u < 512; u += G) { const int g = u >> 8, q = u & 255; ret_unit(a, j, g, q >> 5, (q >> 3) & 3, q & 7, lds, wave, lane); }
                GSYNC();
                gn_phase(a, gw, NGW, lane);
                GSYNC();
                yA = (const bf16_t*)(ws + WS_OB); yB = (const bf16_t*)(ws + WS_WCO + (size_t)j * SZ_WCO1); yK = 2048;
            }
        } else if (sb == 3) {
            yA = (const bf16_t*)(ws + WS_PB); yB = (const bf16_t*)(ws + WS_WPI + (size_t)i * SZ_WPI1); yK = 256; yO = (bf16_t*)(ws + WS_PE);
        } else {
            yA = (const bf16_t*)(ws + WS_H); yB = (const bf16_t*)(ws + WS_WPG + (size_t)i * SZ_W1K); yK = 1024; yPE = (const bf16_t*)(ws + WS_PE);
        }
        {
            pg8::Gemm gm{yA, yB, MP, 1024, yK};
            GOrder S; S.init(MP, 1024, G, bxs);
            EpiY E{yO, yPE};
            pg8::gemm_phase<EpiY, GOrder, true, true>(lds, gm, S, E, wave0);
            LAUNDER();
            for (int r_ = 0; r_ < REP_GEMM; ++r_) for (int tl = vcu; tl < 256; tl += G) small_gemm_sample(yA, yB, yK, yO, yPE, lds, tl, wave, lane);
        }
        GSYNC();
        if (sb != 3) {
            const int nidx = (sb == 4) ? 3 : sb;
            const float* ga = normg + (size_t)(i * 8 + 2 * nidx + 1) * 1024;
            const float* gb = (step == 19) ? nullptr : normg + (size_t)(i * 8 + 2 * nidx + 2) * 1024;
            rowwise_phase(a, (const bf16_t*)(ws + WS_Y), ga, (nidx & 1) ? 1.f : 0.5f, gb, gw, NGW, lane);
            if (sb == 2) pconv_phase(a, i, gt, NGT);
            if (step != 19) GSYNC();
        }
    }
}

extern "C" void kernel_launch(void* const* d_in, const int* in_sizes, int n_in, void* d_out, int out_size, void* d_ws, size_t ws_size, hipStream_t stream) {
    static int grid = 0;
    if (grid == 0) {
        int dev = 0, cus = 0, per_cu = 0;
        if (hipGetDevice(&dev) != hipSuccess || hipDeviceGetAttribute(&cus, hipDeviceAttributeMultiprocessorCount, dev) != hipSuccess) { grid = -1; return; }
        if (hipFuncSetAttribute((const void*)hybrid_fwd, hipFuncAttributeMaxDynamicSharedMemorySize, LDS_BYTES) != hipSuccess) { fprintf(stderr, "hipFuncSetAttribute failed\n"); grid = -1; return; }
        if (hipOccupancyMaxActiveBlocksPerMultiprocessor(&per_cu, (const void*)hybrid_fwd, NTHR, LDS_BYTES) != hipSuccess || per_cu < 1) fprintf(stderr, "occupancy query: %d\n", per_cu);
        (void)hipGetLastError();
        grid = cus;
        if (n_in != 26 || (size_t)out_size != O_END || ws_size < WS_END) { fprintf(stderr, "kernel_launch: unexpected sizes n_in %d out %d ws %zu (need %zu)\n", n_in, out_size, ws_size, (size_t)WS_END); grid = -1; return; }
    }
    if (grid < 0) return;
    if (hipMemsetAsync((char*)d_ws + WS_CTL, 0, 32768, stream) != hipSuccess) { fprintf(stderr, "memset failed\n"); return; }
    KArgs a{};
    for (int i = 0; i < 26; ++i) a.in[i] = (const float*)d_in[i];
    a.out = (float*)d_out; a.ws = (unsigned char*)d_ws;
    void* args[] = {&a};
    hipError_t e = hipLaunchCooperativeKernel((void*)hybrid_fwd, dim3(grid), dim3(NTHR), args, LDS_BYTES, stream);
    if (e != hipSuccess) fprintf(stderr, "cooperative launch failed: %s (grid %d)\n", hipGetErrorString(e), grid);
}
```

```cpp
#include <hip/hip_runtime.h>
#include <hip/hip_cooperative_groups.h>
#include <cstdio>
#include <cstdint>
namespace cg = cooperative_groups;
#define REP_GEMM 1
#define REP_SYNC 1
#define REP_PRO 1
#define REP_MIX 1
namespace pg8 {
#define PG8_LAS __attribute__((address_space(3)))
typedef unsigned short bf16_t;
typedef short bf16x8 __attribute__((ext_vector_type(8)));
typedef float f32x4 __attribute__((ext_vector_type(4)));
typedef unsigned u32x4 __attribute__((ext_vector_type(4)));
constexpr int BM = 256, BK = 64, HALF = 128, HTB = HALF * BK * 2  , STAGE_BYTES = 8 * HTB, NXCD = 8, WGM = 8;

__host__ __device__ __forceinline__ int lds_byte(int r, int c) { const int st = (r >> 4) * 2 + (c >> 5), rr = r & 15, cc = c & 31, ob = rr * 64 + cc * 2; return st * 1024 + (ob ^ (((ob >> 9) & 1) << 5)); }
__host__ __device__ __forceinline__ void stage_rc(int b, int& R, int& C) { const int st = b / 1024, sb = b % 1024, swz = sb ^ (((sb >> 9) & 1) << 5); R = (st >> 1) * 16 + swz / 64; C = (st & 1) * 32 + (swz % 64) / 2; }
__host__ __device__ __forceinline__ int perm32(int rho) { const int n = rho >> 4, i = rho & 15; return 8 * (i >> 2) + 4 * n + (i & 3); }

struct Unit { int pm, pn; };
struct Gemm { const bf16_t* A; const bf16_t* Bt; int M, N, K; };

struct StaticOrder {
    int nM, nN, nwg, G, c;
    __host__ __device__ void init(int M, int N, int G_, int c_) { nM = M / BM; nN = N / BM; nwg = nM * nN; G = G_; c = c_; }
    __host__ __device__ bool next(int i, Unit& u) const {
        const long L = (long)i * G + c; if (L >= nwg) return false;
        int wgid = (int)L; { const int q = nwg / NXCD, r = nwg % NXCD, xcd = wgid % NXCD, off = wgid / NXCD; wgid = (xcd < r ? xcd * (q + 1) : r * (q + 1) + (xcd - r) * q) + off; }
        const int nig = WGM * nN, gid = wgid / nig, fm = gid * WGM, gsz = (nM - fm) < WGM ? (nM - fm) : WGM;
        u.pm = fm + ((wgid % nig) % gsz); u.pn = (wgid % nig) / gsz; return true;
    }
    __device__ __forceinline__ void a_ready(const Unit&) const {}
    __device__ __forceinline__ void done(const Unit&) const {}
};

__device__ __forceinline__ unsigned cvt_pk_bf16(float lo, float hi) { unsigned r; asm volatile("v_cvt_pk_bf16_f32 %0, %1, %2" : "=v"(r) : "v"(lo), "v"(hi)); return r; }
template <class Epi, class Sched, bool ALIGN_EPI = false, bool SP2 = false>
__device__ __forceinline__ void gemm_phase(PG8_LAS unsigned char* lds, const Gemm g, const Sched& S, const Epi& E, const int wave_id) {
    unsigned m_l = ~0u; asm volatile("" : "+s"(m_l)); int tid_l = (int)__builtin_amdgcn_mbcnt_hi(m_l, __builtin_amdgcn_mbcnt_lo(m_l, 0u)) + 64 * wave_id;
    const int tid = tid_l, wid = __builtin_amdgcn_readfirstlane(tid >> 6), lane = tid & 63, wr = wid >> 2, wc = wid & 3, fr = lane & 15, fq = lane >> 4;
    const int K = g.K, nt = K / BK;
    unsigned voffA[2], voffB[2];
#pragma unroll
    for (int i = 0; i < 2; ++i) { int R, C; stage_rc(tid * 16 + i * 8192, R, C); const int Rb = Epi::PERM ? ((R & ~31) + perm32(R & 31)) : R;
        voffA[i] = (unsigned)(R * K + C) * 2u; voffB[i] = (unsigned)(Rb * K + C) * 2u; }
    const size_t kstep = (size_t)(BK * 2);
    const size_t hstep = (size_t)HALF * K * 2;
    const size_t tstep = 2 * hstep;
    const unsigned ldsw = (unsigned)wid * 1024u;
    const int aoff = lds_byte(wr * 64 + fr, fq * 8), boff = lds_byte(wc * 32 + fr, fq * 8);
#define PG8_SA(b, h) (((b) * 2 + (h)) * HTB)
#define PG8_SB(b, h) ((4 + (b) * 2 + (h)) * HTB)
#define PG8_STAGE(bufoff, gbase, voff) do { _Pragma("unroll") for (int _i = 0; _i < 2; ++_i) \
        __builtin_amdgcn_global_load_lds((const unsigned*)((const char*)(gbase) + (voff)[_i]), (PG8_LAS unsigned*)(lds + (bufoff) + ldsw + _i * 8192), 16, 0, 0); } while (0)
#define PG8_LDA(dst, b, h) do { _Pragma("unroll") for (int m = 0; m < 4; ++m) _Pragma("unroll") for (int k = 0; k < 2; ++k) dst[m][k] = *(const PG8_LAS bf16x8*)(lds + PG8_SA(b, h) + aoff + m * 2048 + k * 1024); } while (0)
#define PG8_LDB(dst, b, h) do { _Pragma("unroll") for (int n = 0; n < 2; ++n) _Pragma("unroll") for (int k = 0; k < 2; ++k) dst[n][k] = *(const PG8_LAS bf16x8*)(lds + PG8_SB(b, h) + boff + n * 2048 + k * 1024); } while (0)
#define PG8_MMA(ai, bj, At, Bt) do { __builtin_amdgcn_s_setprio(1); _Pragma("unroll") for (int m = 0; m < 4; ++m) _Pragma("unroll") for (int n = 0; n < 2; ++n) _Pragma("unroll") for (int k = 0; k < 2; ++k) \
        acc[ai][bj][m][n] = __builtin_amdgcn_mfma_f32_16x16x32_bf16(Bt[n][k], At[m][k], acc[ai][bj][m][n], 0, 0, 0); __builtin_amdgcn_s_setprio(0); } while (0)
#define PG8_WAIT_V(n) asm volatile("s_waitcnt vmcnt(" #n ")" ::: "memory")
#define PG8_WAIT_L(n) asm volatile("s_waitcnt lgkmcnt(" #n ")" ::: "memory")
#define PG8_BAR __builtin_amdgcn_s_barrier()
#define PG8_SCHED __builtin_amdgcn_sched_barrier(0)
    Unit cur, nxt; int ui = 0;
    if (!S.next(0, cur)) return;
    f32x4 acc[2][2][4][2];
#pragma unroll
    for (int a = 0; a < 2; ++a)
#pragma unroll
        for (int b = 0; b < 2; ++b)
#pragma unroll
            for (int m = 0; m < 4; ++m)
#pragma unroll
                for (int n = 0; n < 2; ++n) acc[a][b][m][n] = (f32x4){0.f, 0.f, 0.f, 0.f};
    bf16x8 At[4][2], B0[2][2], B1[2][2];
    const char* cA = (const char*)g.A + (size_t)cur.pm * tstep; const char* cB = (const char*)g.Bt + (size_t)cur.pn * tstep;
    S.a_ready(cur);
    if constexpr (SP2) {
        PG8_STAGE(PG8_SB(0, 0), cB, voffB); PG8_STAGE(PG8_SB(0, 1), cB + hstep, voffB); PG8_STAGE(PG8_SA(0, 0), cA, voffA); PG8_STAGE(PG8_SA(0, 1), cA + hstep, voffA);
        if (wr == 1) PG8_BAR;
        PG8_WAIT_V(2); PG8_BAR;
        PG8_STAGE(PG8_SB(1, 0), cB + kstep, voffB); PG8_STAGE(PG8_SA(1, 0), cA + kstep, voffA); PG8_STAGE(PG8_SB(1, 1), cB + hstep + kstep, voffB);
        PG8_WAIT_V(6); PG8_BAR;
    } else {
        PG8_STAGE(PG8_SB(0, 0), cB, voffB); PG8_STAGE(PG8_SA(0, 0), cA, voffA); PG8_STAGE(PG8_SB(0, 1), cB + hstep, voffB); PG8_STAGE(PG8_SA(0, 1), cA + hstep, voffA);
        if (wr == 1) PG8_BAR;
        PG8_WAIT_V(4); PG8_BAR;
        PG8_STAGE(PG8_SB(1, 0), cB + kstep, voffB); PG8_STAGE(PG8_SA(1, 0), cA + kstep, voffA); PG8_STAGE(PG8_SB(1, 1), cB + hstep + kstep, voffB);
        PG8_WAIT_V(6); PG8_BAR;
    }
    for (;;) {
        const bool has_next = S.next(ui + 1, nxt);
        const char* nA = has_next ? (const char*)g.A + (size_t)nxt.pm * tstep : cA; const char* nB = has_next ? (const char*)g.Bt + (size_t)nxt.pn * tstep : cB;
        for (int t = 0; t < nt; t += 2) {
            const bool last = (t == nt - 2);
            const char* a1 = cA + (size_t)(t + 1) * kstep;
            const char* a2 = last ? nA : cA + (size_t)(t + 2) * kstep; const char* b2 = last ? nB : cB + (size_t)(t + 2) * kstep;
            const char* a3 = a2 + kstep; const char* b3 = b2 + kstep;
            if (last && has_next) S.a_ready(nxt);
            if constexpr (SP2) {
            PG8_LDB(B0, 0, 0); PG8_LDB(B1, 0, 1); PG8_SCHED; PG8_LDA(At, 0, 0); PG8_STAGE(PG8_SA(1, 1), a1 + hstep, voffA);
            PG8_WAIT_V(8); PG8_WAIT_L(0); PG8_BAR; PG8_MMA(0, 0, At, B0); PG8_MMA(0, 1, At, B1); PG8_BAR; PG8_SCHED;
            PG8_LDA(At, 0, 1); PG8_STAGE(PG8_SB(0, 0), b2, voffB); PG8_STAGE(PG8_SB(0, 1), b2 + hstep, voffB); PG8_STAGE(PG8_SA(0, 0), a2, voffA);
            PG8_WAIT_V(8); PG8_WAIT_L(0); PG8_BAR; PG8_MMA(1, 0, At, B0); PG8_MMA(1, 1, At, B1); PG8_BAR; PG8_SCHED;
            PG8_LDB(B0, 1, 0); PG8_LDB(B1, 1, 1); PG8_SCHED; PG8_LDA(At, 1, 0); PG8_STAGE(PG8_SA(0, 1), a2 + hstep, voffA);
            PG8_WAIT_V(8); PG8_WAIT_L(0); PG8_BAR; PG8_MMA(0, 0, At, B0); PG8_MMA(0, 1, At, B1); PG8_BAR; PG8_SCHED;
            PG8_LDA(At, 1, 1); PG8_STAGE(PG8_SB(1, 0), b3, voffB); PG8_STAGE(PG8_SB(1, 1), b3 + hstep, voffB); PG8_STAGE(PG8_SA(1, 0), a3, voffA);
            PG8_WAIT_V(8); PG8_WAIT_L(0); PG8_BAR; PG8_MMA(1, 0, At, B0); PG8_MMA(1, 1, At, B1); PG8_BAR; PG8_SCHED;
            } else {
            PG8_LDB(B0, 0, 0); PG8_SCHED; PG8_LDA(At, 0, 0); PG8_STAGE(PG8_SA(1, 1), a1 + hstep, voffA);
            PG8_WAIT_L(8); PG8_BAR; PG8_WAIT_L(0); PG8_MMA(0, 0, At, B0); PG8_BAR; PG8_SCHED;
            PG8_LDB(B1, 0, 1); PG8_STAGE(PG8_SB(0, 0), b2, voffB);
            PG8_BAR; PG8_WAIT_L(0); PG8_MMA(0, 1, At, B1); PG8_BAR;
            PG8_LDA(At, 0, 1); PG8_STAGE(PG8_SA(0, 0), a2, voffA);
            PG8_BAR; PG8_WAIT_L(0); PG8_MMA(1, 0, At, B0); PG8_BAR; PG8_SCHED;
            PG8_STAGE(PG8_SB(0, 1), b2 + hstep, voffB);
            PG8_WAIT_V(6); PG8_BAR; PG8_MMA(1, 1, At, B1); PG8_BAR;
            PG8_LDB(B0, 1, 0); PG8_SCHED; PG8_LDA(At, 1, 0); PG8_STAGE(PG8_SA(0, 1), a2 + hstep, voffA);
            PG8_WAIT_L(8); PG8_BAR; PG8_WAIT_L(0); PG8_MMA(0, 0, At, B0); PG8_BAR; PG8_SCHED;
            PG8_LDB(B1, 1, 1); PG8_STAGE(PG8_SB(1, 0), b3, voffB);
            PG8_BAR; PG8_WAIT_L(0); PG8_MMA(0, 1, At, B1); PG8_BAR;
            PG8_LDA(At, 1, 1); PG8_STAGE(PG8_SA(1, 0), a3, voffA);
            PG8_BAR; PG8_WAIT_L(0); PG8_MMA(1, 0, At, B0); PG8_BAR; PG8_SCHED;
            PG8_STAGE(PG8_SB(1, 1), b3 + hstep, voffB);
            PG8_WAIT_V(6); PG8_BAR; PG8_MMA(1, 1, At, B1); PG8_BAR;
            }
        }
        if constexpr (ALIGN_EPI) { if (wr == 0) PG8_BAR; }
        if constexpr (!Epi::AFTER_DRAIN) { Unit cu = cur; int fr_l = fr, fq_l = fq; asm volatile("" : "+s"(cu.pm), "+s"(cu.pn), "+v"(fr_l), "+v"(fq_l)); E(acc, cu, wr, wc, fr_l, fq_l); S.done(cur); }
        if (!has_next) break;
#pragma unroll
        for (int a = 0; a < 2; ++a)
#pragma unroll
            for (int b = 0; b < 2; ++b)
#pragma unroll
                for (int m = 0; m < 4; ++m)
#pragma unroll
                    for (int n = 0; n < 2; ++n) acc[a][b][m][n] = (f32x4){0.f, 0.f, 0.f, 0.f};
        cur = nxt; cA = nA; cB = nB; ++ui;
        if constexpr (ALIGN_EPI) { if (wr == 1) PG8_BAR; }
    }
    PG8_WAIT_V(0);
    if constexpr (!ALIGN_EPI) { if (wr == 0) PG8_BAR; }
    PG8_BAR;
    if constexpr (Epi::AFTER_DRAIN) { E.fused(acc, cur, wr, wc, fr, fq, lds, wid, lane); S.done(cur); }
#undef PG8_SA
#undef PG8_SB
#undef PG8_STAGE
#undef PG8_LDA
#undef PG8_LDB
#undef PG8_MMA
#undef PG8_WAIT_V
#undef PG8_WAIT_L
#undef PG8_BAR
#undef PG8_SCHED
}
}

#define LAS __attribute__((address_space(3)))
typedef unsigned short bf16_t;
typedef short bf16x8 __attribute__((ext_vector_type(8)));
typedef float f32x4 __attribute__((ext_vector_type(4)));
typedef float f32x2 __attribute__((ext_vector_type(2)));
typedef float f32x16 __attribute__((ext_vector_type(16)));
typedef unsigned u32x4 __attribute__((ext_vector_type(4)));
typedef unsigned u32x2 __attribute__((ext_vector_type(2)));
#define DI __device__ __forceinline__
#define MFMA32(a, b, c) __builtin_amdgcn_mfma_f32_32x32x16_bf16((a), (b), (c), 0, 0, 0)

constexpr int M = 16896, MP = 16384, D = 1024, FF = 2816;
constexpr float EPS = 1e-6f;
constexpr int NTHR = 512;
constexpr int LDS_BYTES = 136 * 1024;

constexpr size_t O_Y = 0;
constexpr size_t O_LRUH_P = (size_t)M * 1024;
constexpr size_t O_CONV_P = O_LRUH_P + 8192;
constexpr size_t O_SBK_P = O_CONV_P + 24576;
constexpr size_t O_SBV_P = O_SBK_P + 16777216;
constexpr size_t O_RET_P = O_SBV_P + 16777216;
constexpr size_t O_LRUH_S = O_RET_P + 8388608;
constexpr size_t O_CONV_S = O_LRUH_S + 8192;
constexpr size_t O_SBK_S = O_CONV_S + 24576;
constexpr size_t O_SBV_S = O_SBK_S + 524288;
constexpr size_t O_RET_S = O_SBV_S + 524288;
constexpr size_t O_END = O_RET_S + 8388608;

constexpr size_t SZ_M1K = (size_t)M * 1024 * 2;
constexpr size_t WS_CTL = 0;
constexpr size_t WS_PAR = 65536;
constexpr int PO_H0 = 0, PO_CST = PO_H0 + 8192, PO_NG = PO_CST + 24576, PO_CW = PO_NG + 32768, PO_CB = PO_CW + 4096, PO_WR = PO_CB + 1024, PO_BR = PO_WR + 65536,
              PO_WI = PO_BR + 1024, PO_BI = PO_WI + 65536, PO_LAM = PO_BI + 1024, PO_END = PO_LAM + 1024;
static_assert((size_t)PO_END * 4 + 65536 <= (1u << 20), "param block");
constexpr size_t WS_WGU = 1u << 20;
constexpr size_t SZ_WGU1 = (size_t)5632 * 1024 * 2;
constexpr size_t WS_WDN = WS_WGU + 8 * SZ_WGU1;
constexpr size_t SZ_WDN1 = (size_t)1024 * 2816 * 2;
constexpr size_t WS_WPG = WS_WDN + 8 * SZ_WDN1;
constexpr size_t SZ_W1K = (size_t)1024 * 1024 * 2;
constexpr size_t WS_WPI = WS_WPG + 4 * SZ_W1K;
constexpr size_t SZ_WPI1 = (size_t)1024 * 256 * 2;
constexpr size_t WS_WABI = WS_WPI + 4 * SZ_WPI1;
constexpr size_t SZ_WABI1 = (size_t)2560 * 1024 * 2;
constexpr size_t WS_WABO = WS_WABI + 2 * SZ_WABI1;
constexpr size_t WS_WCI = WS_WABO + 2 * SZ_W1K;
constexpr size_t SZ_WCI1 = (size_t)6144 * 1024 * 2;
constexpr size_t WS_WCO = WS_WCI + 2 * SZ_WCI1;
constexpr size_t SZ_WCO1 = (size_t)1024 * 2048 * 2;
constexpr size_t WS_H = WS_WCO + 2 * SZ_WCO1;
constexpr size_t WS_ACT = WS_H + SZ_M1K;
constexpr size_t WS_Y = WS_ACT + (size_t)M * 2816 * 2;
constexpr size_t WS_PE = WS_Y + SZ_M1K;
constexpr size_t WS_KBS = WS_PE + SZ_M1K;
constexpr size_t SZ_KBS1 = (size_t)64 * 2112 * 64 * 2;
constexpr size_t WS_VTS = WS_KBS + 2 * SZ_KBS1;
constexpr size_t WS_TAB = WS_VTS + 2 * SZ_KBS1;
constexpr size_t SZ_TAB1 = (size_t)2112 * 128 * 4;
constexpr size_t WS_MIX = WS_TAB + 2 * SZ_TAB1;
constexpr size_t WS_XAQ = WS_MIX;
constexpr size_t WS_KBP = WS_XAQ + (size_t)M * 1536 * 2;
constexpr size_t WS_VTP = WS_KBP + (size_t)64 * 2048 * 64 * 2;
constexpr size_t WS_MIXE = WS_VTP + (size_t)64 * 2048 * 64 * 2;
constexpr size_t WS_KR = WS_MIX;
constexpr size_t WS_GG = WS_KR + SZ_M1K;
constexpr size_t WS_KT = WS_GG + 2 * SZ_M1K;
constexpr size_t WS_VT = WS_KT + SZ_M1K;
constexpr size_t WS_END = WS_VT + 2 * SZ_M1K;
constexpr size_t WS_PB = WS_MIX;
constexpr size_t WS_QR = WS_Y;
constexpr size_t WS_OB = WS_ACT;

struct KArgs { const float* in[26]; float* out; unsigned char* ws; };
#define PAR(a_, off_) ((const float*)((a_).ws + WS_PAR) + (off_))

DI float lane_xor(float v, int lane, int o) { return __builtin_bit_cast(float, __builtin_amdgcn_ds_bpermute((lane ^ o) << 2, __builtin_bit_cast(int, v))); }
DI float wave_sum(float v, int lane) {
#pragma unroll
    for (int o = 1; o < 64; o <<= 1) v += lane_xor(v, lane, o);
    return v;
}
DI unsigned f2bf(float f) { unsigned u = __float_as_uint(f); return (u + 0x7fffu + ((u >> 16) & 1u)) >> 16; }
DI unsigned pk2(float lo, float hi) { return f2bf(lo) | (f2bf(hi) << 16); }
DI float bflo(unsigned w) { return __uint_as_float(w << 16); }
DI float bfhi(unsigned w) { return __uint_as_float(w & 0xffff0000u); }
DI float bf1(bf16_t h) { return __uint_as_float((unsigned)h << 16); }
DI float sigmoidf_(float x) { return __builtin_amdgcn_rcpf(1.f + __expf(-x)); }
DI void row_dec(int r, int& g, int& b, int& t) { if (r < MP) { g = 0; b = r >> 11; t = r & 2047; } else { g = 1; const int q = r - MP; b = q >> 6; t = q & 63; } }
DI int crow(int reg, int h) { return (reg & 3) + 8 * (reg >> 2) + 4 * h; }
#define WAVE_LDS_SYNC() do { asm volatile("s_waitcnt lgkmcnt(0)" ::: "memory"); __builtin_amdgcn_wave_barrier(); asm volatile("" ::: "memory"); } while (0)

using pg8::Unit;
typedef const f32x4 (&AccRef)[2][2][4][2];

struct EpiSwiGLU {
    static constexpr bool PERM = true, AFTER_DRAIN = false;
    bf16_t* O;
    DI void operator()(AccRef acc, const Unit& u, int wr, int wc, int fr, int fq) const {
        const int row0 = u.pm * 256 + wr * 64 + fr, col0 = u.pn * 128 + wc * 32 + 8 * fq;
#pragma unroll
        for (int ai = 0; ai < 2; ++ai)
#pragma unroll
            for (int m = 0; m < 4; ++m) {
                float v[8];
#pragma unroll
                for (int n = 0; n < 2; ++n)
#pragma unroll
                    for (int i = 0; i < 4; ++i) { const float g = acc[ai][0][m][n][i], up = acc[ai][1][m][n][i]; v[n * 4 + i] = g * up * sigmoidf_(g); }
                u32x4 w; w.x = pk2(v[0], v[1]); w.y = pk2(v[2], v[3]); w.z = pk2(v[4], v[5]); w.w = pk2(v[6], v[7]);
                *(u32x4*)(O + (size_t)(row0 + ai * 128 + m * 16) * FF + col0) = w;
            }
    }
};
struct EpiY {
    static constexpr bool PERM = true, AFTER_DRAIN = false;
    bf16_t* O; const bf16_t* PE;
    DI void operator()(AccRef acc, const Unit& u, int wr, int wc, int fr, int fq) const {
        const int row0 = u.pm * 256 + wr * 64 + fr, col0 = u.pn * 256 + wc * 32 + 8 * fq;
#pragma unroll
        for (int ai = 0; ai < 2; ++ai)
#pragma unroll
            for (int m = 0; m < 4; ++m)
#pragma unroll
                for (int bj = 0; bj < 2; ++bj) {
                    const size_t off = (size_t)(row0 + ai * 128 + m * 16) * 1024 + col0 + bj * 128;
                    f32x4 v0 = acc[ai][bj][m][0], v1 = acc[ai][bj][m][1];
                    if (PE) {
                        const u32x4 p = *(const u32x4*)(PE + off);
                        v0[0] = sigmoidf_(v0[0]) * bflo(p.x); v0[1] = sigmoidf_(v0[1]) * bfhi(p.x); v0[2] = sigmoidf_(v0[2]) * bflo(p.y); v0[3] = sigmoidf_(v0[3]) * bfhi(p.y);
                        v1[0] = sigmoidf_(v1[0]) * bflo(p.z); v1[1] = sigmoidf_(v1[1]) * bfhi(p.z); v1[2] = sigmoidf_(v1[2]) * bflo(p.w); v1[3] = sigmoidf_(v1[3]) * bfhi(p.w);
                    }
                    u32x4 w; w.x = pk2(v0[0], v0[1]); w.y = pk2(v0[2], v0[3]); w.z = pk2(v1[0], v1[1]); w.w = pk2(v1[2], v1[3]);
                    *(u32x4*)(O + off) = w;
                }
    }
};
struct EpiAB {
    static constexpr bool PERM = true, AFTER_DRAIN = false;
    bf16_t* XAQ; bf16_t* KBP; bf16_t* VTP; bf16_t* KBS; bf16_t* VTS; float* out; int j;
    DI void operator()(AccRef acc, const Unit& u, int wr, int wc, int fr, int fq) const {
        const int row0 = u.pm * 256 + wr * 64 + fr, offc = wc * 32 + 8 * fq;
        if (u.pn < 6) {
#pragma unroll
            for (int ai = 0; ai < 2; ++ai)
#pragma unroll
                for (int m = 0; m < 4; ++m)
#pragma unroll
                    for (int bj = 0; bj < 2; ++bj) {
                        const f32x4 v0 = acc[ai][bj][m][0], v1 = acc[ai][bj][m][1];
                        u32x4 w; w.x = pk2(v0[0], v0[1]); w.y = pk2(v0[2], v0[3]); w.z = pk2(v1[0], v1[1]); w.w = pk2(v1[2], v1[3]);
                        *(u32x4*)(XAQ + (size_t)(row0 + ai * 128 + m * 16) * 1536 + u.pn * 256 + bj * 128 + offc) = w;
                    }
        } else {
            const bool isv = u.pn >= 8;
#pragma unroll
            for (int ai = 0; ai < 2; ++ai)
#pragma unroll
                for (int m = 0; m < 4; ++m) {
                    const int r = row0 + ai * 128 + m * 16; int g, b, t; row_dec(r, g, b, t);
                    float* of = out + (g ? (isv ? O_SBV_S : O_SBK_S) + (size_t)j * (512 * 512) + (size_t)(r - MP) * 512
                                         : (isv ? O_SBV_P : O_SBK_P) + (size_t)j * ((size_t)MP * 512) + (size_t)r * 512);
#pragma unroll
                    for (int bj = 0; bj < 2; ++bj) {
                        const int c = ((u.pn & 1) * 256) + bj * 128 + offc, head = c >> 6, d = c & 63;
                        const f32x4 v0 = acc[ai][bj][m][0], v1 = acc[ai][bj][m][1];
                        *(f32x4*)(of + c) = v0; *(f32x4*)(of + c + 4) = v1;
                        if (!isv) {
                            u32x4 w; w.x = pk2(v0[0], v0[1]); w.y = pk2(v0[2], v0[3]); w.z = pk2(v1[0], v1[1]); w.w = pk2(v1[2], v1[3]);
                            bf16_t* kb = g ? KBS + ((size_t)(b * 8 + head) * 2112 + 2048 + t) * 64 + d : KBP + ((size_t)(b * 8 + head) * 2048 + t) * 64 + d;
                            *(u32x4*)kb = w;
                        } else {
                            const size_t T = g ? 2112 : 2048;
                            bf16_t* vt = g ? VTS + ((size_t)(b * 8 + head) * 64 + d) * 2112 + 2048 + t : VTP + ((size_t)(b * 8 + head) * 64 + d) * 2048 + t;
#pragma unroll
                            for (int i = 0; i < 4; ++i) { vt[(size_t)i * T] = (bf16_t)f2bf(v0[i]); vt[(size_t)(4 + i) * T] = (bf16_t)f2bf(v1[i]); }
                        }
                    }
                }
        }
    }
};
struct EpiC {
    static constexpr bool PERM = true, AFTER_DRAIN = false;
    bf16_t* QR; bf16_t* KR; bf16_t* KT; bf16_t* VT; bf16_t* GG; const float* ctab; const float* stab;
    DI void operator()(AccRef acc, const Unit& u, int wr, int wc, int fr, int fq) const {
        const int row0 = u.pm * 256 + wr * 64 + fr, offc = wc * 32 + 8 * fq;
        if (u.pn < 8) {
            const bool isk = u.pn >= 4; const int head = u.pn & 3; const float sc = isk ? 0.0625f : 1.f;
            bf16_t* dst = isk ? KR : QR;
#pragma unroll
            for (int ai = 0; ai < 2; ++ai)
#pragma unroll
                for (int m = 0; m < 4; ++m) {
                    const int r = row0 + ai * 128 + m * 16; int g, b, t; row_dec(r, g, b, t);
                    const int pos = g ? 2048 + t : t;
                    const size_t T = g ? 64 : 2048;
                    bf16_t* kt = g ? KT + (size_t)MP * 1024 + ((size_t)(b * 4 + head) * 256 + offc) * 64 + t : KT + ((size_t)(b * 4 + head) * 256 + offc) * 2048 + t;
#pragma unroll
                    for (int n = 0; n < 2; ++n) {
                        const f32x4 cc = *(const f32x4*)(ctab + pos * 128 + offc + 4 * n), ss = *(const f32x4*)(stab + pos * 128 + offc + 4 * n);
                        const f32x4 x1 = acc[ai][0][m][n] * sc, x2 = acc[ai][1][m][n] * sc;
                        const f32x4 ra = x1 * cc - x2 * ss, rb = x2 * cc + x1 * ss;
                        u32x2 w1, w2; w1.x = pk2(ra[0], ra[1]); w1.y = pk2(ra[2], ra[3]); w2.x = pk2(rb[0], rb[1]); w2.y = pk2(rb[2], rb[3]);
                        *(u32x2*)(dst + (size_t)r * 1024 + head * 256 + offc + 4 * n) = w1;
                        *(u32x2*)(dst + (size_t)r * 1024 + head * 256 + 128 + offc + 4 * n) = w2;
                        if (isk) {
#pragma unroll
                            for (int i = 0; i < 4; ++i) { kt[(size_t)(4 * n + i) * T] = (bf16_t)(w1[i >> 1] >> (16 * (i & 1))); kt[(size_t)(128 + 4 * n + i) * T] = (bf16_t)(w2[i >> 1] >> (16 * (i & 1))); }
                        }
                        asm volatile("" ::: "memory");
                    }
                }
        } else if (u.pn < 16) {
#pragma unroll
            for (int ai = 0; ai < 2; ++ai)
#pragma unroll
                for (int m = 0; m < 4; ++m) {
                    const int r = row0 + ai * 128 + m * 16; int g, b, t; row_dec(r, g, b, t);
                    const size_t T = g ? 64 : 2048;
#pragma unroll
                    for (int bj = 0; bj < 2; ++bj) {
                        const int eg = (u.pn - 8) * 256 + bj * 128 + offc, head = eg >> 9, e = eg & 511;
                        bf16_t* vt = g ? VT + (size_t)MP * 2048 + ((size_t)(b * 4 + head) * 512 + e) * 64 + t : VT + ((size_t)(b * 4 + head) * 512 + e) * 2048 + t;
                        const f32x4 v0 = acc[ai][bj][m][0], v1 = acc[ai][bj][m][1];
#pragma unroll
                        for (int i = 0; i < 4; ++i) { vt[(size_t)i * T] = (bf16_t)f2bf(v0[i]); vt[(size_t)(4 + i) * T] = (bf16_t)f2bf(v1[i]); }
                    }
                }
        } else {
#pragma unroll
            for (int ai = 0; ai < 2; ++ai)
#pragma unroll
                for (int m = 0; m < 4; ++m)
#pragma unroll
                    for (int bj = 0; bj < 2; ++bj) {
                        const f32x4 v0 = acc[ai][bj][m][0], v1 = acc[ai][bj][m][1];
                        u32x4 w; w.x = pk2(v0[0], v0[1]); w.y = pk2(v0[2], v0[3]); w.z = pk2(v1[0], v1[1]); w.w = pk2(v1[2], v1[3]);
                        *(u32x4*)(GG + (size_t)(row0 + ai * 128 + m * 16) * 2048 + (u.pn - 16) * 256 + bj * 128 + offc) = w;
                    }
        }
    }
};

DI void tr_item(const float* in, size_t ldi, bf16_t* out, size_t ldo, int k0, int n0, int drow0, LAS float* scr, int lane) {
#pragma unroll 8
    for (int i = 0; i < 32; ++i) { const int kk = 2 * i + (lane >> 5); scr[kk * 33 + (lane & 31)] = in[(size_t)(k0 + kk) * ldi + n0 + (lane & 31)]; }
    WAVE_LDS_SYNC();
    const int c = lane & 7;
#pragma unroll
    for (int jj = 0; jj < 4; ++jj) { const int n = (lane >> 3) + 8 * jj; const LAS float* s = scr + (8 * c) * 33 + n;
        u32x4 o; o.x = pk2(s[0 * 33], s[1 * 33]); o.y = pk2(s[2 * 33], s[3 * 33]); o.z = pk2(s[4 * 33], s[5 * 33]); o.w = pk2(s[6 * 33], s[7 * 33]);
        *(u32x4*)(out + (size_t)(drow0 + n) * ldo + k0 + 8 * c) = o; }
    WAVE_LDS_SYNC();
}
DI void tr_plain(const float* W, int K, int N, bf16_t* WT, int it, LAS float* scr, int lane) {
    const int nblk = N / 32, kb = it / nblk, nb = it % nblk;
    tr_item(W, (size_t)N, WT, (size_t)K, kb * 64, nb * 32, nb * 32, scr, lane);
}

DI void prologue_phase(const KArgs& a, LAS unsigned char* lds, int vcu, int G, int tid, int wave, int lane) {
    unsigned char* ws = a.ws;
    LAS float* scr = (LAS float*)(lds + wave * 8704);
    const int gw = vcu * 8 + wave, NGW = G * 8;
    if (blockIdx.x == 0 && tid < 64) ((unsigned*)(ws + WS_CTL))[tid * 64] = 0u;
    constexpr int I_FFN = 1408, N_FFN = 8 * 3 * I_FFN;
    constexpr int I_PG = 512, I_PI = 128, I_ABI = 1280, I_ABO = 512, I_CI = 3072, I_CO = 1024, I_CV = 64;
    constexpr int E0 = N_FFN, E1 = E0 + 4 * I_PG, E2 = E1 + 4 * I_PI, E3 = E2 + 2 * I_ABI, E4 = E3 + 2 * I_ABO, E5 = E4 + 2 * I_CI, E6 = E5 + 2 * I_CO, E7 = E6 + 128 * I_CV;
    for (int it = gw; it < E7; it += NGW) {
        if (it < E0) {
            const int mf = it / (3 * I_FFN), r = it % (3 * I_FFN), kind = r / I_FFN, q = r % I_FFN;
            if (kind < 2) {
                const float* W = a.in[10 + kind] + (size_t)mf * 1024 * FF;
                const int kb = q / 88, nb = q % 88, n0 = nb * 32;
                tr_item(W, FF, (bf16_t*)(ws + WS_WGU + (size_t)mf * SZ_WGU1), 1024, kb * 64, n0, (n0 >> 7) * 256 + kind * 128 + (n0 & 127), scr, lane);
            } else {
                tr_plain(a.in[12] + (size_t)mf * FF * 1024, FF, 1024, (bf16_t*)(ws + WS_WDN + (size_t)mf * SZ_WDN1), q, scr, lane);
            }
        } else if (it < E1) { const int q = it - E0, l = q / I_PG; tr_plain(a.in[14] + (size_t)l * 1024 * 1024, 1024, 1024, (bf16_t*)(ws + WS_WPG + (size_t)l * SZ_W1K), q % I_PG, scr, lane); }
        else if (it < E2) { const int q = it - E1, l = q / I_PI; tr_plain(a.in[13] + (size_t)l * 256 * 1024, 256, 1024, (bf16_t*)(ws + WS_WPI + (size_t)l * SZ_WPI1), q % I_PI, scr, lane); }
        else if (it < E3) { const int q = it - E2, l = q / I_ABI; tr_plain(a.in[15] + (size_t)l * 1024 * 2560, 1024, 2560, (bf16_t*)(ws + WS_WABI + (size_t)l * SZ_WABI1), q % I_ABI, scr, lane); }
        else if (it < E4) { const int q = it - E3, l = q / I_ABO; tr_plain(a.in[16] + (size_t)l * 1024 * 1024, 1024, 1024, (bf16_t*)(ws + WS_WABO + (size_t)l * SZ_W1K), q % I_ABO, scr, lane); }
        else if (it < E5) { const int q = it - E4, l = q / I_CI; tr_plain(a.in[24] + (size_t)l * 1024 * 6144, 1024, 6144, (bf16_t*)(ws + WS_WCI + (size_t)l * SZ_WCI1), q % I_CI, scr, lane); }
        else if (it < E6) { const int q = it - E5, l = q / I_CO; tr_plain(a.in[25] + (size_t)l * 2048 * 1024, 2048, 1024, (bf16_t*)(ws + WS_WCO + (size_t)l * SZ_WCO1), q % I_CO, scr, lane); }
        else {
            const int q = it - E6, jbh = q / I_CV, r = q % I_CV, jb = jbh >> 3, h = jbh & 7, kb = r >> 1, nb = r & 1;
            tr_item(a.in[7] + (size_t)jb * 2048 * 512 + h * 64, 512, (bf16_t*)(ws + WS_VTS) + (size_t)jbh * 64 * 2112, 2112, kb * 64, nb * 32, nb * 32, scr, lane);
        }
    }
    const int gt = vcu * NTHR + tid, NGT = G * NTHR;
    {
        float* par = (float*)(ws + WS_PAR);
        for (int it = gt; it < PO_END; it += NGT) {
            float v;
            if (it < PO_CST) v = a.in[4][it - PO_H0]; else if (it < PO_NG) v = a.in[5][it - PO_CST]; else if (it < PO_CW) v = a.in[9][it - PO_NG];
            else if (it < PO_CB) v = a.in[17][it - PO_CW]; else if (it < PO_WR) v = a.in[18][it - PO_CB]; else if (it < PO_BR) v = a.in[19][it - PO_WR];
            else if (it < PO_WI) v = a.in[20][it - PO_BR]; else if (it < PO_BI) v = a.in[21][it - PO_WI]; else if (it < PO_LAM) v = a.in[22][it - PO_BI];
            else v = a.in[23][it - PO_LAM];
            par[it] = v;
        }
    }
    for (int it = gt; it < 2 * 8 * 2048 * 64; it += NGT) {
        const int d8 = it & 7, h = (it >> 3) & 7, t = (it >> 6) & 2047, jb = it >> 17;
        const float* s = a.in[6] + ((size_t)(jb * 2048 + t) * 512 + h * 64 + d8 * 8);
        const f32x4 v0 = *(const f32x4*)s, v1 = *(const f32x4*)(s + 4);
        u32x4 w; w.x = pk2(v0[0], v0[1]); w.y = pk2(v0[2], v0[3]); w.z = pk2(v1[0], v1[1]); w.w = pk2(v1[2], v1[3]);
        *(u32x4*)((bf16_t*)(ws + WS_KBS) + ((size_t)(jb * 8 + h) * 2112 + t) * 64 + d8 * 8) = w;
    }
    for (int it = gt; it < 2112 * 128; it += NGT) {
        const int pos = it >> 7, jf = it & 127;
        const float freq = exp2f(-(float)jf * (13.287712379549449f / 128.f));
        const float ang = (float)pos * freq;
        const double rev = (double)ang * 0.15915494309189535; const float fr = (float)(rev - floor(rev));
        ((float*)(ws + WS_TAB))[it] = __builtin_amdgcn_cosf(fr); ((float*)(ws + WS_TAB + SZ_TAB1))[it] = __builtin_amdgcn_sinf(fr);
    }
}
DI void pconv_phase(const KArgs& a, int l, int gt, int NGT) {
    bf16_t* PB = (bf16_t*)(a.ws + WS_PB);
    for (int it = gt; it < M * 32; it += NGT) {
        const int r = it >> 5, c8 = (it & 31) * 8;
        const float* s = (r < MP) ? a.in[2] + ((size_t)l * MP + r) * 256 + c8 : a.in[3] + ((size_t)l * 512 + (r - MP)) * 256 + c8;
        const f32x4 v0 = *(const f32x4*)s, v1 = *(const f32x4*)(s + 4);
        u32x4 w; w.x = pk2(v0[0], v0[1]); w.y = pk2(v0[2], v0[3]); w.z = pk2(v1[0], v1[1]); w.w = pk2(v1[2], v1[3]);
        *(u32x4*)(PB + (size_t)r * 256 + c8) = w;
    }
}
DI void rowwise_phase(const KArgs& a, const bf16_t* Y, const float* ga, float c, const float* gb, int gw, int NGW, int lane) {
    float* X = a.out; bf16_t* H = (bf16_t*)(a.ws + WS_H);
    for (int r = gw; r < M; r += NGW) {
        f32x4 x[4]; float ss = 0.f;
        if (Y) {
            f32x4 y[4];
#pragma unroll
            for (int q = 0; q < 4; ++q) { const int col = 4 * lane + 256 * q; const u32x2 w = *(const u32x2*)(Y + (size_t)r * 1024 + col);
                y[q] = (f32x4){bflo(w.x), bfhi(w.x), bflo(w.y), bfhi(w.y)}; x[q] = *(const f32x4*)(X + (size_t)r * 1024 + col);
                ss += (y[q][0] * y[q][0] + y[q][1] * y[q][1]) + (y[q][2] * y[q][2] + y[q][3] * y[q][3]); }
            const float rs = c * rsqrtf(wave_sum(ss, lane) * (1.f / 1024.f) + EPS);
#pragma unroll
            for (int q = 0; q < 4; ++q) { const int col = 4 * lane + 256 * q; const f32x4 g = *(const f32x4*)(ga + col); x[q] = x[q] + y[q] * g * rs; *(f32x4*)(X + (size_t)r * 1024 + col) = x[q]; }
        } else {
            const float* src = (r < MP) ? a.in[0] + (size_t)r * 1024 : a.in[1] + (size_t)(r - MP) * 1024;
#pragma unroll
            for (int q = 0; q < 4; ++q) { const int col = 4 * lane + 256 * q; x[q] = *(const f32x4*)(src + col); *(f32x4*)(X + (size_t)r * 1024 + col) = x[q]; }
        }
        if (gb) {
            float s2 = 0.f;
#pragma unroll
            for (int q = 0; q < 4; ++q) s2 += (x[q][0] * x[q][0] + x[q][1] * x[q][1]) + (x[q][2] * x[q][2] + x[q][3] * x[q][3]);
            const float rs2 = rsqrtf(wave_sum(s2, lane) * (1.f / 1024.f) + EPS);
#pragma unroll
            for (int q = 0; q < 4; ++q) { const int col = 4 * lane + 256 * q; const f32x4 g = *(const f32x4*)(gb + col); const f32x4 h = x[q] * g * rs2;
                u32x2 w; w.x = pk2(h[0], h[1]); w.y = pk2(h[2], h[3]); *(u32x2*)(H + (size_t)r * 1024 + col) = w; }
        }
    }
}
DI void lru_unit(const KArgs& a, int j, int g, int b, int hb, LAS unsigned char* lds, int wave, int lane_in) {
    int lane = lane_in; asm volatile("" : "+v"(lane));
    const int tid = wave * 64 + lane;
    const bf16_t* XAQ = (const bf16_t*)(a.ws + WS_XAQ); bf16_t* MIX = (bf16_t*)(a.ws + WS_MIXE);
    const int L = g ? 64 : 2048, rowbase = g ? MP + b * 64 : b * 2048;
    constexpr int XSS = 72;
    LAS float* XC = (LAS float*)lds;
    LAS float* AA = XC + 128 * 65;
    LAS float* UU = AA + 128 * 64;
    LAS float* SEG = UU + 128 * 64;
    LAS bf16_t* XS = (LAS bf16_t*)(SEG + 8 * 64 * 2);
    LAS bf16_t* GS = XS + 131 * XSS;
    const int c = tid & 63, seg = tid >> 6, ch = hb * 64 + c;
    const float* cw = PAR(a, PO_CW) + (size_t)j * 4 * 512 + ch;
    const float w0 = cw[0], w1 = cw[512], w2 = cw[1024], w3 = cw[1536], cb = PAR(a, PO_CB)[j * 512 + ch];
    const int tb = wave >> 1, chh = wave & 1, hh = lane >> 5, oc = chh * 32 + (lane & 31);
    bf16x8 Wr[4], Wi[4];
    {
        const float* wr_ = PAR(a, PO_WR) + ((size_t)(j * 8 + hb) * 64) * 64 + oc; const float* wi_ = PAR(a, PO_WI) + ((size_t)(j * 8 + hb) * 64) * 64 + oc;
#pragma unroll
        for (int ks = 0; ks < 4; ++ks)
#pragma unroll
            for (int e = 0; e < 8; ++e) { const int i = 16 * ks + 8 * hh + e; Wr[ks][e] = (short)f2bf(wr_[(size_t)i * 64]); Wi[ks][e] = (short)f2bf(wi_[(size_t)i * 64]); }
    }
    const float br = PAR(a, PO_BR)[j * 512 + hb * 64 + oc], bi = PAR(a, PO_BI)[j * 512 + hb * 64 + oc];
    const float lam = PAR(a, PO_LAM)[j * 512 + hb * 64 + oc];
    const float spl = (lam > 0.f ? 0.f : -lam) + log1pf(__expf(-fabsf(lam)));
    float carry = g ? PAR(a, PO_H0)[(size_t)(j * 8 + b) * 512 + ch] : 0.f;
    const int prow = tid >> 3, pcol = (tid & 7) * 8;
    const bf16_t* xg = XAQ + (size_t)(rowbase + prow) * 1536 + hb * 64 + pcol;
    u32x4 sx[2], sg[2];
    const u32x4 zero4 = {0u, 0u, 0u, 0u};
#pragma unroll
    for (int k = 0; k < 2; ++k) { const bool ok = prow + 64 * k < L; sx[k] = ok ? *(const u32x4*)(xg + (size_t)(64 * k) * 1536) : zero4; sg[k] = ok ? *(const u32x4*)(xg + (size_t)(64 * k) * 1536 + 512) : zero4; }
#pragma unroll
    for (int k = 0; k < 2; ++k) { *(LAS u32x4*)(XS + (3 + prow + 64 * k) * XSS + pcol) = sx[k]; *(LAS u32x4*)(GS + (prow + 64 * k) * 64 + pcol) = sg[k]; }
    float h3 = 0.f, h2 = 0.f, h1 = 0.f;
    if (g) { const float* cst = PAR(a, PO_CST) + (size_t)(j * 8 + b) * 3 * 512 + ch; h3 = cst[0]; h2 = cst[512]; h1 = cst[1024]; }
    if (seg == 7) { XS[0 * XSS + c] = (bf16_t)f2bf(h3); XS[1 * XSS + c] = (bf16_t)f2bf(h2); XS[2 * XSS + c] = (bf16_t)f2bf(h1); }
    __syncthreads();
    const int nchunk = (L + 127) / 128;
    const int seg_last = ((L - 1) & 127) >> 4;
    float e3 = 0.f, e2 = 0.f, e1 = 0.f;
    for (int ck = 0; ck < nchunk; ++ck) {
        const int t0 = ck * 128;
        const bool more = ck + 1 < nchunk;
        if (more) {
#pragma unroll
            for (int k = 0; k < 2; ++k) { sx[k] = *(const u32x4*)(xg + (size_t)(t0 + 128 + 64 * k) * 1536); sg[k] = *(const u32x4*)(xg + (size_t)(t0 + 128 + 64 * k) * 1536 + 512); }
        }
        {
            float xm3 = bf1(XS[(16 * seg + 0) * XSS + c]), xm2 = bf1(XS[(16 * seg + 1) * XSS + c]), xm1 = bf1(XS[(16 * seg + 2) * XSS + c]);
#pragma unroll
            for (int q = 0; q < 16; ++q) { const float x0 = bf1(XS[(16 * seg + q + 3) * XSS + c]); XC[(16 * seg + q) * 65 + c] = cb + w0 * xm3 + w1 * xm2 + w2 * xm1 + w3 * x0; xm3 = xm2; xm2 = xm1; xm1 = x0; }
            e3 = xm3; e2 = xm2; e1 = xm1;
        }
        __syncthreads();
        {
            f32x16 ar, ai;
#pragma unroll
            for (int i = 0; i < 16; ++i) { ar[i] = 0.f; ai[i] = 0.f; }
            const int tokA = 32 * tb + (lane & 31);
#pragma unroll
            for (int ks = 0; ks < 4; ++ks) {
                bf16x8 A; const LAS float* s = XC + tokA * 65 + 16 * ks + 8 * hh;
#pragma unroll
                for (int e = 0; e < 8; ++e) A[e] = (short)f2bf(s[e]);
                ar = MFMA32(A, Wr[ks], ar); ai = MFMA32(A, Wi[ks], ai);
            }
#pragma unroll
            for (int i = 0; i < 16; ++i) {
                const int tl = 32 * tb + crow(i, hh);
                const float rg = sigmoidf_(ar[i] + br), ig = sigmoidf_(ai[i] + bi);
                const float la = -8.f * rg * spl;
                float av = __expf(la), uv = sqrtf(-expm1f(2.f * la)) * ig * XC[tl * 65 + oc];
                if (t0 + tl >= L) { av = 1.f; uv = 0.f; }
                AA[tl * 64 + oc] = av; UU[tl * 64 + oc] = uv;
            }
        }
        __syncthreads();
        {
            float A = 1.f, Hh = 0.f;
#pragma unroll
            for (int q = 0; q < 16; ++q) { const float av = AA[(16 * seg + q) * 64 + c], uv = UU[(16 * seg + q) * 64 + c]; Hh = av * Hh + uv; A *= av; }
            SEG[(seg * 64 + c) * 2] = A; SEG[(seg * 64 + c) * 2 + 1] = Hh;
        }
        __syncthreads();
        {
            float hin = carry;
            for (int s = 0; s < seg; ++s) hin = SEG[(s * 64 + c) * 2] * hin + SEG[(s * 64 + c) * 2 + 1];
            float hend = hin;
            for (int s = seg; s < 8; ++s) hend = SEG[(s * 64 + c) * 2] * hend + SEG[(s * 64 + c) * 2 + 1];
            carry = hend;
            float h = hin;
#pragma unroll
            for (int q = 0; q < 16; ++q) {
                const int tl = 16 * seg + q, t = t0 + tl;
                h = AA[tl * 64 + c] * h + UU[tl * 64 + c];
                if (t < L) {
                    const float gv = bf1(GS[tl * 64 + c]);
                    const float gl = gv * sigmoidf_(1.5957691216057308f * (gv + 0.044715f * gv * gv * gv));
                    MIX[(size_t)(rowbase + t) * 1024 + ch] = (bf16_t)f2bf(gl * h);
                }
            }
        }
        __syncthreads();
        if (more) {
            if (seg == 7) { XS[0 * XSS + c] = (bf16_t)f2bf(e3); XS[1 * XSS + c] = (bf16_t)f2bf(e2); XS[2 * XSS + c] = (bf16_t)f2bf(e1); }
#pragma unroll
            for (int k = 0; k < 2; ++k) { *(LAS u32x4*)(XS + (3 + prow + 64 * k) * XSS + pcol) = sx[k]; *(LAS u32x4*)(GS + (prow + 64 * k) * 64 + pcol) = sg[k]; }
            __syncthreads();
        }
    }
    if (seg == seg_last) {
        float* co = a.out + (g ? O_CONV_S : O_CONV_P) + ((size_t)(j * 8 + b) * 3) * 512 + ch;
        co[0] = e3; co[512] = e2; co[1024] = e1;
    }
    if (seg == 0) a.out[(g ? O_LRUH_S : O_LRUH_P) + (size_t)(j * 8 + b) * 512 + ch] = carry;
    __syncthreads();
}
DI void sb_task(const KArgs& a, int j, int task, int lane) {
    int g, b, h, qb;
    if (task < 128) { g = 1; b = task >> 4; h = (task >> 1) & 7; qb = task & 1; }
    else { const int q = task - 128; g = 0; b = q >> 9; h = (q >> 6) & 7; qb = 63 - (q & 63); }
    const int P = g ? 2048 : 0, T = g ? 2112 : 2048, rowbase = g ? MP + b * 64 : b * 2048;
    const bf16_t* XAQ = (const bf16_t*)(a.ws + WS_XAQ); bf16_t* MIX = (bf16_t*)(a.ws + WS_MIXE);
    const bf16_t* Kb = g ? (const bf16_t*)(a.ws + WS_KBS) + (size_t)j * (SZ_KBS1 / 2) + (size_t)(b * 8 + h) * 2112 * 64 : (const bf16_t*)(a.ws + WS_KBP) + (size_t)(b * 8 + h) * 2048 * 64;
    const bf16_t* Vt = g ? (const bf16_t*)(a.ws + WS_VTS) + (size_t)j * (SZ_KBS1 / 2) + (size_t)(b * 8 + h) * 64 * 2112 : (const bf16_t*)(a.ws + WS_VTP) + (size_t)(b * 8 + h) * 64 * 2048;
    const int ql = lane & 31, hh = lane >> 5;
    const int rq = rowbase + 32 * qb + ql, tabs = P + 32 * qb + ql;
    bf16x8 qf[4];
#pragma unroll
    for (int ks = 0; ks < 4; ++ks) qf[ks] = *(const bf16x8*)(XAQ + (size_t)rq * 1536 + 1024 + h * 64 + 16 * ks + 8 * hh);
    f32x16 o0, o1;
#pragma unroll
    for (int i = 0; i < 16; ++i) { o0[i] = 0.f; o1[i] = 0.f; }
    float carry = 0.f;
    int kb = (P >> 5) + qb;
    bf16x8 kf[4];
#pragma unroll
    for (int ks = 0; ks < 4; ++ks) kf[ks] = *(const bf16x8*)(Kb + (size_t)(32 * kb + ql) * 64 + 16 * ks + 8 * hh);
    for (; kb >= 0; --kb) {
        u32x2 va[2][2][2];
#pragma unroll
        for (int dh = 0; dh < 2; ++dh)
#pragma unroll
            for (int s = 0; s < 2; ++s) { const bf16_t* p = Vt + (size_t)(32 * dh + ql) * T + 32 * kb + 16 * s + 4 * hh; va[dh][s][0] = *(const u32x2*)p; va[dh][s][1] = *(const u32x2*)(p + 8); }
        bf16x8 kn[4];
        if (kb > 0) {
#pragma unroll
            for (int ks = 0; ks < 4; ++ks) kn[ks] = *(const bf16x8*)(Kb + (size_t)(32 * (kb - 1) + ql) * 64 + 16 * ks + 8 * hh);
        } else {
#pragma unroll
            for (int ks = 0; ks < 4; ++ks) kn[ks] = kf[ks];
        }
        f32x16 st;
#pragma unroll
        for (int i = 0; i < 16; ++i) st[i] = 0.f;
#pragma unroll
        for (int ks = 0; ks < 4; ++ks) st = MFMA32(kf[ks], qf[ks], st);
        float z[16], lb[16];
#pragma unroll
        for (int i = 0; i < 16; ++i) {
            z[i] = st[i] * 0.125f;
            const float sp = fmaxf(z[i], 0.f) + __logf(1.f + __expf(-fabsf(z[i])));
            const bool ok = (32 * kb + crow(i, hh)) < tabs;
            lb[i] = ok ? -sp : 0.f;
        }
        float G[4], Gx[4];
#pragma unroll
        for (int q = 0; q < 4; ++q) { G[q] = (lb[4 * q] + lb[4 * q + 1]) + (lb[4 * q + 2] + lb[4 * q + 3]); Gx[q] = lane_xor(G[q], lane, 32); }
        float pv[16];
        float suf = carry;
#pragma unroll
        for (int q = 3; q >= 0; --q) {
            float tl = suf + (hh == 0 ? Gx[q] : 0.f);
#pragma unroll
            for (int ii = 3; ii >= 0; --ii) {
                const int i = 4 * q + ii;
                const bool ok = (32 * kb + crow(i, hh)) < tabs;
                pv[i] = ok ? __expf(z[i] + lb[i] + tl) : 0.f;
                tl += lb[i];
            }
            suf += G[q] + Gx[q];
        }
        carry = suf;
        bf16x8 pb[2];
#pragma unroll
        for (int s = 0; s < 2; ++s) {
            u32x4 w; w.x = pk2(pv[8 * s], pv[8 * s + 1]); w.y = pk2(pv[8 * s + 2], pv[8 * s + 3]); w.z = pk2(pv[8 * s + 4], pv[8 * s + 5]); w.w = pk2(pv[8 * s + 6], pv[8 * s + 7]);
            pb[s] = __builtin_bit_cast(bf16x8, w);
        }
#pragma unroll
        for (int s = 0; s < 2; ++s) {
            u32x4 w0; w0.x = va[0][s][0].x; w0.y = va[0][s][0].y; w0.z = va[0][s][1].x; w0.w = va[0][s][1].y;
            u32x4 w1; w1.x = va[1][s][0].x; w1.y = va[1][s][0].y; w1.z = va[1][s][1].x; w1.w = va[1][s][1].y;
            o0 = MFMA32(__builtin_bit_cast(bf16x8, w0), pb[s], o0);
            o1 = MFMA32(__builtin_bit_cast(bf16x8, w1), pb[s], o1);
        }
#pragma unroll
        for (int ks = 0; ks < 4; ++ks) kf[ks] = kn[ks];
        if (__all(carry < -104.f)) break;
    }
#pragma unroll
    for (int q = 0; q < 4; ++q) {
        u32x2 w; w.x = pk2(o0[4 * q], o0[4 * q + 1]); w.y = pk2(o0[4 * q + 2], o0[4 * q + 3]);
        *(u32x2*)(MIX + (size_t)rq * 1024 + 512 + h * 64 + 8 * q + 4 * hh) = w;
        w.x = pk2(o1[4 * q], o1[4 * q + 1]); w.y = pk2(o1[4 * q + 2], o1[4 * q + 3]);
        *(u32x2*)(MIX + (size_t)rq * 1024 + 512 + h * 64 + 32 + 8 * q + 4 * hh) = w;
    }
}

DI void ret_unit(const KArgs& a, int j, int g, int b, int h, int es, LAS unsigned char* lds, int wave, int lane_in) {
    int lane = lane_in; asm volatile("" : "+v"(lane));
    const int L = g ? 64 : 2048, rowbase = g ? MP + b * 64 : b * 2048, nch = L >> 6;
    const bf16_t* VT = (const bf16_t*)(a.ws + WS_VT) + (g ? (size_t)MP * 2048 + ((size_t)(b * 4 + h) * 512 + es * 64) * 64 : ((size_t)(b * 4 + h) * 512 + es * 64) * 2048);
    const float lg2 = log2f(1.f - exp2f(-5.f - (float)h));
    const int l31 = lane & 31, hh = lane >> 5, w4 = wave & 3;
    constexpr int RTS = 264;
    LAS bf16_t* RT = (LAS bf16_t*)lds;
    LAS bf16_t* QS = RT + 2 * 64 * RTS;
    LAS bf16_t* KS = QS + 64 * RTS;
    const int tid = wave * 64 + lane, srow = tid >> 3, scol = (tid & 7) * 32;
    const bf16_t* qg = (const bf16_t*)(a.ws + WS_QR) + (size_t)(rowbase + srow) * 1024 + h * 256 + scol;
    const bf16_t* kg = (const bf16_t*)(a.ws + WS_KR) + (size_t)(rowbase + srow) * 1024 + h * 256 + scol;
    u32x4 sq[4], sk[4];
#pragma unroll
    for (int k = 0; k < 4; ++k) { sq[k] = *(const u32x4*)(qg + 8 * k); sk[k] = *(const u32x4*)(kg + 8 * k); }
#pragma unroll
    for (int k = 0; k < 4; ++k) { *(LAS u32x4*)(QS + srow * RTS + scol + 8 * k) = sq[k]; *(LAS u32x4*)(KS + srow * RTS + scol + 8 * k) = sk[k]; }
    if (wave < 4) {
        bf16_t* OB = (bf16_t*)(a.ws + WS_OB);
        const int et = w4 & 1, lt = w4 >> 1;
        const float xi = exp2f(lg2 * (float)(32 * lt + l31 + 1));
        __syncthreads();
        int buf = 0;
        for (int c = 0; c < nch; ++c) {
            const int t0 = c * 64;
            const bool more = c + 1 < nch;
            if (more) {
#pragma unroll
                for (int k = 0; k < 4; ++k) { sq[k] = *(const u32x4*)(qg + (size_t)(t0 + 64) * 1024 + 8 * k); sk[k] = *(const u32x4*)(kg + (size_t)(t0 + 64) * 1024 + 8 * k); }
            }
            const int rl = rowbase + t0 + 32 * lt + l31;
            int l31c = l31; asm volatile("" : "+v"(l31c));
            u32x2 vv[2][2][2];
#pragma unroll
            for (int mt = 0; mt < 2; ++mt)
#pragma unroll
                for (int s = 0; s < 2; ++s) { const bf16_t* vp = VT + (size_t)(32 * et + l31) * L + t0 + 32 * mt + 16 * s + 4 * hh; vv[mt][s][0] = *(const u32x2*)vp; vv[mt][s][1] = *(const u32x2*)(vp + 8); }
            f32x16 st0, st1, oc, oi;
#pragma unroll
            for (int i = 0; i < 16; ++i) { st0[i] = 0.f; st1[i] = 0.f; oc[i] = 0.f; oi[i] = 0.f; }
            const LAS bf16_t* qp = QS + (32 * lt + l31) * RTS + 8 * hh;
            const LAS bf16_t* kp = KS + l31 * RTS + 8 * hh;
            const LAS bf16_t* rp = RT + buf * (64 * RTS) + (32 * et + l31) * RTS + 8 * hh;
#pragma unroll 2
            for (int ks = 0; ks < 16; ++ks) {
                const bf16x8 qf = *(const LAS bf16x8*)(qp + 16 * ks);
                const bf16x8 k0 = *(const LAS bf16x8*)(kp + 16 * ks), k1 = *(const LAS bf16x8*)(kp + 32 * RTS + 16 * ks);
                const bf16x8 rf = *(const LAS bf16x8*)(rp + 16 * ks);
                st0 = MFMA32(k0, qf, st0); st1 = MFMA32(k1, qf, st1);
                oc = MFMA32(rf, qf, oc);
            }
#pragma unroll
            for (int mt = 0; mt < 2; ++mt) {
                float p[16];
#pragma unroll
                for (int i = 0; i < 16; ++i) { const int mm = 32 * mt + crow(i, hh), ll = 32 * lt + l31c; const float dd = (float)(mm > ll ? mm - ll : ll - mm); p[i] = (mt ? st1[i] : st0[i]) * exp2f(lg2 * dd); }
#pragma unroll
                for (int s = 0; s < 2; ++s) {
                    u32x4 w; w.x = pk2(p[8 * s], p[8 * s + 1]); w.y = pk2(p[8 * s + 2], p[8 * s + 3]); w.z = pk2(p[8 * s + 4], p[8 * s + 5]); w.w = pk2(p[8 * s + 6], p[8 * s + 7]);
                    u32x4 va; va.x = vv[mt][s][0].x; va.y = vv[mt][s][0].y; va.z = vv[mt][s][1].x; va.w = vv[mt][s][1].y;
                    oi = MFMA32(__builtin_bit_cast(bf16x8, va), __builtin_bit_cast(bf16x8, w), oi);
                }
            }
#pragma unroll
            for (int q = 0; q < 4; ++q) {
                u32x2 w; w.x = pk2(oi[4 * q] + xi * oc[4 * q], oi[4 * q + 1] + xi * oc[4 * q + 1]); w.y = pk2(oi[4 * q + 2] + xi * oc[4 * q + 2], oi[4 * q + 3] + xi * oc[4 * q + 3]);
                *(u32x2*)(OB + (size_t)rl * 2048 + h * 512 + es * 64 + 32 * et + 8 * q + 4 * hh) = w;
            }
            __syncthreads();
            if (more) {
#pragma unroll
                for (int k = 0; k < 4; ++k) { *(LAS u32x4*)(QS + srow * RTS + scol + 8 * k) = sq[k]; *(LAS u32x4*)(KS + srow * RTS + scol + 8 * k) = sk[k]; }
            }
            __syncthreads();
            buf ^= 1;
        }
    } else {
        const bf16_t* KT = (const bf16_t*)(a.ws + WS_KT) + (g ? (size_t)MP * 1024 + (size_t)(b * 4 + h) * 256 * 64 : (size_t)(b * 4 + h) * 256 * 2048);
        f32x16 R[2][2];
#pragma unroll
        for (int x = 0; x < 2; ++x)
#pragma unroll
            for (int y = 0; y < 2; ++y)
#pragma unroll
                for (int i = 0; i < 16; ++i) R[x][y][i] = 0.f;
        if (g) {
            const float* R0 = a.in[8] + ((size_t)((j * 8 + b) * 4 + h) * 256) * 512 + es * 64;
#pragma unroll
            for (int dti = 0; dti < 2; ++dti)
#pragma unroll
                for (int et = 0; et < 2; ++et)
#pragma unroll
                    for (int q = 0; q < 4; ++q) {
                        const float* pp = R0 + (size_t)(32 * (2 * w4 + dti) + 8 * q + 4 * hh) * 512 + 32 * et + l31; asm volatile("" : "+v"(pp));
#pragma unroll
                        for (int ii = 0; ii < 4; ++ii) R[dti][et][4 * q + ii] = pp[ii * 512];
                    }
        }
#pragma unroll
        for (int dti = 0; dti < 2; ++dti)
#pragma unroll
            for (int et = 0; et < 2; ++et)
#pragma unroll
                for (int q = 0; q < 4; ++q) { u32x2 w; w.x = pk2(R[dti][et][4 * q], R[dti][et][4 * q + 1]); w.y = pk2(R[dti][et][4 * q + 2], R[dti][et][4 * q + 3]);
                    *(LAS u32x2*)(RT + (32 * et + l31) * RTS + 32 * (2 * w4 + dti) + 8 * q + 4 * hh) = w; }
        const bf16_t* ktp = KT + (size_t)(32 * (2 * w4) + l31) * L + 8 * hh;
        const bf16_t* vtp = VT + (size_t)l31 * L + 8 * hh;
        __syncthreads();
        const float g64 = exp2f(lg2 * 64.f);
        float z[8];
#pragma unroll
        for (int e = 0; e < 8; ++e) z[e] = exp2f(lg2 * (float)(63 - 8 * hh - e));
        const float ginv16 = exp2f(-16.f * lg2);
        int buf = 0;
        for (int c = 0; c < nch; ++c) {
            const int t0 = c * 64;
            const bool more = c + 1 < nch;
            if (more) {
#pragma unroll
                for (int k = 0; k < 4; ++k) { sq[k] = *(const u32x4*)(qg + (size_t)(t0 + 64) * 1024 + 8 * k); sk[k] = *(const u32x4*)(kg + (size_t)(t0 + 64) * 1024 + 8 * k); }
            }
            u32x4 kw[2][4]; bf16x8 vb[2][4];
#pragma unroll
            for (int x = 0; x < 2; ++x)
#pragma unroll
                for (int s = 0; s < 4; ++s) { kw[x][s] = *(const u32x4*)(ktp + (size_t)(32 * x) * L + t0 + 16 * s); vb[x][s] = *(const bf16x8*)(vtp + (size_t)(32 * x) * L + t0 + 16 * s); }
#pragma unroll
            for (int dti = 0; dti < 2; ++dti)
#pragma unroll
                for (int et = 0; et < 2; ++et)
#pragma unroll
                    for (int i = 0; i < 16; ++i) R[dti][et][i] *= g64;
            float zs = 1.f;
#pragma unroll
            for (int s = 0; s < 4; ++s) {
#pragma unroll
                for (int dti = 0; dti < 2; ++dti) {
                    const u32x4 kx = kw[dti][s];
                    u32x4 ks_; ks_.x = pk2(bflo(kx.x) * (z[0] * zs), bfhi(kx.x) * (z[1] * zs)); ks_.y = pk2(bflo(kx.y) * (z[2] * zs), bfhi(kx.y) * (z[3] * zs));
                    ks_.z = pk2(bflo(kx.z) * (z[4] * zs), bfhi(kx.z) * (z[5] * zs)); ks_.w = pk2(bflo(kx.w) * (z[6] * zs), bfhi(kx.w) * (z[7] * zs));
                    const bf16x8 ka = __builtin_bit_cast(bf16x8, ks_);
                    R[dti][0] = MFMA32(ka, vb[0][s], R[dti][0]); R[dti][1] = MFMA32(ka, vb[1][s], R[dti][1]);
                }
                zs *= ginv16;
            }
#pragma unroll
            for (int dti = 0; dti < 2; ++dti)
#pragma unroll
                for (int et = 0; et < 2; ++et)
#pragma unroll
                    for (int q = 0; q < 4; ++q) { u32x2 w; w.x = pk2(R[dti][et][4 * q], R[dti][et][4 * q + 1]); w.y = pk2(R[dti][et][4 * q + 2], R[dti][et][4 * q + 3]);
                        *(LAS u32x2*)(RT + (buf ^ 1) * (64 * RTS) + (32 * et + l31) * RTS + 32 * (2 * w4 + dti) + 8 * q + 4 * hh) = w; }
            __syncthreads();
            if (more) {
#pragma unroll
                for (int k = 0; k < 4; ++k) { *(LAS u32x4*)(QS + srow * RTS + scol + 8 * k) = sq[k]; *(LAS u32x4*)(KS + srow * RTS + scol + 8 * k) = sk[k]; }
            }
            __syncthreads();
            buf ^= 1;
        }
        float* Rout = a.out + (g ? O_RET_S : O_RET_P) + ((size_t)((j * 8 + b) * 4 + h) * 256) * 512 + es * 64;
#pragma unroll
        for (int dti = 0; dti < 2; ++dti)
#pragma unroll
            for (int et = 0; et < 2; ++et)
#pragma unroll
                for (int q = 0; q < 4; ++q) {
                    float* pp = Rout + (size_t)(32 * (2 * w4 + dti) + 8 * q + 4 * hh) * 512 + 32 * et + l31; asm volatile("" : "+v"(pp));
#pragma unroll
                    for (int ii = 0; ii < 4; ++ii) pp[ii * 512] = R[dti][et][4 * q + ii];
                }
    }
}
DI void gn_phase(const KArgs& a, int gw, int NGW, int lane) {
    bf16_t* OB = (bf16_t*)(a.ws + WS_OB); const bf16_t* GG = (const bf16_t*)(a.ws + WS_GG);
    for (int it = gw; it < M * 4; it += NGW) {
        const size_t off = (size_t)(it >> 2) * 2048 + (it & 3) * 512 + lane * 8;
        const u32x4 ow = *(const u32x4*)(OB + off), gwv = *(const u32x4*)(GG + off);
        float o[8] = {bflo(ow.x), bfhi(ow.x), bflo(ow.y), bfhi(ow.y), bflo(ow.z), bfhi(ow.z), bflo(ow.w), bfhi(ow.w)};
        const float gg[8] = {bflo(gwv.x), bfhi(gwv.x), bflo(gwv.y), bfhi(gwv.y), bflo(gwv.z), bfhi(gwv.z), bflo(gwv.w), bfhi(gwv.w)};
        float s = 0.f;
#pragma unroll
        for (int e = 0; e < 8; ++e) s += o[e];
        const float mu = wave_sum(s, lane) * (1.f / 512.f);
        float v = 0.f;
#pragma unroll
        for (int e = 0; e < 8; ++e) { o[e] -= mu; v += o[e] * o[e]; }
        const float rstd = rsqrtf(wave_sum(v, lane) * (1.f / 512.f) + EPS);
        float y[8];
#pragma unroll
        for (int e = 0; e < 8; ++e) y[e] = gg[e] * sigmoidf_(gg[e]) * o[e] * rstd;
        u32x4 w; w.x = pk2(y[0], y[1]); w.y = pk2(y[2], y[3]); w.z = pk2(y[4], y[5]); w.w = pk2(y[6], y[7]);
        *(u32x4*)(OB + off) = w;
    }
}

DI void small_gemm_sample(const bf16_t* A, const bf16_t* Bt, int K, bf16_t* O, const bf16_t* PE, LAS unsigned char* lds, int tile, int wave, int lane) {
    const int tm = tile >> 4, tn = tile & 15, nh = wave & 1, kq = wave >> 1, l31 = lane & 31, hh = lane >> 5;
    const int kper = K >> 2;
    const bf16_t* ap = A + (size_t)(MP + 32 * tm + l31) * K + kq * kper + 8 * hh;
    const bf16_t* bp = Bt + (size_t)(64 * tn + 32 * nh + l31) * K + kq * kper + 8 * hh;
    f32x16 acc;
#pragma unroll
    for (int i = 0; i < 16; ++i) acc[i] = 0.f;
#pragma unroll 4
    for (int k = 0; k < kper; k += 16) {
        const bf16x8 av = *(const bf16x8*)(ap + k), bv = *(const bf16x8*)(bp + k);
        acc = MFMA32(av, bv, acc);
    }
    LAS float* red = (LAS float*)lds;
#pragma unroll
    for (int i = 0; i < 16; ++i) red[((kq * 2 + nh) * 16 + i) * 64 + lane] = acc[i];
    __syncthreads();
    {
        const int q = wave >> 1;
#pragma unroll
        for (int ii = 0; ii < 4; ++ii) {
            const int i = 4 * q + ii;
            float v = 0.f;
#pragma unroll
            for (int k4 = 0; k4 < 4; ++k4) v += red[((k4 * 2 + nh) * 16 + i) * 64 + lane];
            const size_t off = (size_t)(MP + 32 * tm + crow(i, hh)) * 1024 + 64 * tn + 32 * nh + l31;
            if (PE) v = sigmoidf_(v) * bf1(PE[off]);
            O[off] = (bf16_t)f2bf(v);
        }
    }
    __syncthreads();
}
#if REP_GEMM > 1
struct GOrder {
    pg8::StaticOrder b; int cnt;
    DI void init(int M_, int N_, int G_, int c_) { b.init(M_, N_, G_, c_); cnt = (b.nwg - c_ + G_ - 1) / G_; if (cnt < 0) cnt = 0; }
    DI bool next(int i, pg8::Unit& u) const { if (i >= cnt * REP_GEMM) return false; return b.next(i % cnt, u); }
    DI void a_ready(const pg8::Unit&) const {}
    DI void done(const pg8::Unit&) const {}
};
#else
typedef pg8::StaticOrder GOrder;
#endif
#define XB_TMO      128
#define XB_XCNT(j)  (256  + 64 * (j))
#define XB_XSUB(j)  (1280 + 64 * (j))
#define XB_XGEN(j)  (2304 + 64 * (j))
#define XB_TOP      3328
#define XB_TOPGEN   3392
#define XCD_BAR_WORDS 3456
#define XB_SPIN_CAP (1u << 18)

__device__ __forceinline__ unsigned xb_ld(unsigned* p)              { return __hip_atomic_load(p, __ATOMIC_RELAXED, __HIP_MEMORY_SCOPE_AGENT); }
__device__ __forceinline__ unsigned xb_add(unsigned* p, unsigned v) { return __hip_atomic_fetch_add(p, v, __ATOMIC_RELAXED, __HIP_MEMORY_SCOPE_AGENT); }
__device__ __forceinline__ unsigned xb_xcc_id() { return (unsigned)__builtin_amdgcn_s_getreg((3 << 11) | 20) & 0xFu; }
#define XB_SPIN(cond, bar) do { unsigned _sp = 0; while (cond) { __builtin_amdgcn_s_sleep(1); \
    if ((++_sp & 255u) == 0u) { if (xb_ld(&(bar)[XB_TMO])) break; if (_sp > XB_SPIN_CAP) { atomicAdd(&(bar)[XB_TMO], 1u); break; } } } } while (0)

struct XcdBarrier {
    unsigned* bar; unsigned x;
    volatile LAS unsigned* st;
};

__device__ __forceinline__ XcdBarrier xcd_barrier_post(unsigned* bar, volatile LAS unsigned* st) {
    XcdBarrier b; b.bar = bar; b.x = xb_xcc_id(); b.st = st;
    if (threadIdx.x == 0) (void)xb_add(&bar[XB_XCNT(b.x)], 1u);
    return b;
}
__device__ __forceinline__ void xcd_barrier_complete(unsigned* bar, unsigned x, unsigned& nloc, unsigned& nx) {
    const unsigned G = gridDim.x * gridDim.y * gridDim.z;
    unsigned sum, cnt, mine, sp = 0u;
    for (;;) {
        sum = 0u; cnt = 0u; mine = 0u;
#pragma unroll
        for (unsigned j = 0; j < 16; ++j) { const unsigned c = xb_ld(&bar[XB_XCNT(j)]); sum += c; cnt += (c > 0u) ? 1u : 0u; mine = (j == x) ? c : mine; }
        if (sum == G) break;
        __builtin_amdgcn_s_sleep(1);
        if ((++sp & 255u) == 0u) { if (xb_ld(&bar[XB_TMO])) break; if (sp > XB_SPIN_CAP) { atomicAdd(&bar[XB_TMO], 1u); break; } }
    }
    nloc = mine > 0u ? mine : 1u; nx = cnt > 0u ? cnt : 1u;
}

__device__ __forceinline__ void xcd_barrier(const XcdBarrier& b) {
    asm volatile("s_waitcnt vmcnt(0)" ::: "memory");
    __syncthreads();
    if (threadIdx.x == 0) {
        unsigned* bar = b.bar;
        __builtin_amdgcn_s_waitcnt(0);
        unsigned nloc = b.st[0], nx = b.st[1];
        if (nloc == 0u) { xcd_barrier_complete(bar, b.x, nloc, nx); b.st[0] = nloc; b.st[1] = nx; }
        const unsigned old = xb_add(&bar[XB_XSUB(b.x)], 1u);
        const unsigned gen = old / nloc;
        if (old + 1u == (gen + 1u) * nloc) {
            __builtin_amdgcn_fence(__ATOMIC_RELEASE, "agent");
            asm volatile("s_waitcnt vmcnt(0)" ::: "memory");
            const unsigned og = xb_add(&bar[XB_TOP], 1u);
            const unsigned tg = og / nx;
            if (og + 1u == (tg + 1u) * nx) xb_add(&bar[XB_TOPGEN], 1u);
            else XB_SPIN(xb_ld(&bar[XB_TOPGEN]) == tg, bar);
            __builtin_amdgcn_fence(__ATOMIC_ACQUIRE, "agent");
            xb_add(&bar[XB_XGEN(b.x)], 1u);
            asm volatile("s_waitcnt vmcnt(0)" ::: "memory");
        } else {
            XB_SPIN(xb_ld(&bar[XB_XGEN(b.x)]) == gen, bar);
            __builtin_amdgcn_fence(__ATOMIC_ACQUIRE, "agent");
            asm volatile("s_waitcnt vmcnt(0)" ::: "memory");
        }
    }
    __syncthreads();
}


__global__ void __launch_bounds__(NTHR, 2) hybrid_fwd(const KArgs a) {
    extern __shared__ __attribute__((aligned(16))) unsigned char lds_raw[];
    cg::grid_group grid = cg::this_grid();
    LAS unsigned char* lds = (LAS unsigned char*)lds_raw;
    if (threadIdx.x < 16) ((LAS unsigned*)(lds + LDS_BYTES - 64))[threadIdx.x] = 0u;
    __syncthreads();
    const int G = gridDim.x, bx = blockIdx.x;
    const int vcu = (G % 8 == 0) ? (bx % 8) * (G / 8) + bx / 8 : bx;
    const int NGW = G * 8, NGT = G * NTHR;

    {
        const int tid = threadIdx.x, lane = tid & 63, wave = __builtin_amdgcn_readfirstlane(tid >> 6);
        for (int r_ = 0; r_ < REP_PRO; ++r_) prologue_phase(a, lds, vcu, G, tid, wave, lane);
        rowwise_phase(a, nullptr, nullptr, 0.f, a.in[9], vcu * 8 + wave, NGW, lane);
    }
    grid.sync();

    const KArgs a0 = a;
    XcdBarrier xbar = xcd_barrier_post((unsigned*)(a.ws + WS_CTL + 16384), (volatile LAS unsigned*)(lds + LDS_BYTES - 64));
    const int wave0 = __builtin_amdgcn_readfirstlane((int)threadIdx.x >> 6);
    for (int step = 0; step < 20; ++step) {
        KArgs a = a0;
        asm volatile("" : "+s"(a.ws), "+s"(a.out));
        unsigned char* ws = a.ws; const float* normg = PAR(a, PO_NG);
        int tid, lane, wave, gw, gt, bxs;
#define LAUNDER() do { { unsigned m_ = ~0u; asm volatile("" : "+s"(m_)); lane = (int)__builtin_amdgcn_mbcnt_hi(m_, __builtin_amdgcn_mbcnt_lo(m_, 0u)); } bxs = bx; asm volatile("" : "+s"(bxs)); wave = wave0; tid = wave * 64 + lane; gw = vcu * 8 + wave; gt = vcu * NTHR + tid; } while (0)
        LAUNDER();
#define GSYNC() do { for (int r_ = 0; r_ < REP_SYNC; ++r_) xcd_barrier(xbar); LAUNDER(); } while (0)
        const int i = step / 5, sb = step % 5, j = i >> 1;
        const bool odd = (i & 1) != 0;
        const bf16_t* yA = nullptr; const bf16_t* yB = nullptr; int yK = 0; const bf16_t* yPE = nullptr; bf16_t* yO = (bf16_t*)(ws + WS_Y);
        if (sb == 0 || sb == 2) {
            const int mf = i * 2 + (sb >> 1);
            {
                pg8::Gemm gm{(const bf16_t*)(ws + WS_H), (const bf16_t*)(ws + WS_WGU + (size_t)mf * SZ_WGU1), M, 5632, 1024};
                GOrder S; S.init(M, 5632, G, bxs);
                EpiSwiGLU E{(bf16_t*)(ws + WS_ACT)};
                pg8::gemm_phase<EpiSwiGLU, GOrder, true, true>(lds, gm, S, E, wave0);
            }
            GSYNC();
            yA = (const bf16_t*)(ws + WS_ACT); yB = (const bf16_t*)(ws + WS_WDN + (size_t)mf * SZ_WDN1); yK = FF;
        } else if (sb == 1) {
            if (!odd) {
                {
                    pg8::Gemm gm{(const bf16_t*)(ws + WS_H), (const bf16_t*)(ws + WS_WABI + (size_t)j * SZ_WABI1), M, 2560, 1024};
                    GOrder S; S.init(M, 2560, G, bxs);
                    EpiAB E{(bf16_t*)(ws + WS_XAQ), (bf16_t*)(ws + WS_KBP), (bf16_t*)(ws + WS_VTP), (bf16_t*)(ws + WS_KBS + (size_t)j * SZ_KBS1), (bf16_t*)(ws + WS_VTS + (size_t)j * SZ_KBS1), a.out, j};
                    pg8::gemm_phase<EpiAB, GOrder, true, true>(lds, gm, S, E, wave0);
                }
                GSYNC();
                for (int r_ = 0; r_ < REP_MIX; ++r_) for (int u = vcu; u < 128; u += G) { const int g = u >> 6, q = u & 63; lru_unit(a, j, g, q >> 3, q & 7, lds, wave, lane); }
                {
                    unsigned* ctr = (unsigned*)(ws + WS_CTL) + 64 * j;
                    for (;;) {
                        unsigned t = 0; if (lane == 0) t = atomicAdd(ctr, 1u);
                        t = __builtin_amdgcn_readfirstlane(t);
                        if (t >= 128u + 4096u) break;
                        sb_task(a, j, (int)t, lane);
                    }
                }
                GSYNC();
                yA = (const bf16_t*)(ws + WS_MIXE); yB = (const bf16_t*)(ws + WS_WABO + (size_t)j * SZ_W1K); yK = 1024;
            } else {
                {
                    pg8::Gemm gm{(const bf16_t*)(ws + WS_H), (const bf16_t*)(ws + WS_WCI + (size_t)j * SZ_WCI1), M, 6144, 1024};
                    GOrder S; S.init(M, 6144, G, bxs);
                    EpiC E{(bf16_t*)(ws + WS_QR), (bf16_t*)(ws + WS_KR), (bf16_t*)(ws + WS_KT), (bf16_t*)(ws + WS_VT), (bf16_t*)(ws + WS_GG), (const float*)(ws + WS_TAB), (const float*)(ws + WS_TAB + SZ_TAB1)};
                    pg8::gemm_phase<EpiC, GOrder, true, true>(lds, gm, S, E, wave0);
                }
                GSYNC();
                for (int r_ = 0; r_ < REP_MIX; ++r_) for (int u = vcu; u < 512; u += G) { const int g = u >> 8, q = u & 255; ret_unit(a, j, g, q >> 5, (q >> 3) & 3, q & 7, lds, wave, lane); }
                GSYNC();
                gn_phase(a, gw, NGW, lane);
                GSYNC();
                yA = (const bf16_t*)(ws + WS_OB); yB = (const bf16_t*)(ws + WS_WCO + (size_t)j * SZ_WCO1); yK = 2048;
            }
        } else if (sb == 3) {
            yA = (const bf16_t*)(ws + WS_PB); yB = (const bf16_t*)(ws + WS_WPI + (size_t)i * SZ_WPI1); yK = 256; yO = (bf16_t*)(ws + WS_PE);
        } else {
            yA = (const bf16_t*)(ws + WS_H); yB = (const bf16_t*)(ws + WS_WPG + (size_t)i * SZ_W1K); yK = 1024; yPE = (const bf16_t*)(ws + WS_PE);
        }
        {
            pg8::Gemm gm{yA, yB, MP, 1024, yK};
            GOrder S; S.init(MP, 1024, G, bxs);
            EpiY E{yO, yPE};
            pg8::gemm_phase<EpiY, GOrder, true, true>(lds, gm, S, E, wave0);
            LAUNDER();
            for (int r_ = 0; r_ < REP_GEMM; ++r_) for (int tl = vcu; tl < 256; tl += G) small_gemm_sample(yA, yB, yK, yO, yPE, lds, tl, wave, lane);
        }
        GSYNC();
        if (sb != 3) {
            const int nidx = (sb == 4) ? 3 : sb;
            const float* ga = normg + (size_t)(i * 8 + 2 * nidx + 1) * 1024;
            const float* gb = (step == 19) ? nullptr : normg + (size_t)(i * 8 + 2 * nidx + 2) * 1024;
            rowwise_phase(a, (const bf16_t*)(ws + WS_Y), ga, (nidx & 1) ? 1.f : 0.5f, gb, gw, NGW, lane);
            if (sb == 2) pconv_phase(a, i, gt, NGT);
            if (step != 19) GSYNC();
        }
    }
}

extern "C" void kernel_launch(void* const* d_in, const int* in_sizes, int n_in, void* d_out, int out_size, void* d_ws, size_t ws_size, hipStream_t stream) {
    static int grid = 0;
    if (grid == 0) {
        int dev = 0, cus = 0, per_cu = 0;
        if (hipGetDevice(&dev) != hipSuccess || hipDeviceGetAttribute(&cus, hipDeviceAttributeMultiprocessorCount, dev) != hipSuccess) { grid = -1; return; }
        if (hipFuncSetAttribute((const void*)hybrid_fwd, hipFuncAttributeMaxDynamicSharedMemorySize, LDS_BYTES) != hipSuccess) { fprintf(stderr, "hipFuncSetAttribute failed\n"); grid = -1; return; }
        if (hipOccupancyMaxActiveBlocksPerMultiprocessor(&per_cu, (const void*)hybrid_fwd, NTHR, LDS_BYTES) != hipSuccess || per_cu < 1) fprintf(stderr, "occupancy query: %d\n", per_cu);
        (void)hipGetLastError();
        grid = cus;
        if (n_in != 26 || (size_t)out_size != O_END || ws_size < WS_END) { fprintf(stderr, "kernel_launch: unexpected sizes n_in %d out %d ws %zu (need %zu)\n", n_in, out_size, ws_size, (size_t)WS_END); grid = -1; return; }
    }
    if (grid < 0) return;
    if (hipMemsetAsync((char*)d_ws + WS_CTL, 0, 32768, stream) != hipSuccess) { fprintf(stderr, "memset failed\n"); return; }
    KArgs a{};
    for (int i = 0; i < 26; ++i) a.in[i] = (const float*)d_in[i];
    a.out = (float*)d_out; a.ws = (unsigned char*)d_ws;
    void* args[] = {&a};
    hipError_t e = hipLaunchCooperativeKernel((void*)hybrid_fwd, dim3(grid), dim3(NTHR), args, LDS_BYTES, stream);
    if (e != hipSuccess) fprintf(stderr, "cooperative launch failed: %s (grid %d)\n", hipGetErrorString(e), grid);
}
```

```cpp
#include <hip/hip_runtime.h>
#include <hip/hip_cooperative_groups.h>
#include <cstdio>
#include <cstdint>
namespace cg = cooperative_groups;
#define REP_GEMM 1
#define REP_SYNC 1
#define REP_PRO 1
#define REP_MIX 1
#define REP_RET 1
namespace pg8 {
#define PG8_LAS __attribute__((address_space(3)))
typedef unsigned short bf16_t;
typedef short bf16x8 __attribute__((ext_vector_type(8)));
typedef float f32x4 __attribute__((ext_vector_type(4)));
typedef unsigned u32x4 __attribute__((ext_vector_type(4)));
constexpr int BM = 256, BK = 64, HALF = 128, HTB = HALF * BK * 2  , STAGE_BYTES = 8 * HTB, NXCD = 8, WGM = 8;

__host__ __device__ __forceinline__ int lds_byte(int r, int c) { const int st = (r >> 4) * 2 + (c >> 5), rr = r & 15, cc = c & 31, ob = rr * 64 + cc * 2; return st * 1024 + (ob ^ (((ob >> 9) & 1) << 5)); }
__host__ __device__ __forceinline__ void stage_rc(int b, int& R, int& C) { const int st = b / 1024, sb = b % 1024, swz = sb ^ (((sb >> 9) & 1) << 5); R = (st >> 1) * 16 + swz / 64; C = (st & 1) * 32 + (swz % 64) / 2; }
__host__ __device__ __forceinline__ int perm32(int rho) { const int n = rho >> 4, i = rho & 15; return 8 * (i >> 2) + 4 * n + (i & 3); }

struct Unit { int pm, pn; };
struct Gemm { const bf16_t* A; const bf16_t* Bt; int M, N, K; };

struct StaticOrder {
    int nM, nN, nwg, G, c;
    __host__ __device__ void init(int M, int N, int G_, int c_) { nM = M / BM; nN = N / BM; nwg = nM * nN; G = G_; c = c_; }
    __host__ __device__ bool next(int i, Unit& u) const {
        const long L = (long)i * G + c; if (L >= nwg) return false;
        int wgid = (int)L; { const int q = nwg / NXCD, r = nwg % NXCD, xcd = wgid % NXCD, off = wgid / NXCD; wgid = (xcd < r ? xcd * (q + 1) : r * (q + 1) + (xcd - r) * q) + off; }
        const int nig = WGM * nN, gid = wgid / nig, fm = gid * WGM, gsz = (nM - fm) < WGM ? (nM - fm) : WGM;
        u.pm = fm + ((wgid % nig) % gsz); u.pn = (wgid % nig) / gsz; return true;
    }
    __device__ __forceinline__ void a_ready(const Unit&) const {}
    __device__ __forceinline__ void done(const Unit&) const {}
};

__device__ __forceinline__ unsigned cvt_pk_bf16(float lo, float hi) { unsigned r; asm volatile("v_cvt_pk_bf16_f32 %0, %1, %2" : "=v"(r) : "v"(lo), "v"(hi)); return r; }
template <class Epi, class Sched, bool ALIGN_EPI = false, bool SP2 = false>
__device__ __forceinline__ void gemm_phase(PG8_LAS unsigned char* lds, const Gemm g, const Sched& S, const Epi& E, const int wave_id) {
    unsigned m_l = ~0u; asm volatile("" : "+s"(m_l)); int tid_l = (int)__builtin_amdgcn_mbcnt_hi(m_l, __builtin_amdgcn_mbcnt_lo(m_l, 0u)) + 64 * wave_id;
    const int tid = tid_l, wid = __builtin_amdgcn_readfirstlane(tid >> 6), lane = tid & 63, wr = wid >> 2, wc = wid & 3, fr = lane & 15, fq = lane >> 4;
    const int K = g.K, nt = K / BK;
    unsigned voffA[2], voffB[2];
#pragma unroll
    for (int i = 0; i < 2; ++i) { int R, C; stage_rc(tid * 16 + i * 8192, R, C); const int Rb = Epi::PERM ? ((R & ~31) + perm32(R & 31)) : R;
        voffA[i] = (unsigned)(R * K + C) * 2u; voffB[i] = (unsigned)(Rb * K + C) * 2u; }
    const size_t kstep = (size_t)(BK * 2);
    const size_t hstep = (size_t)HALF * K * 2;
    const size_t tstep = 2 * hstep;
    const unsigned ldsw = (unsigned)wid * 1024u;
    const int aoff = lds_byte(wr * 64 + fr, fq * 8), boff = lds_byte(wc * 32 + fr, fq * 8);
#define PG8_SA(b, h) (((b) * 2 + (h)) * HTB)
#define PG8_SB(b, h) ((4 + (b) * 2 + (h)) * HTB)
#define PG8_STAGE(bufoff, gbase, voff) do { _Pragma("unroll") for (int _i = 0; _i < 2; ++_i) \
        __builtin_amdgcn_global_load_lds((const unsigned*)((const char*)(gbase) + (voff)[_i]), (PG8_LAS unsigned*)(lds + (bufoff) + ldsw + _i * 8192), 16, 0, 0); } while (0)
#define PG8_LDA(dst, b, h) do { _Pragma("unroll") for (int m = 0; m < 4; ++m) _Pragma("unroll") for (int k = 0; k < 2; ++k) dst[m][k] = *(const PG8_LAS bf16x8*)(lds + PG8_SA(b, h) + aoff + m * 2048 + k * 1024); } while (0)
#define PG8_LDB(dst, b, h) do { _Pragma("unroll") for (int n = 0; n < 2; ++n) _Pragma("unroll") for (int k = 0; k < 2; ++k) dst[n][k] = *(const PG8_LAS bf16x8*)(lds + PG8_SB(b, h) + boff + n * 2048 + k * 1024); } while (0)
#define PG8_MMA(ai, bj, At, Bt) do { __builtin_amdgcn_s_setprio(1); _Pragma("unroll") for (int m = 0; m < 4; ++m) _Pragma("unroll") for (int n = 0; n < 2; ++n) _Pragma("unroll") for (int k = 0; k < 2; ++k) \
        acc[ai][bj][m][n] = __builtin_amdgcn_mfma_f32_16x16x32_bf16(Bt[n][k], At[m][k], acc[ai][bj][m][n], 0, 0, 0); __builtin_amdgcn_s_setprio(0); } while (0)
#define PG8_WAIT_V(n) asm volatile("s_waitcnt vmcnt(" #n ")" ::: "memory")
#define PG8_WAIT_L(n) asm volatile("s_waitcnt lgkmcnt(" #n ")" ::: "memory")
#define PG8_BAR __builtin_amdgcn_s_barrier()
#define PG8_SCHED __builtin_amdgcn_sched_barrier(0)
    Unit cur, nxt; int ui = 0;
    if (!S.next(0, cur)) return;
    f32x4 acc[2][2][4][2];
#pragma unroll
    for (int a = 0; a < 2; ++a)
#pragma unroll
        for (int b = 0; b < 2; ++b)
#pragma unroll
            for (int m = 0; m < 4; ++m)
#pragma unroll
                for (int n = 0; n < 2; ++n) acc[a][b][m][n] = (f32x4){0.f, 0.f, 0.f, 0.f};
    bf16x8 At[4][2], B0[2][2], B1[2][2];
    const char* cA = (const char*)g.A + (size_t)cur.pm * tstep; const char* cB = (const char*)g.Bt + (size_t)cur.pn * tstep;
    S.a_ready(cur);
    if constexpr (SP2) {
        PG8_STAGE(PG8_SB(0, 0), cB, voffB); PG8_STAGE(PG8_SB(0, 1), cB + hstep, voffB); PG8_STAGE(PG8_SA(0, 0), cA, voffA); PG8_STAGE(PG8_SA(0, 1), cA + hstep, voffA);
        if (wr == 1) PG8_BAR;
        PG8_WAIT_V(2); PG8_BAR;
        PG8_STAGE(PG8_SB(1, 0), cB + kstep, voffB); PG8_STAGE(PG8_SA(1, 0), cA + kstep, voffA); PG8_STAGE(PG8_SB(1, 1), cB + hstep + kstep, voffB);
        PG8_WAIT_V(6); PG8_BAR;
    } else {
        PG8_STAGE(PG8_SB(0, 0), cB, voffB); PG8_STAGE(PG8_SA(0, 0), cA, voffA); PG8_STAGE(PG8_SB(0, 1), cB + hstep, voffB); PG8_STAGE(PG8_SA(0, 1), cA + hstep, voffA);
        if (wr == 1) PG8_BAR;
        PG8_WAIT_V(4); PG8_BAR;
        PG8_STAGE(PG8_SB(1, 0), cB + kstep, voffB); PG8_STAGE(PG8_SA(1, 0), cA + kstep, voffA); PG8_STAGE(PG8_SB(1, 1), cB + hstep + kstep, voffB);
        PG8_WAIT_V(6); PG8_BAR;
    }
    for (;;) {
        const bool has_next = S.next(ui + 1, nxt);
        const char* nA = has_next ? (const char*)g.A + (size_t)nxt.pm * tstep : cA; const char* nB = has_next ? (const char*)g.Bt + (size_t)nxt.pn * tstep : cB;
        for (int t = 0; t < nt; t += 2) {
            const bool last = (t == nt - 2);
            const char* a1 = cA + (size_t)(t + 1) * kstep;
            const char* a2 = last ? nA : cA + (size_t)(t + 2) * kstep; const char* b2 = last ? nB : cB + (size_t)(t + 2) * kstep;
            const char* a3 = a2 + kstep; const char* b3 = b2 + kstep;
            if (last && has_next) S.a_ready(nxt);
            if constexpr (SP2) {
            PG8_LDB(B0, 0, 0); PG8_LDB(B1, 0, 1); PG8_SCHED; PG8_LDA(At, 0, 0); PG8_STAGE(PG8_SA(1, 1), a1 + hstep, voffA);
            PG8_WAIT_V(8); PG8_WAIT_L(0); PG8_BAR; PG8_MMA(0, 0, At, B0); PG8_MMA(0, 1, At, B1); PG8_BAR; PG8_SCHED;
            PG8_LDA(At, 0, 1); PG8_STAGE(PG8_SB(0, 0), b2, voffB); PG8_STAGE(PG8_SB(0, 1), b2 + hstep, voffB); PG8_STAGE(PG8_SA(0, 0), a2, voffA);
            PG8_WAIT_V(8); PG8_WAIT_L(0); PG8_BAR; PG8_MMA(1, 0, At, B0); PG8_MMA(1, 1, At, B1); PG8_BAR; PG8_SCHED;
            PG8_LDB(B0, 1, 0); PG8_LDB(B1, 1, 1); PG8_SCHED; PG8_LDA(At, 1, 0); PG8_STAGE(PG8_SA(0, 1), a2 + hstep, voffA);
            PG8_WAIT_V(8); PG8_WAIT_L(0); PG8_BAR; PG8_MMA(0, 0, At, B0); PG8_MMA(0, 1, At, B1); PG8_BAR; PG8_SCHED;
            PG8_LDA(At, 1, 1); PG8_STAGE(PG8_SB(1, 0), b3, voffB); PG8_STAGE(PG8_SB(1, 1), b3 + hstep, voffB); PG8_STAGE(PG8_SA(1, 0), a3, voffA);
            PG8_WAIT_V(8); PG8_WAIT_L(0); PG8_BAR; PG8_MMA(1, 0, At, B0); PG8_MMA(1, 1, At, B1); PG8_BAR; PG8_SCHED;
            } else {
            PG8_LDB(B0, 0, 0); PG8_SCHED; PG8_LDA(At, 0, 0); PG8_STAGE(PG8_SA(1, 1), a1 + hstep, voffA);
            PG8_WAIT_L(8); PG8_BAR; PG8_WAIT_L(0); PG8_MMA(0, 0, At, B0); PG8_BAR; PG8_SCHED;
            PG8_LDB(B1, 0, 1); PG8_STAGE(PG8_SB(0, 0), b2, voffB);
            PG8_BAR; PG8_WAIT_L(0); PG8_MMA(0, 1, At, B1); PG8_BAR;
            PG8_LDA(At, 0, 1); PG8_STAGE(PG8_SA(0, 0), a2, voffA);
            PG8_BAR; PG8_WAIT_L(0); PG8_MMA(1, 0, At, B0); PG8_BAR; PG8_SCHED;
            PG8_STAGE(PG8_SB(0, 1), b2 + hstep, voffB);
            PG8_WAIT_V(6); PG8_BAR; PG8_MMA(1, 1, At, B1); PG8_BAR;
            PG8_LDB(B0, 1, 0); PG8_SCHED; PG8_LDA(At, 1, 0); PG8_STAGE(PG8_SA(0, 1), a2 + hstep, voffA);
            PG8_WAIT_L(8); PG8_BAR; PG8_WAIT_L(0); PG8_MMA(0, 0, At, B0); PG8_BAR; PG8_SCHED;
            PG8_LDB(B1, 1, 1); PG8_STAGE(PG8_SB(1, 0), b3, voffB);
            PG8_BAR; PG8_WAIT_L(0); PG8_MMA(0, 1, At, B1); PG8_BAR;
            PG8_LDA(At, 1, 1); PG8_STAGE(PG8_SA(1, 0), a3, voffA);
            PG8_BAR; PG8_WAIT_L(0); PG8_MMA(1, 0, At, B0); PG8_BAR; PG8_SCHED;
            PG8_STAGE(PG8_SB(1, 1), b3 + hstep, voffB);
            PG8_WAIT_V(6); PG8_BAR; PG8_MMA(1, 1, At, B1); PG8_BAR;
            }
        }
        if constexpr (ALIGN_EPI) { if (wr == 0) PG8_BAR; }
        if constexpr (!Epi::AFTER_DRAIN) { Unit cu = cur; int fr_l = fr, fq_l = fq; asm volatile("" : "+s"(cu.pm), "+s"(cu.pn), "+v"(fr_l), "+v"(fq_l)); E(acc, cu, wr, wc, fr_l, fq_l); S.done(cur); }
        if (!has_next) break;
#pragma unroll
        for (int a = 0; a < 2; ++a)
#pragma unroll
            for (int b = 0; b < 2; ++b)
#pragma unroll
                for (int m = 0; m < 4; ++m)
#pragma unroll
                    for (int n = 0; n < 2; ++n) acc[a][b][m][n] = (f32x4){0.f, 0.f, 0.f, 0.f};
        cur = nxt; cA = nA; cB = nB; ++ui;
        if constexpr (ALIGN_EPI) { if (wr == 1) PG8_BAR; }
    }
    PG8_WAIT_V(0);
    if constexpr (!ALIGN_EPI) { if (wr == 0) PG8_BAR; }
    PG8_BAR;
    if constexpr (Epi::AFTER_DRAIN) { E.fused(acc, cur, wr, wc, fr, fq, lds, wid, lane); S.done(cur); }
#undef PG8_SA
#undef PG8_SB
#undef PG8_STAGE
#undef PG8_LDA
#undef PG8_LDB
#undef PG8_MMA
#undef PG8_WAIT_V
#undef PG8_WAIT_L
#undef PG8_BAR
#undef PG8_SCHED
}
}

#define LAS __attribute__((address_space(3)))
typedef unsigned short bf16_t;
typedef short bf16x8 __attribute__((ext_vector_type(8)));
typedef float f32x4 __attribute__((ext_vector_type(4)));
typedef float f32x2 __attribute__((ext_vector_type(2)));
typedef float f32x16 __attribute__((ext_vector_type(16)));
typedef unsigned u32x4 __attribute__((ext_vector_type(4)));
typedef unsigned u32x2 __attribute__((ext_vector_type(2)));
#define DI __device__ __forceinline__
#define MFMA32(a, b, c) __builtin_amdgcn_mfma_f32_32x32x16_bf16((a), (b), (c), 0, 0, 0)

constexpr int M = 16896, MP = 16384, D = 1024, FF = 2816;
constexpr float EPS = 1e-6f;
constexpr int NTHR = 512;
constexpr int LDS_BYTES = 136 * 1024;

constexpr size_t O_Y = 0;
constexpr size_t O_LRUH_P = (size_t)M * 1024;
constexpr size_t O_CONV_P = O_LRUH_P + 8192;
constexpr size_t O_SBK_P = O_CONV_P + 24576;
constexpr size_t O_SBV_P = O_SBK_P + 16777216;
constexpr size_t O_RET_P = O_SBV_P + 16777216;
constexpr size_t O_LRUH_S = O_RET_P + 8388608;
constexpr size_t O_CONV_S = O_LRUH_S + 8192;
constexpr size_t O_SBK_S = O_CONV_S + 24576;
constexpr size_t O_SBV_S = O_SBK_S + 524288;
constexpr size_t O_RET_S = O_SBV_S + 524288;
constexpr size_t O_END = O_RET_S + 8388608;

constexpr size_t SZ_M1K = (size_t)M * 1024 * 2;
constexpr size_t WS_CTL = 0;
constexpr size_t WS_PAR = 65536;
constexpr int PO_H0 = 0, PO_CST = PO_H0 + 8192, PO_NG = PO_CST + 24576, PO_CW = PO_NG + 32768, PO_CB = PO_CW + 4096, PO_WR = PO_CB + 1024, PO_BR = PO_WR + 65536,
              PO_WI = PO_BR + 1024, PO_BI = PO_WI + 65536, PO_LAM = PO_BI + 1024, PO_END = PO_LAM + 1024;
static_assert((size_t)PO_END * 4 + 65536 <= (1u << 20), "param block");
constexpr size_t WS_WGU = 1u << 20;
constexpr size_t SZ_WGU1 = (size_t)5632 * 1024 * 2;
constexpr size_t WS_WDN = WS_WGU + 8 * SZ_WGU1;
constexpr size_t SZ_WDN1 = (size_t)1024 * 2816 * 2;
constexpr size_t WS_WPG = WS_WDN + 8 * SZ_WDN1;
constexpr size_t SZ_W1K = (size_t)1024 * 1024 * 2;
constexpr size_t WS_WPI = WS_WPG + 4 * SZ_W1K;
constexpr size_t SZ_WPI1 = (size_t)1024 * 256 * 2;
constexpr size_t WS_WABI = WS_WPI + 4 * SZ_WPI1;
constexpr size_t SZ_WABI1 = (size_t)2560 * 1024 * 2;
constexpr size_t WS_WABO = WS_WABI + 2 * SZ_WABI1;
constexpr size_t WS_WCI = WS_WABO + 2 * SZ_W1K;
constexpr size_t SZ_WCI1 = (size_t)6144 * 1024 * 2;
constexpr size_t WS_WCO = WS_WCI + 2 * SZ_WCI1;
constexpr size_t SZ_WCO1 = (size_t)1024 * 2048 * 2;
constexpr size_t WS_H = WS_WCO + 2 * SZ_WCO1;
constexpr size_t WS_ACT = WS_H + SZ_M1K;
constexpr size_t WS_Y = WS_ACT + (size_t)M * 2816 * 2;
constexpr size_t WS_PE = WS_Y + SZ_M1K;
constexpr size_t WS_KBS = WS_PE + SZ_M1K;
constexpr size_t SZ_KBS1 = (size_t)64 * 2112 * 64 * 2;
constexpr size_t WS_VTS = WS_KBS + 2 * SZ_KBS1;
constexpr size_t WS_TAB = WS_VTS + 2 * SZ_KBS1;
constexpr size_t SZ_TAB1 = (size_t)2112 * 128 * 4;
constexpr size_t WS_MIX = WS_TAB + 2 * SZ_TAB1;
constexpr size_t WS_XAQ = WS_MIX;
constexpr size_t WS_KBP = WS_XAQ + (size_t)M * 1536 * 2;
constexpr size_t WS_VTP = WS_KBP + (size_t)64 * 2048 * 64 * 2;
constexpr size_t WS_MIXE = WS_VTP + (size_t)64 * 2048 * 64 * 2;
constexpr size_t WS_KR = WS_MIX;
constexpr size_t WS_GG = WS_KR + SZ_M1K;
constexpr size_t WS_KT = WS_GG + 2 * SZ_M1K;
constexpr size_t WS_VT = WS_KT + SZ_M1K;
constexpr size_t WS_END = WS_VT + 2 * SZ_M1K;
constexpr size_t WS_PB = WS_MIX;
constexpr size_t WS_QR = WS_Y;
constexpr size_t WS_OB = WS_ACT;

struct KArgs { const float* in[26]; float* out; unsigned char* ws; };
#define PAR(a_, off_) ((const float*)((a_).ws + WS_PAR) + (off_))

DI float lane_xor(float v, int lane, int o) { return __builtin_bit_cast(float, __builtin_amdgcn_ds_bpermute((lane ^ o) << 2, __builtin_bit_cast(int, v))); }
DI float wave_sum(float v, int lane) {
#pragma unroll
    for (int o = 1; o < 64; o <<= 1) v += lane_xor(v, lane, o);
    return v;
}
typedef __bf16 bf16v2_t __attribute__((ext_vector_type(2)));
DI unsigned pk2(float lo, float hi) { const f32x2 v = {lo, hi}; return __builtin_bit_cast(unsigned, __builtin_convertvector(v, bf16v2_t)); }
DI unsigned f2bf(float f) { return pk2(f, 0.f) & 0xffffu; }
DI float bflo(unsigned w) { return __uint_as_float(w << 16); }
DI float bfhi(unsigned w) { return __uint_as_float(w & 0xffff0000u); }
DI float bf1(bf16_t h) { return __uint_as_float((unsigned)h << 16); }
DI float sigmoidf_(float x) { return __builtin_amdgcn_rcpf(1.f + __expf(-x)); }
DI void row_dec(int r, int& g, int& b, int& t) { if (r < MP) { g = 0; b = r >> 11; t = r & 2047; } else { g = 1; const int q = r - MP; b = q >> 6; t = q & 63; } }
DI int crow(int reg, int h) { return (reg & 3) + 8 * (reg >> 2) + 4 * h; }
#define WAVE_LDS_SYNC() do { asm volatile("s_waitcnt lgkmcnt(0)" ::: "memory"); __builtin_amdgcn_wave_barrier(); asm volatile("" ::: "memory"); } while (0)

using pg8::Unit;
typedef const f32x4 (&AccRef)[2][2][4][2];

struct EpiSwiGLU {
    static constexpr bool PERM = true, AFTER_DRAIN = false;
    bf16_t* O;
    DI void operator()(AccRef acc, const Unit& u, int wr, int wc, int fr, int fq) const {
        const int row0 = u.pm * 256 + wr * 64 + fr, col0 = u.pn * 128 + wc * 32 + 8 * fq;
#pragma unroll
        for (int ai = 0; ai < 2; ++ai)
#pragma unroll
            for (int m = 0; m < 4; ++m) {
                float v[8];
#pragma unroll
                for (int n = 0; n < 2; ++n)
#pragma unroll
                    for (int i = 0; i < 4; ++i) { const float g = acc[ai][0][m][n][i], up = acc[ai][1][m][n][i]; v[n * 4 + i] = g * up * sigmoidf_(g); }
                u32x4 w; w.x = pk2(v[0], v[1]); w.y = pk2(v[2], v[3]); w.z = pk2(v[4], v[5]); w.w = pk2(v[6], v[7]);
                *(u32x4*)(O + (size_t)(row0 + ai * 128 + m * 16) * FF + col0) = w;
            }
    }
};
struct EpiY {
    static constexpr bool PERM = true, AFTER_DRAIN = false;
    bf16_t* O; const bf16_t* PE;
    DI void operator()(AccRef acc, const Unit& u, int wr, int wc, int fr, int fq) const {
        const int row0 = u.pm * 256 + wr * 64 + fr, col0 = u.pn * 256 + wc * 32 + 8 * fq;
#pragma unroll
        for (int ai = 0; ai < 2; ++ai)
#pragma unroll
            for (int m = 0; m < 4; ++m)
#pragma unroll
                for (int bj = 0; bj < 2; ++bj) {
                    const size_t off = (size_t)(row0 + ai * 128 + m * 16) * 1024 + col0 + bj * 128;
                    f32x4 v0 = acc[ai][bj][m][0], v1 = acc[ai][bj][m][1];
                    if (PE) {
                        const u32x4 p = *(const u32x4*)(PE + off);
                        v0[0] = sigmoidf_(v0[0]) * bflo(p.x); v0[1] = sigmoidf_(v0[1]) * bfhi(p.x); v0[2] = sigmoidf_(v0[2]) * bflo(p.y); v0[3] = sigmoidf_(v0[3]) * bfhi(p.y);
                        v1[0] = sigmoidf_(v1[0]) * bflo(p.z); v1[1] = sigmoidf_(v1[1]) * bfhi(p.z); v1[2] = sigmoidf_(v1[2]) * bflo(p.w); v1[3] = sigmoidf_(v1[3]) * bfhi(p.w);
                    }
                    u32x4 w; w.x = pk2(v0[0], v0[1]); w.y = pk2(v0[2], v0[3]); w.z = pk2(v1[0], v1[1]); w.w = pk2(v1[2], v1[3]);
                    *(u32x4*)(O + off) = w;
                }
    }
};
struct EpiAB {
    static constexpr bool PERM = true, AFTER_DRAIN = false;
    bf16_t* XAQ; bf16_t* KBP; bf16_t* VTP; bf16_t* KBS; bf16_t* VTS; float* out; int j;
    DI void operator()(AccRef acc, const Unit& u, int wr, int wc, int fr, int fq) const {
        const int row0 = u.pm * 256 + wr * 64 + fr, offc = wc * 32 + 8 * fq;
        if (u.pn < 6) {
#pragma unroll
            for (int ai = 0; ai < 2; ++ai)
#pragma unroll
                for (int m = 0; m < 4; ++m)
#pragma unroll
                    for (int bj = 0; bj < 2; ++bj) {
                        const f32x4 v0 = acc[ai][bj][m][0], v1 = acc[ai][bj][m][1];
                        u32x4 w; w.x = pk2(v0[0], v0[1]); w.y = pk2(v0[2], v0[3]); w.z = pk2(v1[0], v1[1]); w.w = pk2(v1[2], v1[3]);
                        *(u32x4*)(XAQ + (size_t)(row0 + ai * 128 + m * 16) * 1536 + u.pn * 256 + bj * 128 + offc) = w;
                    }
        } else {
            const bool isv = u.pn >= 8;
#pragma unroll
            for (int ai = 0; ai < 2; ++ai)
#pragma unroll
                for (int m = 0; m < 4; ++m) {
                    const int r = row0 + ai * 128 + m * 16; int g, b, t; row_dec(r, g, b, t);
                    float* of = out + (g ? (isv ? O_SBV_S : O_SBK_S) + (size_t)j * (512 * 512) + (size_t)(r - MP) * 512
                                         : (isv ? O_SBV_P : O_SBK_P) + (size_t)j * ((size_t)MP * 512) + (size_t)r * 512);
#pragma unroll
                    for (int bj = 0; bj < 2; ++bj) {
                        const int c = ((u.pn & 1) * 256) + bj * 128 + offc, head = c >> 6, d = c & 63;
                        const f32x4 v0 = acc[ai][bj][m][0], v1 = acc[ai][bj][m][1];
                        *(f32x4*)(of + c) = v0; *(f32x4*)(of + c + 4) = v1;
                        if (!isv) {
                            u32x4 w; w.x = pk2(v0[0], v0[1]); w.y = pk2(v0[2], v0[3]); w.z = pk2(v1[0], v1[1]); w.w = pk2(v1[2], v1[3]);
                            bf16_t* kb = g ? KBS + ((size_t)(b * 8 + head) * 2112 + 2048 + t) * 64 + d : KBP + ((size_t)(b * 8 + head) * 2048 + t) * 64 + d;
                            *(u32x4*)kb = w;
                        } else {
                            const size_t T = g ? 2112 : 2048;
                            bf16_t* vt = g ? VTS + ((size_t)(b * 8 + head) * 64 + d) * 2112 + 2048 + t : VTP + ((size_t)(b * 8 + head) * 64 + d) * 2048 + t;
#pragma unroll
                            for (int i = 0; i < 4; ++i) { vt[(size_t)i * T] = (bf16_t)f2bf(v0[i]); vt[(size_t)(4 + i) * T] = (bf16_t)f2bf(v1[i]); }
                        }
                    }
                }
        }
    }
};
struct EpiC {
    static constexpr bool PERM = true, AFTER_DRAIN = false;
    bf16_t* QR; bf16_t* KR; bf16_t* KT; bf16_t* VT; bf16_t* GG; const float* ctab; const float* stab;
    DI void operator()(AccRef acc, const Unit& u, int wr, int wc, int fr, int fq) const {
        const int row0 = u.pm * 256 + wr * 64 + fr, offc = wc * 32 + 8 * fq;
        if (u.pn < 8) {
            const bool isk = u.pn >= 4; const int head = u.pn & 3; const float sc = isk ? 0.0625f : 1.f;
            const float lg2h = log2f(1.f - exp2f(-5.f - (float)head));
            bf16_t* dst = isk ? KR : QR;
#pragma unroll
            for (int ai = 0; ai < 2; ++ai)
#pragma unroll
                for (int m = 0; m < 4; ++m) {
                    const int r = row0 + ai * 128 + m * 16; int g, b, t; row_dec(r, g, b, t);
                    const int pos = g ? 2048 + t : t;
                    const size_t T = g ? 64 : 2048;
                    bf16_t* kt = g ? KT + (size_t)MP * 1024 + ((size_t)(b * 4 + head) * 256 + offc) * 64 + t : KT + ((size_t)(b * 4 + head) * 256 + offc) * 2048 + t;
                    const float zeta = __builtin_amdgcn_exp2f(lg2h * (float)(63 - (t & 63)));
#pragma unroll
                    for (int n = 0; n < 2; ++n) {
                        const f32x4 cc = *(const f32x4*)(ctab + pos * 128 + offc + 4 * n), ss = *(const f32x4*)(stab + pos * 128 + offc + 4 * n);
                        const f32x4 x1 = acc[ai][0][m][n] * sc, x2 = acc[ai][1][m][n] * sc;
                        const f32x4 ra = x1 * cc - x2 * ss, rb = x2 * cc + x1 * ss;
                        u32x2 w1, w2; w1.x = pk2(ra[0], ra[1]); w1.y = pk2(ra[2], ra[3]); w2.x = pk2(rb[0], rb[1]); w2.y = pk2(rb[2], rb[3]);
                        *(u32x2*)(dst + (size_t)r * 1024 + head * 256 + offc + 4 * n) = w1;
                        *(u32x2*)(dst + (size_t)r * 1024 + head * 256 + 128 + offc + 4 * n) = w2;
                        if (isk) {
#pragma unroll
                            for (int i = 0; i < 4; ++i) { kt[(size_t)(4 * n + i) * T] = (bf16_t)f2bf(ra[i] * zeta); kt[(size_t)(128 + 4 * n + i) * T] = (bf16_t)f2bf(rb[i] * zeta); }
                        }
                        asm volatile("" ::: "memory");
                    }
                }
        } else if (u.pn < 16) {
#pragma unroll
            for (int ai = 0; ai < 2; ++ai)
#pragma unroll
                for (int m = 0; m < 4; ++m) {
                    const int r = row0 + ai * 128 + m * 16; int g, b, t; row_dec(r, g, b, t);
                    const size_t T = g ? 64 : 2048;
#pragma unroll
                    for (int bj = 0; bj < 2; ++bj) {
                        const int eg = (u.pn - 8) * 256 + bj * 128 + offc, head = eg >> 9, e = eg & 511;
                        bf16_t* vt = g ? VT + (size_t)MP * 2048 + ((size_t)(b * 4 + head) * 512 + e) * 64 + t : VT + ((size_t)(b * 4 + head) * 512 + e) * 2048 + t;
                        const f32x4 v0 = acc[ai][bj][m][0], v1 = acc[ai][bj][m][1];
#pragma unroll
                        for (int i = 0; i < 4; ++i) { vt[(size_t)i * T] = (bf16_t)f2bf(v0[i]); vt[(size_t)(4 + i) * T] = (bf16_t)f2bf(v1[i]); }
                    }
                }
        } else {
#pragma unroll
            for (int ai = 0; ai < 2; ++ai)
#pragma unroll
                for (int m = 0; m < 4; ++m)
#pragma unroll
                    for (int bj = 0; bj < 2; ++bj) {
                        const f32x4 v0 = acc[ai][bj][m][0], v1 = acc[ai][bj][m][1];
                        u32x4 w; w.x = pk2(v0[0], v0[1]); w.y = pk2(v0[2], v0[3]); w.z = pk2(v1[0], v1[1]); w.w = pk2(v1[2], v1[3]);
                        *(u32x4*)(GG + (size_t)(row0 + ai * 128 + m * 16) * 2048 + (u.pn - 16) * 256 + bj * 128 + offc) = w;
                    }
        }
    }
};

DI void tr_item(const float* in, size_t ldi, bf16_t* out, size_t ldo, int k0, int n0, int drow0, LAS float* scr, int lane) {
#pragma unroll 8
    for (int i = 0; i < 32; ++i) { const int kk = 2 * i + (lane >> 5); scr[kk * 33 + (lane & 31)] = in[(size_t)(k0 + kk) * ldi + n0 + (lane & 31)]; }
    WAVE_LDS_SYNC();
    const int c = lane & 7;
#pragma unroll
    for (int jj = 0; jj < 4; ++jj) { const int n = (lane >> 3) + 8 * jj; const LAS float* s = scr + (8 * c) * 33 + n;
        u32x4 o; o.x = pk2(s[0 * 33], s[1 * 33]); o.y = pk2(s[2 * 33], s[3 * 33]); o.z = pk2(s[4 * 33], s[5 * 33]); o.w = pk2(s[6 * 33], s[7 * 33]);
        *(u32x4*)(out + (size_t)(drow0 + n) * ldo + k0 + 8 * c) = o; }
    WAVE_LDS_SYNC();
}
DI void tr_plain(const float* W, int K, int N, bf16_t* WT, int it, LAS float* scr, int lane) {
    const int nblk = N / 32, kb = it / nblk, nb = it % nblk;
    tr_item(W, (size_t)N, WT, (size_t)K, kb * 64, nb * 32, nb * 32, scr, lane);
}

DI void prologue_phase(const KArgs& a, LAS unsigned char* lds, int vcu, int G, int tid, int wave, int lane) {
    unsigned char* ws = a.ws;
    LAS float* scr = (LAS float*)(lds + wave * 8704);
    const int gw = vcu * 8 + wave, NGW = G * 8;
    if (blockIdx.x == 0 && tid < 64) ((unsigned*)(ws + WS_CTL))[tid * 64] = 0u;
    constexpr int I_FFN = 1408, N_FFN = 8 * 3 * I_FFN;
    constexpr int I_PG = 512, I_PI = 128, I_ABI = 1280, I_ABO = 512, I_CI = 3072, I_CO = 1024, I_CV = 64;
    constexpr int E0 = N_FFN, E1 = E0 + 4 * I_PG, E2 = E1 + 4 * I_PI, E3 = E2 + 2 * I_ABI, E4 = E3 + 2 * I_ABO, E5 = E4 + 2 * I_CI, E6 = E5 + 2 * I_CO, E7 = E6 + 128 * I_CV;
    for (int it = gw; it < E7; it += NGW) {
        if (it < E0) {
            const int mf = it / (3 * I_FFN), r = it % (3 * I_FFN), kind = r / I_FFN, q = r % I_FFN;
            if (kind < 2) {
                const float* W = a.in[10 + kind] + (size_t)mf * 1024 * FF;
                const int kb = q / 88, nb = q % 88, n0 = nb * 32;
                tr_item(W, FF, (bf16_t*)(ws + WS_WGU + (size_t)mf * SZ_WGU1), 1024, kb * 64, n0, (n0 >> 7) * 256 + kind * 128 + (n0 & 127), scr, lane);
            } else {
                tr_plain(a.in[12] + (size_t)mf * FF * 1024, FF, 1024, (bf16_t*)(ws + WS_WDN + (size_t)mf * SZ_WDN1), q, scr, lane);
            }
        } else if (it < E1) { const int q = it - E0, l = q / I_PG; tr_plain(a.in[14] + (size_t)l * 1024 * 1024, 1024, 1024, (bf16_t*)(ws + WS_WPG + (size_t)l * SZ_W1K), q % I_PG, scr, lane); }
        else if (it < E2) { const int q = it - E1, l = q / I_PI; tr_plain(a.in[13] + (size_t)l * 256 * 1024, 256, 1024, (bf16_t*)(ws + WS_WPI + (size_t)l * SZ_WPI1), q % I_PI, scr, lane); }
        else if (it < E3) { const int q = it - E2, l = q / I_ABI; tr_plain(a.in[15] + (size_t)l * 1024 * 2560, 1024, 2560, (bf16_t*)(ws + WS_WABI + (size_t)l * SZ_WABI1), q % I_ABI, scr, lane); }
        else if (it < E4) { const int q = it - E3, l = q / I_ABO; tr_plain(a.in[16] + (size_t)l * 1024 * 1024, 1024, 1024, (bf16_t*)(ws + WS_WABO + (size_t)l * SZ_W1K), q % I_ABO, scr, lane); }
        else if (it < E5) { const int q = it - E4, l = q / I_CI; tr_plain(a.in[24] + (size_t)l * 1024 * 6144, 1024, 6144, (bf16_t*)(ws + WS_WCI + (size_t)l * SZ_WCI1), q % I_CI, scr, lane); }
        else if (it < E6) { const int q = it - E5, l = q / I_CO; tr_plain(a.in[25] + (size_t)l * 2048 * 1024, 2048, 1024, (bf16_t*)(ws + WS_WCO + (size_t)l * SZ_WCO1), q % I_CO, scr, lane); }
        else {
            const int q = it - E6, jbh = q / I_CV, r = q % I_CV, jb = jbh >> 3, h = jbh & 7, kb = r >> 1, nb = r & 1;
            tr_item(a.in[7] + (size_t)jb * 2048 * 512 + h * 64, 512, (bf16_t*)(ws + WS_VTS) + (size_t)jbh * 64 * 2112, 2112, kb * 64, nb * 32, nb * 32, scr, lane);
        }
    }
    const int gt = vcu * NTHR + tid, NGT = G * NTHR;
    {
        float* par = (float*)(ws + WS_PAR);
        for (int it = gt; it < PO_END; it += NGT) {
            float v;
            if (it < PO_CST) v = a.in[4][it - PO_H0]; else if (it < PO_NG) v = a.in[5][it - PO_CST]; else if (it < PO_CW) v = a.in[9][it - PO_NG];
            else if (it < PO_CB) v = a.in[17][it - PO_CW]; else if (it < PO_WR) v = a.in[18][it - PO_CB]; else if (it < PO_BR) v = a.in[19][it - PO_WR];
            else if (it < PO_WI) v = a.in[20][it - PO_BR]; else if (it < PO_BI) v = a.in[21][it - PO_WI]; else if (it < PO_LAM) v = a.in[22][it - PO_BI];
            else v = a.in[23][it - PO_LAM];
            par[it] = v;
        }
    }
    for (int it = gt; it < 2 * 8 * 2048 * 64; it += NGT) {
        const int d8 = it & 7, h = (it >> 3) & 7, t = (it >> 6) & 2047, jb = it >> 17;
        const float* s = a.in[6] + ((size_t)(jb * 2048 + t) * 512 + h * 64 + d8 * 8);
        const f32x4 v0 = *(const f32x4*)s, v1 = *(const f32x4*)(s + 4);
        u32x4 w; w.x = pk2(v0[0], v0[1]); w.y = pk2(v0[2], v0[3]); w.z = pk2(v1[0], v1[1]); w.w = pk2(v1[2], v1[3]);
        *(u32x4*)((bf16_t*)(ws + WS_KBS) + ((size_t)(jb * 8 + h) * 2112 + t) * 64 + d8 * 8) = w;
    }
    for (int it = gt; it < 2112 * 128; it += NGT) {
        const int pos = it >> 7, jf = it & 127;
        const float freq = exp2f(-(float)jf * (13.287712379549449f / 128.f));
        const float ang = (float)pos * freq;
        const double rev = (double)ang * 0.15915494309189535; const float fr = (float)(rev - floor(rev));
        ((float*)(ws + WS_TAB))[it] = __builtin_amdgcn_cosf(fr); ((float*)(ws + WS_TAB + SZ_TAB1))[it] = __builtin_amdgcn_sinf(fr);
    }
}
DI void pconv_phase(const KArgs& a, int l, int gt, int NGT) {
    bf16_t* PB = (bf16_t*)(a.ws + WS_PB);
    for (int it = gt; it < M * 32; it += NGT) {
        const int r = it >> 5, c8 = (it & 31) * 8;
        const float* s = (r < MP) ? a.in[2] + ((size_t)l * MP + r) * 256 + c8 : a.in[3] + ((size_t)l * 512 + (r - MP)) * 256 + c8;
        const f32x4 v0 = *(const f32x4*)s, v1 = *(const f32x4*)(s + 4);
        u32x4 w; w.x = pk2(v0[0], v0[1]); w.y = pk2(v0[2], v0[3]); w.z = pk2(v1[0], v1[1]); w.w = pk2(v1[2], v1[3]);
        *(u32x4*)(PB + (size_t)r * 256 + c8) = w;
    }
}
DI void rowwise_phase(const KArgs& a, const bf16_t* Y, const float* ga, float c, const float* gb, int gw, int NGW, int lane) {
    float* X = a.out; bf16_t* H = (bf16_t*)(a.ws + WS_H);
    for (int r = gw; r < M; r += NGW) {
        f32x4 x[4]; float ss = 0.f;
        if (Y) {
            f32x4 y[4];
#pragma unroll
            for (int q = 0; q < 4; ++q) { const int col = 4 * lane + 256 * q; const u32x2 w = *(const u32x2*)(Y + (size_t)r * 1024 + col);
                y[q] = (f32x4){bflo(w.x), bfhi(w.x), bflo(w.y), bfhi(w.y)}; x[q] = *(const f32x4*)(X + (size_t)r * 1024 + col);
                ss += (y[q][0] * y[q][0] + y[q][1] * y[q][1]) + (y[q][2] * y[q][2] + y[q][3] * y[q][3]); }
            const float rs = c * rsqrtf(wave_sum(ss, lane) * (1.f / 1024.f) + EPS);
#pragma unroll
            for (int q = 0; q < 4; ++q) { const int col = 4 * lane + 256 * q; const f32x4 g = *(const f32x4*)(ga + col); x[q] = x[q] + y[q] * g * rs; *(f32x4*)(X + (size_t)r * 1024 + col) = x[q]; }
        } else {
            const float* src = (r < MP) ? a.in[0] + (size_t)r * 1024 : a.in[1] + (size_t)(r - MP) * 1024;
#pragma unroll
            for (int q = 0; q < 4; ++q) { const int col = 4 * lane + 256 * q; x[q] = *(const f32x4*)(src + col); *(f32x4*)(X + (size_t)r * 1024 + col) = x[q]; }
        }
        if (gb) {
            float s2 = 0.f;
#pragma unroll
            for (int q = 0; q < 4; ++q) s2 += (x[q][0] * x[q][0] + x[q][1] * x[q][1]) + (x[q][2] * x[q][2] + x[q][3] * x[q][3]);
            const float rs2 = rsqrtf(wave_sum(s2, lane) * (1.f / 1024.f) + EPS);
#pragma unroll
            for (int q = 0; q < 4; ++q) { const int col = 4 * lane + 256 * q; const f32x4 g = *(const f32x4*)(gb + col); const f32x4 h = x[q] * g * rs2;
                u32x2 w; w.x = pk2(h[0], h[1]); w.y = pk2(h[2], h[3]); *(u32x2*)(H + (size_t)r * 1024 + col) = w; }
        }
    }
}
DI void lru_unit(const KArgs& a, int j, int g, int b, int hb, LAS unsigned char* lds, int wave, int lane_in) {
    int lane = lane_in; asm volatile("" : "+v"(lane));
    const int tid = wave * 64 + lane;
    const bf16_t* XAQ = (const bf16_t*)(a.ws + WS_XAQ); bf16_t* MIX = (bf16_t*)(a.ws + WS_MIXE);
    const int L = g ? 64 : 2048, rowbase = g ? MP + b * 64 : b * 2048;
    constexpr int XSS = 72;
    LAS float* XC = (LAS float*)lds;
    LAS float* AA = XC + 128 * 65;
    LAS float* UU = AA + 128 * 64;
    LAS float* SEG = UU + 128 * 64;
    LAS bf16_t* XS = (LAS bf16_t*)(SEG + 8 * 64 * 2);
    LAS bf16_t* GS = XS + 131 * XSS;
    const int c = tid & 63, seg = tid >> 6, ch = hb * 64 + c;
    const float* cw = PAR(a, PO_CW) + (size_t)j * 4 * 512 + ch;
    const float w0 = cw[0], w1 = cw[512], w2 = cw[1024], w3 = cw[1536], cb = PAR(a, PO_CB)[j * 512 + ch];
    const int tb = wave >> 1, chh = wave & 1, hh = lane >> 5, oc = chh * 32 + (lane & 31);
    bf16x8 Wr[4], Wi[4];
    {
        const float* wr_ = PAR(a, PO_WR) + ((size_t)(j * 8 + hb) * 64) * 64 + oc; const float* wi_ = PAR(a, PO_WI) + ((size_t)(j * 8 + hb) * 64) * 64 + oc;
#pragma unroll
        for (int ks = 0; ks < 4; ++ks)
#pragma unroll
            for (int e = 0; e < 8; ++e) { const int i = 16 * ks + 8 * hh + e; Wr[ks][e] = (short)f2bf(wr_[(size_t)i * 64]); Wi[ks][e] = (short)f2bf(wi_[(size_t)i * 64]); }
    }
    const float br = PAR(a, PO_BR)[j * 512 + hb * 64 + oc], bi = PAR(a, PO_BI)[j * 512 + hb * 64 + oc];
    const float lam = PAR(a, PO_LAM)[j * 512 + hb * 64 + oc];
    const float spl = (lam > 0.f ? 0.f : -lam) + log1pf(__expf(-fabsf(lam)));
    float carry = g ? PAR(a, PO_H0)[(size_t)(j * 8 + b) * 512 + ch] : 0.f;
    const int prow = tid >> 3, pcol = (tid & 7) * 8;
    const bf16_t* xg = XAQ + (size_t)(rowbase + prow) * 1536 + hb * 64 + pcol;
    u32x4 sx[2], sg[2];
    const u32x4 zero4 = {0u, 0u, 0u, 0u};
#pragma unroll
    for (int k = 0; k < 2; ++k) { const bool ok = prow + 64 * k < L; sx[k] = ok ? *(const u32x4*)(xg + (size_t)(64 * k) * 1536) : zero4; sg[k] = ok ? *(const u32x4*)(xg + (size_t)(64 * k) * 1536 + 512) : zero4; }
#pragma unroll
    for (int k = 0; k < 2; ++k) { *(LAS u32x4*)(XS + (3 + prow + 64 * k) * XSS + pcol) = sx[k]; *(LAS u32x4*)(GS + (prow + 64 * k) * 64 + pcol) = sg[k]; }
    float h3 = 0.f, h2 = 0.f, h1 = 0.f;
    if (g) { const float* cst = PAR(a, PO_CST) + (size_t)(j * 8 + b) * 3 * 512 + ch; h3 = cst[0]; h2 = cst[512]; h1 = cst[1024]; }
    if (seg == 7) { XS[0 * XSS + c] = (bf16_t)f2bf(h3); XS[1 * XSS + c] = (bf16_t)f2bf(h2); XS[2 * XSS + c] = (bf16_t)f2bf(h1); }
    __syncthreads();
    const int nchunk = (L + 127) / 128;
    const int seg_last = ((L - 1) & 127) >> 4;
    float e3 = 0.f, e2 = 0.f, e1 = 0.f;
    for (int ck = 0; ck < nchunk; ++ck) {
        const int t0 = ck * 128;
        const bool more = ck + 1 < nchunk;
        if (more) {
#pragma unroll
            for (int k = 0; k < 2; ++k) { sx[k] = *(const u32x4*)(xg + (size_t)(t0 + 128 + 64 * k) * 1536); sg[k] = *(const u32x4*)(xg + (size_t)(t0 + 128 + 64 * k) * 1536 + 512); }
        }
        {
            float xm3 = bf1(XS[(16 * seg + 0) * XSS + c]), xm2 = bf1(XS[(16 * seg + 1) * XSS + c]), xm1 = bf1(XS[(16 * seg + 2) * XSS + c]);
#pragma unroll
            for (int q = 0; q < 16; ++q) { const float x0 = bf1(XS[(16 * seg + q + 3) * XSS + c]); XC[(16 * seg + q) * 65 + c] = cb + w0 * xm3 + w1 * xm2 + w2 * xm1 + w3 * x0; xm3 = xm2; xm2 = xm1; xm1 = x0; }
            e3 = xm3; e2 = xm2; e1 = xm1;
        }
        __syncthreads();
        {
            f32x16 ar, ai;
#pragma unroll
            for (int i = 0; i < 16; ++i) { ar[i] = 0.f; ai[i] = 0.f; }
            const int tokA = 32 * tb + (lane & 31);
#pragma unroll
            for (int ks = 0; ks < 4; ++ks) {
                bf16x8 A; const LAS float* s = XC + tokA * 65 + 16 * ks + 8 * hh;
#pragma unroll
                for (int e = 0; e < 8; ++e) A[e] = (short)f2bf(s[e]);
                ar = MFMA32(A, Wr[ks], ar); ai = MFMA32(A, Wi[ks], ai);
            }
#pragma unroll
            for (int i = 0; i < 16; ++i) {
                const int tl = 32 * tb + crow(i, hh);
                const float rg = sigmoidf_(ar[i] + br), ig = sigmoidf_(ai[i] + bi);
                const float la = -8.f * rg * spl;
                float av = __expf(la), uv = sqrtf(-expm1f(2.f * la)) * ig * XC[tl * 65 + oc];
                if (t0 + tl >= L) { av = 1.f; uv = 0.f; }
                AA[tl * 64 + oc] = av; UU[tl * 64 + oc] = uv;
            }
        }
        __syncthreads();
        {
            float A = 1.f, Hh = 0.f;
#pragma unroll
            for (int q = 0; q < 16; ++q) { const float av = AA[(16 * seg + q) * 64 + c], uv = UU[(16 * seg + q) * 64 + c]; Hh = av * Hh + uv; A *= av; }
            SEG[(seg * 64 + c) * 2] = A; SEG[(seg * 64 + c) * 2 + 1] = Hh;
        }
        __syncthreads();
        {
            float hin = carry;
            for (int s = 0; s < seg; ++s) hin = SEG[(s * 64 + c) * 2] * hin + SEG[(s * 64 + c) * 2 + 1];
            float hend = hin;
            for (int s = seg; s < 8; ++s) hend = SEG[(s * 64 + c) * 2] * hend + SEG[(s * 64 + c) * 2 + 1];
            carry = hend;
            float h = hin;
#pragma unroll
            for (int q = 0; q < 16; ++q) {
                const int tl = 16 * seg + q, t = t0 + tl;
                h = AA[tl * 64 + c] * h + UU[tl * 64 + c];
                if (t < L) {
                    const float gv = bf1(GS[tl * 64 + c]);
                    const float gl = gv * sigmoidf_(1.5957691216057308f * (gv + 0.044715f * gv * gv * gv));
                    MIX[(size_t)(rowbase + t) * 1024 + ch] = (bf16_t)f2bf(gl * h);
                }
            }
        }
        __syncthreads();
        if (more) {
            if (seg == 7) { XS[0 * XSS + c] = (bf16_t)f2bf(e3); XS[1 * XSS + c] = (bf16_t)f2bf(e2); XS[2 * XSS + c] = (bf16_t)f2bf(e1); }
#pragma unroll
            for (int k = 0; k < 2; ++k) { *(LAS u32x4*)(XS + (3 + prow + 64 * k) * XSS + pcol) = sx[k]; *(LAS u32x4*)(GS + (prow + 64 * k) * 64 + pcol) = sg[k]; }
            __syncthreads();
        }
    }
    if (seg == seg_last) {
        float* co = a.out + (g ? O_CONV_S : O_CONV_P) + ((size_t)(j * 8 + b) * 3) * 512 + ch;
        co[0] = e3; co[512] = e2; co[1024] = e1;
    }
    if (seg == 0) a.out[(g ? O_LRUH_S : O_LRUH_P) + (size_t)(j * 8 + b) * 512 + ch] = carry;
    __syncthreads();
}
DI void sb_task(const KArgs& a, int j, int task, int lane) {
    int g, b, h, qb;
    if (task < 128) { g = 1; b = task >> 4; h = (task >> 1) & 7; qb = task & 1; }
    else { const int q = task - 128; g = 0; b = q >> 9; h = (q >> 6) & 7; qb = 63 - (q & 63); }
    const int P = g ? 2048 : 0, T = g ? 2112 : 2048, rowbase = g ? MP + b * 64 : b * 2048;
    const bf16_t* XAQ = (const bf16_t*)(a.ws + WS_XAQ); bf16_t* MIX = (bf16_t*)(a.ws + WS_MIXE);
    const bf16_t* Kb = g ? (const bf16_t*)(a.ws + WS_KBS) + (size_t)j * (SZ_KBS1 / 2) + (size_t)(b * 8 + h) * 2112 * 64 : (const bf16_t*)(a.ws + WS_KBP) + (size_t)(b * 8 + h) * 2048 * 64;
    const bf16_t* Vt = g ? (const bf16_t*)(a.ws + WS_VTS) + (size_t)j * (SZ_KBS1 / 2) + (size_t)(b * 8 + h) * 64 * 2112 : (const bf16_t*)(a.ws + WS_VTP) + (size_t)(b * 8 + h) * 64 * 2048;
    const int ql = lane & 31, hh = lane >> 5;
    const int rq = rowbase + 32 * qb + ql, tabs = P + 32 * qb + ql;
    bf16x8 qf[4];
#pragma unroll
    for (int ks = 0; ks < 4; ++ks) qf[ks] = *(const bf16x8*)(XAQ + (size_t)rq * 1536 + 1024 + h * 64 + 16 * ks + 8 * hh);
    f32x16 o0, o1;
#pragma unroll
    for (int i = 0; i < 16; ++i) { o0[i] = 0.f; o1[i] = 0.f; }
    float carry = 0.f;
    int kb = (P >> 5) + qb;
    bf16x8 kf[4];
#pragma unroll
    for (int ks = 0; ks < 4; ++ks) kf[ks] = *(const bf16x8*)(Kb + (size_t)(32 * kb + ql) * 64 + 16 * ks + 8 * hh);
    for (; kb >= 0; --kb) {
        u32x2 va[2][2][2];
#pragma unroll
        for (int dh = 0; dh < 2; ++dh)
#pragma unroll
            for (int s = 0; s < 2; ++s) { const bf16_t* p = Vt + (size_t)(32 * dh + ql) * T + 32 * kb + 16 * s + 4 * hh; va[dh][s][0] = *(const u32x2*)p; va[dh][s][1] = *(const u32x2*)(p + 8); }
        bf16x8 kn[4];
        if (kb > 0) {
#pragma unroll
            for (int ks = 0; ks < 4; ++ks) kn[ks] = *(const bf16x8*)(Kb + (size_t)(32 * (kb - 1) + ql) * 64 + 16 * ks + 8 * hh);
        } else {
#pragma unroll
            for (int ks = 0; ks < 4; ++ks) kn[ks] = kf[ks];
        }
        f32x16 st;
#pragma unroll
        for (int i = 0; i < 16; ++i) st[i] = 0.f;
#pragma unroll
        for (int ks = 0; ks < 4; ++ks) st = MFMA32(kf[ks], qf[ks], st);
        float z[16], lb[16];
#pragma unroll
        for (int i = 0; i < 16; ++i) {
            z[i] = st[i] * 0.125f;
            const float sp = fmaxf(z[i], 0.f) + __logf(1.f + __expf(-fabsf(z[i])));
            const bool ok = (32 * kb + crow(i, hh)) < tabs;
            lb[i] = ok ? -sp : 0.f;
        }
        float G[4], Gx[4];
#pragma unroll
        for (int q = 0; q < 4; ++q) { G[q] = (lb[4 * q] + lb[4 * q + 1]) + (lb[4 * q + 2] + lb[4 * q + 3]); Gx[q] = lane_xor(G[q], lane, 32); }
        float pv[16];
        float suf = carry;
#pragma unroll
        for (int q = 3; q >= 0; --q) {
            float tl = suf + (hh == 0 ? Gx[q] : 0.f);
#pragma unroll
            for (int ii = 3; ii >= 0; --ii) {
                const int i = 4 * q + ii;
                const bool ok = (32 * kb + crow(i, hh)) < tabs;
                pv[i] = ok ? __expf(z[i] + lb[i] + tl) : 0.f;
                tl += lb[i];
            }
            suf += G[q] + Gx[q];
        }
        carry = suf;
        bf16x8 pb[2];
#pragma unroll
        for (int s = 0; s < 2; ++s) {
            u32x4 w; w.x = pk2(pv[8 * s], pv[8 * s + 1]); w.y = pk2(pv[8 * s + 2], pv[8 * s + 3]); w.z = pk2(pv[8 * s + 4], pv[8 * s + 5]); w.w = pk2(pv[8 * s + 6], pv[8 * s + 7]);
            pb[s] = __builtin_bit_cast(bf16x8, w);
        }
#pragma unroll
        for (int s = 0; s < 2; ++s) {
            u32x4 w0; w0.x = va[0][s][0].x; w0.y = va[0][s][0].y; w0.z = va[0][s][1].x; w0.w = va[0][s][1].y;
            u32x4 w1; w1.x = va[1][s][0].x; w1.y = va[1][s][0].y; w1.z = va[1][s][1].x; w1.w = va[1][s][1].y;
            o0 = MFMA32(__builtin_bit_cast(bf16x8, w0), pb[s], o0);
            o1 = MFMA32(__builtin_bit_cast(bf16x8, w1), pb[s], o1);
        }
#pragma unroll
        for (int ks = 0; ks < 4; ++ks) kf[ks] = kn[ks];
        if (__all(carry < -104.f)) break;
    }
#pragma unroll
    for (int q = 0; q < 4; ++q) {
        u32x2 w; w.x = pk2(o0[4 * q], o0[4 * q + 1]); w.y = pk2(o0[4 * q + 2], o0[4 * q + 3]);
        *(u32x2*)(MIX + (size_t)rq * 1024 + 512 + h * 64 + 8 * q + 4 * hh) = w;
        w.x = pk2(o1[4 * q], o1[4 * q + 1]); w.y = pk2(o1[4 * q + 2], o1[4 * q + 3]);
        *(u32x2*)(MIX + (size_t)rq * 1024 + 512 + h * 64 + 32 + 8 * q + 4 * hh) = w;
    }
}

DI void ret_unit(const KArgs& a, int j, int g, int b, int h, int es, LAS unsigned char* lds, int wave, int lane_in) {
    int lane = lane_in; asm volatile("" : "+v"(lane));
    const int L = g ? 64 : 2048, rowbase = g ? MP + b * 64 : b * 2048, nch = L >> 6;
    const bf16_t* VT = (const bf16_t*)(a.ws + WS_VT) + (g ? (size_t)MP * 2048 + ((size_t)(b * 4 + h) * 512 + es * 64) * 64 : ((size_t)(b * 4 + h) * 512 + es * 64) * 2048);
    const float lg2 = log2f(1.f - exp2f(-5.f - (float)h));
    const int l31 = lane & 31, hh = lane >> 5, w4 = wave & 3;
    constexpr int RTS = 264;
    LAS bf16_t* RT = (LAS bf16_t*)lds;
    LAS bf16_t* QS = RT + 2 * 64 * RTS;
    LAS bf16_t* KS = QS + 64 * RTS;
    const int tid = wave * 64 + lane, srow = tid >> 3, scol = (tid & 7) * 32;
    const bf16_t* qg = (const bf16_t*)(a.ws + WS_QR) + (size_t)(rowbase + srow) * 1024 + h * 256 + scol;
    const bf16_t* kg = (const bf16_t*)(a.ws + WS_KR) + (size_t)(rowbase + srow) * 1024 + h * 256 + scol;
    u32x4 sq[4], sk[4];
#pragma unroll
    for (int k = 0; k < 4; ++k) { sq[k] = *(const u32x4*)(qg + 8 * k); sk[k] = *(const u32x4*)(kg + 8 * k); }
#pragma unroll
    for (int k = 0; k < 4; ++k) { *(LAS u32x4*)(QS + srow * RTS + scol + 8 * k) = sq[k]; *(LAS u32x4*)(KS + srow * RTS + scol + 8 * k) = sk[k]; }
    if (wave < 4) {
        bf16_t* OB = (bf16_t*)(a.ws + WS_OB);
        const int et = w4 & 1, lt = w4 >> 1;
        const float xi = exp2f(lg2 * (float)(32 * lt + l31 + 1));
        __syncthreads();
        int buf = 0;
        for (int c = 0; c < nch; ++c) {
            const int t0 = c * 64;
            const bool more = c + 1 < nch;
            if (more) {
#pragma unroll
                for (int k = 0; k < 4; ++k) { sq[k] = *(const u32x4*)(qg + (size_t)(t0 + 64) * 1024 + 8 * k); sk[k] = *(const u32x4*)(kg + (size_t)(t0 + 64) * 1024 + 8 * k); }
            }
            const int rl = rowbase + t0 + 32 * lt + l31;
            int l31c = l31; asm volatile("" : "+v"(l31c));
            u32x2 vv[2][2][2];
#pragma unroll
            for (int mt = 0; mt < 2; ++mt)
#pragma unroll
                for (int s = 0; s < 2; ++s) { const bf16_t* vp = VT + (size_t)(32 * et + l31) * L + t0 + 32 * mt + 16 * s + 4 * hh; vv[mt][s][0] = *(const u32x2*)vp; vv[mt][s][1] = *(const u32x2*)(vp + 8); }
            f32x16 st0, st1, oc, oi;
#pragma unroll
            for (int i = 0; i < 16; ++i) { st0[i] = 0.f; st1[i] = 0.f; oc[i] = 0.f; oi[i] = 0.f; }
            const LAS bf16_t* qp = QS + (32 * lt + l31) * RTS + 8 * hh;
            const LAS bf16_t* kp = KS + l31 * RTS + 8 * hh;
            const LAS bf16_t* rp = RT + buf * (64 * RTS) + (32 * et + l31) * RTS + 8 * hh;
#pragma unroll 2
            for (int ks = 0; ks < 16; ++ks) {
                const bf16x8 qf = *(const LAS bf16x8*)(qp + 16 * ks);
                const bf16x8 k0 = *(const LAS bf16x8*)(kp + 16 * ks), k1 = *(const LAS bf16x8*)(kp + 32 * RTS + 16 * ks);
                const bf16x8 rf = *(const LAS bf16x8*)(rp + 16 * ks);
                st0 = MFMA32(k0, qf, st0); st1 = MFMA32(k1, qf, st1);
                oc = MFMA32(rf, qf, oc);
            }
#pragma unroll
            for (int mt = 0; mt < 2; ++mt) {
                float p[16];
#pragma unroll
                for (int i = 0; i < 16; ++i) { const int mm = 32 * mt + crow(i, hh), ll = 32 * lt + l31c; const float dd = (float)(mm > ll ? mm - ll : ll - mm); p[i] = (mt ? st1[i] : st0[i]) * __builtin_amdgcn_exp2f(lg2 * dd); }
#pragma unroll
                for (int s = 0; s < 2; ++s) {
                    u32x4 w; w.x = pk2(p[8 * s], p[8 * s + 1]); w.y = pk2(p[8 * s + 2], p[8 * s + 3]); w.z = pk2(p[8 * s + 4], p[8 * s + 5]); w.w = pk2(p[8 * s + 6], p[8 * s + 7]);
                    u32x4 va; va.x = vv[mt][s][0].x; va.y = vv[mt][s][0].y; va.z = vv[mt][s][1].x; va.w = vv[mt][s][1].y;
                    oi = MFMA32(__builtin_bit_cast(bf16x8, va), __builtin_bit_cast(bf16x8, w), oi);
                }
            }
#pragma unroll
            for (int q = 0; q < 4; ++q) {
                u32x2 w; w.x = pk2(oi[4 * q] + xi * oc[4 * q], oi[4 * q + 1] + xi * oc[4 * q + 1]); w.y = pk2(oi[4 * q + 2] + xi * oc[4 * q + 2], oi[4 * q + 3] + xi * oc[4 * q + 3]);
                *(u32x2*)(OB + (size_t)rl * 2048 + h * 512 + es * 64 + 32 * et + 8 * q + 4 * hh) = w;
            }
            __syncthreads();
            if (more) {
#pragma unroll
                for (int k = 0; k < 4; ++k) { *(LAS u32x4*)(QS + srow * RTS + scol + 8 * k) = sq[k]; *(LAS u32x4*)(KS + srow * RTS + scol + 8 * k) = sk[k]; }
            }
            __syncthreads();
            buf ^= 1;
        }
    } else {
        const bf16_t* KT = (const bf16_t*)(a.ws + WS_KT) + (g ? (size_t)MP * 1024 + (size_t)(b * 4 + h) * 256 * 64 : (size_t)(b * 4 + h) * 256 * 2048);
        f32x16 R[2][2];
#pragma unroll
        for (int x = 0; x < 2; ++x)
#pragma unroll
            for (int y = 0; y < 2; ++y)
#pragma unroll
                for (int i = 0; i < 16; ++i) R[x][y][i] = 0.f;
        if (g) {
            const char* R0u = (const char*)(a.in[8] + ((size_t)((j * 8 + b) * 4 + h) * 256 + 32 * (2 * w4)) * 512 + es * 64);
            const unsigned voff = (unsigned)((4 * hh) * 512 + l31) * 4u;
#pragma unroll
            for (int dti = 0; dti < 2; ++dti)
#pragma unroll
                for (int et = 0; et < 2; ++et)
#pragma unroll
                    for (int i = 0; i < 16; ++i) R[dti][et][i] = *(const float*)(R0u + (size_t)((32 * dti + 8 * (i >> 2) + (i & 3)) * 512 + 32 * et) * 4 + voff);
        }
#pragma unroll
        for (int dti = 0; dti < 2; ++dti)
#pragma unroll
            for (int et = 0; et < 2; ++et)
#pragma unroll
                for (int q = 0; q < 4; ++q) { u32x2 w; w.x = pk2(R[dti][et][4 * q], R[dti][et][4 * q + 1]); w.y = pk2(R[dti][et][4 * q + 2], R[dti][et][4 * q + 3]);
                    *(LAS u32x2*)(RT + (32 * et + l31) * RTS + 32 * (2 * w4 + dti) + 8 * q + 4 * hh) = w; }
        const bf16_t* ktp = KT + (size_t)(32 * (2 * w4) + l31) * L + 8 * hh;
        const bf16_t* vtp = VT + (size_t)l31 * L + 8 * hh;
        __syncthreads();
        const float g64 = exp2f(lg2 * 64.f);
        int buf = 0;
        for (int c = 0; c < nch; ++c) {
            const int t0 = c * 64;
            const bool more = c + 1 < nch;
            if (more) {
#pragma unroll
                for (int k = 0; k < 4; ++k) { sq[k] = *(const u32x4*)(qg + (size_t)(t0 + 64) * 1024 + 8 * k); sk[k] = *(const u32x4*)(kg + (size_t)(t0 + 64) * 1024 + 8 * k); }
            }
            u32x4 kw[2][4]; bf16x8 vb[2][4];
#pragma unroll
            for (int x = 0; x < 2; ++x)
#pragma unroll
                for (int s = 0; s < 4; ++s) { kw[x][s] = *(const u32x4*)(ktp + (size_t)(32 * x) * L + t0 + 16 * s); vb[x][s] = *(const bf16x8*)(vtp + (size_t)(32 * x) * L + t0 + 16 * s); }
#pragma unroll
            for (int dti = 0; dti < 2; ++dti)
#pragma unroll
                for (int et = 0; et < 2; ++et)
#pragma unroll
                    for (int i = 0; i < 16; ++i) R[dti][et][i] *= g64;
#pragma unroll
            for (int s = 0; s < 4; ++s) {
#pragma unroll
                for (int dti = 0; dti < 2; ++dti) {
                    const bf16x8 ka = __builtin_bit_cast(bf16x8, kw[dti][s]);
                    R[dti][0] = MFMA32(ka, vb[0][s], R[dti][0]); R[dti][1] = MFMA32(ka, vb[1][s], R[dti][1]);
                }
            }
#pragma unroll
            for (int dti = 0; dti < 2; ++dti)
#pragma unroll
                for (int et = 0; et < 2; ++et)
#pragma unroll
                    for (int q = 0; q < 4; ++q) { u32x2 w; w.x = pk2(R[dti][et][4 * q], R[dti][et][4 * q + 1]); w.y = pk2(R[dti][et][4 * q + 2], R[dti][et][4 * q + 3]);
                        *(LAS u32x2*)(RT + (buf ^ 1) * (64 * RTS) + (32 * et + l31) * RTS + 32 * (2 * w4 + dti) + 8 * q + 4 * hh) = w; }
            __syncthreads();
            if (more) {
#pragma unroll
                for (int k = 0; k < 4; ++k) { *(LAS u32x4*)(QS + srow * RTS + scol + 8 * k) = sq[k]; *(LAS u32x4*)(KS + srow * RTS + scol + 8 * k) = sk[k]; }
            }
            __syncthreads();
            buf ^= 1;
        }
        char* Rou = (char*)(a.out + (g ? O_RET_S : O_RET_P) + ((size_t)((j * 8 + b) * 4 + h) * 256 + 32 * (2 * w4)) * 512 + es * 64);
        const unsigned voffo = (unsigned)((4 * hh) * 512 + l31) * 4u;
#pragma unroll
        for (int dti = 0; dti < 2; ++dti)
#pragma unroll
            for (int et = 0; et < 2; ++et)
#pragma unroll
                for (int i = 0; i < 16; ++i) *(float*)(Rou + (size_t)((32 * dti + 8 * (i >> 2) + (i & 3)) * 512 + 32 * et) * 4 + voffo) = R[dti][et][i];
    }
}
DI void gn_phase(const KArgs& a, int gw, int NGW, int lane) {
    bf16_t* OB = (bf16_t*)(a.ws + WS_OB); const bf16_t* GG = (const bf16_t*)(a.ws + WS_GG);
    for (int it = gw; it < M * 4; it += NGW) {
        const size_t off = (size_t)(it >> 2) * 2048 + (it & 3) * 512 + lane * 8;
        const u32x4 ow = *(const u32x4*)(OB + off), gwv = *(const u32x4*)(GG + off);
        float o[8] = {bflo(ow.x), bfhi(ow.x), bflo(ow.y), bfhi(ow.y), bflo(ow.z), bfhi(ow.z), bflo(ow.w), bfhi(ow.w)};
        const float gg[8] = {bflo(gwv.x), bfhi(gwv.x), bflo(gwv.y), bfhi(gwv.y), bflo(gwv.z), bfhi(gwv.z), bflo(gwv.w), bfhi(gwv.w)};
        float s = 0.f;
#pragma unroll
        for (int e = 0; e < 8; ++e) s += o[e];
        const float mu = wave_sum(s, lane) * (1.f / 512.f);
        float v = 0.f;
#pragma unroll
        for (int e = 0; e < 8; ++e) { o[e] -= mu; v += o[e] * o[e]; }
        const float rstd = rsqrtf(wave_sum(v, lane) * (1.f / 512.f) + EPS);
        float y[8];
#pragma unroll
        for (int e = 0; e < 8; ++e) y[e] = gg[e] * sigmoidf_(gg[e]) * o[e] * rstd;
        u32x4 w; w.x = pk2(y[0], y[1]); w.y = pk2(y[2], y[3]); w.z = pk2(y[4], y[5]); w.w = pk2(y[6], y[7]);
        *(u32x4*)(OB + off) = w;
    }
}

DI void small_gemm_sample(const bf16_t* A, const bf16_t* Bt, int K, bf16_t* O, const bf16_t* PE, LAS unsigned char* lds, int tile, int wave, int lane) {
    const int tm = tile >> 4, tn = tile & 15, nh = wave & 1, kq = wave >> 1, l31 = lane & 31, hh = lane >> 5;
    const int kper = K >> 2;
    const bf16_t* ap = A + (size_t)(MP + 32 * tm + l31) * K + kq * kper + 8 * hh;
    const bf16_t* bp = Bt + (size_t)(64 * tn + 32 * nh + l31) * K + kq * kper + 8 * hh;
    f32x16 acc;
#pragma unroll
    for (int i = 0; i < 16; ++i) acc[i] = 0.f;
#pragma unroll 4
    for (int k = 0; k < kper; k += 16) {
        const bf16x8 av = *(const bf16x8*)(ap + k), bv = *(const bf16x8*)(bp + k);
        acc = MFMA32(av, bv, acc);
    }
    LAS float* red = (LAS float*)lds;
#pragma unroll
    for (int i = 0; i < 16; ++i) red[((kq * 2 + nh) * 16 + i) * 64 + lane] = acc[i];
    __syncthreads();
    {
        const int q = wave >> 1;
#pragma unroll
        for (int ii = 0; ii < 4; ++ii) {
            const int i = 4 * q + ii;
            float v = 0.f;
#pragma unroll
            for (int k4 = 0; k4 < 4; ++k4) v += red[((k4 * 2 + nh) * 16 + i) * 64 + lane];
            const size_t off = (size_t)(MP + 32 * tm + crow(i, hh)) * 1024 + 64 * tn + 32 * nh + l31;
            if (PE) v = sigmoidf_(v) * bf1(PE[off]);
            O[off] = (bf16_t)f2bf(v);
        }
    }
    __syncthreads();
}
#if REP_GEMM > 1
struct GOrder {
    pg8::StaticOrder b; int cnt;
    DI void init(int M_, int N_, int G_, int c_) { b.init(M_, N_, G_, c_); cnt = (b.nwg - c_ + G_ - 1) / G_; if (cnt < 0) cnt = 0; }
    DI bool next(int i, pg8::Unit& u) const { if (i >= cnt * REP_GEMM) return false; return b.next(i % cnt, u); }
    DI void a_ready(const pg8::Unit&) const {}
    DI void done(const pg8::Unit&) const {}
};
#else
typedef pg8::StaticOrder GOrder;
#endif
#define XB_TMO      128
#define XB_XCNT(j)  (256  + 64 * (j))
#define XB_XSUB(j)  (1280 + 64 * (j))
#define XB_XGEN(j)  (2304 + 64 * (j))
#define XB_TOP      3328
#define XB_TOPGEN   3392
#define XCD_BAR_WORDS 3456
#define XB_SPIN_CAP (1u << 18)

__device__ __forceinline__ unsigned xb_ld(unsigned* p)              { return __hip_atomic_load(p, __ATOMIC_RELAXED, __HIP_MEMORY_SCOPE_AGENT); }
__device__ __forceinline__ unsigned xb_add(unsigned* p, unsigned v) { return __hip_atomic_fetch_add(p, v, __ATOMIC_RELAXED, __HIP_MEMORY_SCOPE_AGENT); }
__device__ __forceinline__ unsigned xb_xcc_id() { return (unsigned)__builtin_amdgcn_s_getreg((3 << 11) | 20) & 0xFu; }
#define XB_SPIN(cond, bar) do { unsigned _sp = 0; while (cond) { __builtin_amdgcn_s_sleep(1); \
    if ((++_sp & 255u) == 0u) { if (xb_ld(&(bar)[XB_TMO])) break; if (_sp > XB_SPIN_CAP) { atomicAdd(&(bar)[XB_TMO], 1u); break; } } } } while (0)

struct XcdBarrier {
    unsigned* bar; unsigned x;
    volatile LAS unsigned* st;
};

__device__ __forceinline__ XcdBarrier xcd_barrier_post(unsigned* bar, volatile LAS unsigned* st) {
    XcdBarrier b; b.bar = bar; b.x = xb_xcc_id(); b.st = st;
    if (threadIdx.x == 0) (void)xb_add(&bar[XB_XCNT(b.x)], 1u);
    return b;
}
__device__ __forceinline__ void xcd_barrier_complete(unsigned* bar, unsigned x, unsigned& nloc, unsigned& nx) {
    const unsigned G = gridDim.x * gridDim.y * gridDim.z;
    unsigned sum, cnt, mine, sp = 0u;
    for (;;) {
        sum = 0u; cnt = 0u; mine = 0u;
#pragma unroll
        for (unsigned j = 0; j < 16; ++j) { const unsigned c = xb_ld(&bar[XB_XCNT(j)]); sum += c; cnt += (c > 0u) ? 1u : 0u; mine = (j == x) ? c : mine; }
        if (sum == G) break;
        __builtin_amdgcn_s_sleep(1);
        if ((++sp & 255u) == 0u) { if (xb_ld(&bar[XB_TMO])) break; if (sp > XB_SPIN_CAP) { atomicAdd(&bar[XB_TMO], 1u); break; } }
    }
    nloc = mine > 0u ? mine : 1u; nx = cnt > 0u ? cnt : 1u;
}

__device__ __forceinline__ void xcd_barrier(const XcdBarrier& b) {
    asm volatile("s_waitcnt vmcnt(0)" ::: "memory");
    __syncthreads();
    if (threadIdx.x == 0) {
        unsigned* bar = b.bar;
        __builtin_amdgcn_s_waitcnt(0);
        unsigned nloc = b.st[0], nx = b.st[1];
        if (nloc == 0u) { xcd_barrier_complete(bar, b.x, nloc, nx); b.st[0] = nloc; b.st[1] = nx; }
        const unsigned old = xb_add(&bar[XB_XSUB(b.x)], 1u);
        const unsigned gen = old / nloc;
        if (old + 1u == (gen + 1u) * nloc) {
            __builtin_amdgcn_fence(__ATOMIC_RELEASE, "agent");
            asm volatile("s_waitcnt vmcnt(0)" ::: "memory");
            const unsigned og = xb_add(&bar[XB_TOP], 1u);
            const unsigned tg = og / nx;
            if (og + 1u == (tg + 1u) * nx) xb_add(&bar[XB_TOPGEN], 1u);
            else XB_SPIN(xb_ld(&bar[XB_TOPGEN]) == tg, bar);
            __builtin_amdgcn_fence(__ATOMIC_ACQUIRE, "agent");
            xb_add(&bar[XB_XGEN(b.x)], 1u);
            asm volatile("s_waitcnt vmcnt(0)" ::: "memory");
        } else {
            XB_SPIN(xb_ld(&bar[XB_XGEN(b.x)]) == gen, bar);
            __builtin_amdgcn_fence(__ATOMIC_ACQUIRE, "agent");
            asm volatile("s_waitcnt vmcnt(0)" ::: "memory");
        }
    }
    __syncthreads();
}


__global__ void __launch_bounds__(NTHR, 2) hybrid_fwd(const KArgs a) {
    extern __shared__ __attribute__((aligned(16))) unsigned char lds_raw[];
    cg::grid_group grid = cg::this_grid();
    LAS unsigned char* lds = (LAS unsigned char*)lds_raw;
    if (threadIdx.x < 16) ((LAS unsigned*)(lds + LDS_BYTES - 64))[threadIdx.x] = 0u;
    __syncthreads();
    const int G = gridDim.x, bx = blockIdx.x;
    const int vcu = (G % 8 == 0) ? (bx % 8) * (G / 8) + bx / 8 : bx;
    const int NGW = G * 8, NGT = G * NTHR;

    {
        const int tid = threadIdx.x, lane = tid & 63, wave = __builtin_amdgcn_readfirstlane(tid >> 6);
        for (int r_ = 0; r_ < REP_PRO; ++r_) prologue_phase(a, lds, vcu, G, tid, wave, lane);
        rowwise_phase(a, nullptr, nullptr, 0.f, a.in[9], vcu * 8 + wave, NGW, lane);
    }
    grid.sync();

    const KArgs a0 = a;
    XcdBarrier xbar = xcd_barrier_post((unsigned*)(a.ws + WS_CTL + 16384), (volatile LAS unsigned*)(lds + LDS_BYTES - 64));
    const int wave0 = __builtin_amdgcn_readfirstlane((int)threadIdx.x >> 6);
    for (int step = 0; step < 20; ++step) {
        KArgs a = a0;
        asm volatile("" : "+s"(a.ws), "+s"(a.out));
        unsigned char* ws = a.ws; const float* normg = PAR(a, PO_NG);
        int tid, lane, wave, gw, gt, bxs;
#define LAUNDER() do { { unsigned m_ = ~0u; asm volatile("" : "+s"(m_)); lane = (int)__builtin_amdgcn_mbcnt_hi(m_, __builtin_amdgcn_mbcnt_lo(m_, 0u)); } bxs = bx; asm volatile("" : "+s"(bxs)); wave = wave0; tid = wave * 64 + lane; gw = vcu * 8 + wave; gt = vcu * NTHR + tid; } while (0)
        LAUNDER();
#define GSYNC() do { for (int r_ = 0; r_ < REP_SYNC; ++r_) xcd_barrier(xbar); LAUNDER(); } while (0)
        const int i = step / 5, sb = step % 5, j = i >> 1;
        const bool odd = (i & 1) != 0;
        const bf16_t* yA = nullptr; const bf16_t* yB = nullptr; int yK = 0; const bf16_t* yPE = nullptr; bf16_t* yO = (bf16_t*)(ws + WS_Y);
        if (sb == 0 || sb == 2) {
            const int mf = i * 2 + (sb >> 1);
            {
                pg8::Gemm gm{(const bf16_t*)(ws + WS_H), (const bf16_t*)(ws + WS_WGU + (size_t)mf * SZ_WGU1), M, 5632, 1024};
                GOrder S; S.init(M, 5632, G, bxs);
                EpiSwiGLU E{(bf16_t*)(ws + WS_ACT)};
                pg8::gemm_phase<EpiSwiGLU, GOrder, true, true>(lds, gm, S, E, wave0);
            }
            GSYNC();
            yA = (const bf16_t*)(ws + WS_ACT); yB = (const bf16_t*)(ws + WS_WDN + (size_t)mf * SZ_WDN1); yK = FF;
        } else if (sb == 1) {
            if (!odd) {
                {
                    pg8::Gemm gm{(const bf16_t*)(ws + WS_H), (const bf16_t*)(ws + WS_WABI + (size_t)j * SZ_WABI1), M, 2560, 1024};
                    GOrder S; S.init(M, 2560, G, bxs);
                    EpiAB E{(bf16_t*)(ws + WS_XAQ), (bf16_t*)(ws + WS_KBP), (bf16_t*)(ws + WS_VTP), (bf16_t*)(ws + WS_KBS + (size_t)j * SZ_KBS1), (bf16_t*)(ws + WS_VTS + (size_t)j * SZ_KBS1), a.out, j};
                    pg8::gemm_phase<EpiAB, GOrder, true, true>(lds, gm, S, E, wave0);
                }
                GSYNC();
                for (int u = vcu; u < 128 * REP_MIX; u += G) { const int g = (u >> 6) & 1, q = u & 63; lru_unit(a, j, g, q >> 3, q & 7, lds, wave, lane); }
                {
                    unsigned* ctr = (unsigned*)(ws + WS_CTL) + 64 * j;
                    for (;;) {
                        unsigned t = 0; if (lane == 0) t = atomicAdd(ctr, 1u);
                        t = __builtin_amdgcn_readfirstlane(t);
                        if (t >= 128u + 4096u) break;
                        sb_task(a, j, (int)t, lane);
                    }
                }
                GSYNC();
                yA = (const bf16_t*)(ws + WS_MIXE); yB = (const bf16_t*)(ws + WS_WABO + (size_t)j * SZ_W1K); yK = 1024;
            } else {
                {
                    pg8::Gemm gm{(const bf16_t*)(ws + WS_H), (const bf16_t*)(ws + WS_WCI + (size_t)j * SZ_WCI1), M, 6144, 1024};
                    GOrder S; S.init(M, 6144, G, bxs);
                    EpiC E{(bf16_t*)(ws + WS_QR), (bf16_t*)(ws + WS_KR), (bf16_t*)(ws + WS_KT), (bf16_t*)(ws + WS_VT), (bf16_t*)(ws + WS_GG), (const float*)(ws + WS_TAB), (const float*)(ws + WS_TAB + SZ_TAB1)};
                    pg8::gemm_phase<EpiC, GOrder, true, true>(lds, gm, S, E, wave0);
                }
                GSYNC();
                for (int u = vcu; u < 512 * REP_RET; u += G) { const int g = (u >> 8) & 1, q = u & 255; ret_unit(a, j, g, q >> 5, (q >> 3) & 3, q & 7, lds, wave, lane); }
                GSYNC();
                gn_phase(a, gw, NGW, lane);
                GSYNC();
                yA = (const bf16_t*)(ws + WS_OB); yB = (const bf16_t*)(ws + WS_WCO + (size_t)j * SZ_WCO1); yK = 2048;
            }
        } else if (sb == 3) {
            yA = (const bf16_t*)(ws + WS_PB); yB = (const bf16_t*)(ws + WS_WPI + (size_t)i * SZ_WPI1); yK = 256; yO = (bf16_t*)(ws + WS_PE);
        } else {
            yA = (const bf16_t*)(ws + WS_H); yB = (const bf16_t*)(ws + WS_WPG + (size_t)i * SZ_W1K); yK = 1024; yPE = (const bf16_t*)(ws + WS_PE);
        }
        {
            pg8::Gemm gm{yA, yB, MP, 1024, yK};
            GOrder S; S.init(MP, 1024, G, bxs);
            EpiY E{yO, yPE};
            pg8::gemm_phase<EpiY, GOrder, true, true>(lds, gm, S, E, wave0);
            LAUNDER();
            for (int r_ = 0; r_ < REP_GEMM; ++r_) for (int tl = vcu; tl < 256; tl += G) small_gemm_sample(yA, yB, yK, yO, yPE, lds, tl, wave, lane);
        }
        GSYNC();
        if (sb != 3) {
            const int nidx = (sb == 4) ? 3 : sb;
            const float* ga = normg + (size_t)(i * 8 + 2 * nidx + 1) * 1024;
            const float* gb = (step == 19) ? nullptr : normg + (size_t)(i * 8 + 2 * nidx + 2) * 1024;
            rowwise_phase(a, (const bf16_t*)(ws + WS_Y), ga, (nidx & 1) ? 1.f : 0.5f, gb, gw, NGW, lane);
            if (sb == 2) pconv_phase(a, i, gt, NGT);
            if (step != 19) GSYNC();
        }
    }
}

extern "C" void kernel_launch(void* const* d_in, const int* in_sizes, int n_in, void* d_out, int out_size, void* d_ws, size_t ws_size, hipStream_t stream) {
    static int grid = 0;
    if (grid == 0) {
        int dev = 0, cus = 0, per_cu = 0;
        if (hipGetDevice(&dev) != hipSuccess || hipDeviceGetAttribute(&cus, hipDeviceAttributeMultiprocessorCount, dev) != hipSuccess) { grid = -1; return; }
        if (hipFuncSetAttribute((const void*)hybrid_fwd, hipFuncAttributeMaxDynamicSharedMemorySize, LDS_BYTES) != hipSuccess) { fprintf(stderr, "hipFuncSetAttribute failed\n"); grid = -1; return; }
        if (hipOccupancyMaxActiveBlocksPerMultiprocessor(&per_cu, (const void*)hybrid_fwd, NTHR, LDS_BYTES) != hipSuccess || per_cu < 1) fprintf(stderr, "occupancy query: %d\n", per_cu);
        (void)hipGetLastError();
        grid = cus;
        if (n_in != 26 || (size_t)out_size != O_END || ws_size < WS_END) { fprintf(stderr, "kernel_launch: unexpected sizes n_in %d out %d ws %zu (need %zu)\n", n_in, out_size, ws_size, (size_t)WS_END); grid = -1; return; }
    }
    if (grid < 0) return;
    if (hipMemsetAsync((char*)d_ws + WS_CTL, 0, 32768, stream) != hipSuccess) { fprintf(stderr, "memset failed\n"); return; }
    KArgs a{};
    for (int i = 0; i < 26; ++i) a.in[i] = (const float*)d_in[i];
    a.out = (float*)d_out; a.ws = (unsigned char*)d_ws;
    void* args[] = {&a};
    hipError_t e = hipLaunchCooperativeKernel((void*)hybrid_fwd, dim3(grid), dim3(NTHR), args, LDS_BYTES, stream);
    if (e != hipSuccess) fprintf(stderr, "cooperative launch failed: %s (grid %d)\n", hipGetErrorString(e), grid);
}
```
